# Optimizing an MI355X kernel written in HIP

```python
import jax, jax.numpy as jnp
from jax import lax
import numpy as np

D_MODEL = 1024
BATCH = 4
SEQ = 8192
DEPTH = 1

CHUNK = 64
N_META = 16
D_MIX = D_MODEL
D_ATTN = D_MIX // 2
D_CONV = D_MIX - D_ATTN
ATTN_HEADS = 8
HEAD_DIM = D_ATTN // ATTN_HEADS
CONV_WIDTH = 3
D_FF = 2816
Q_BLOCK = 128
EPS = 1e-6
MIX_IN_SIZES = (D_ATTN, D_ATTN, D_ATTN, ATTN_HEADS, D_CONV, D_CONV, D_CONV)
MIX_IN_WIDTH = sum(MIX_IN_SIZES)
MIX_IN_SPLITS = tuple(int(s) for s in np.cumsum(MIX_IN_SIZES)[:-1])

kernel_name = "hymba_fox_shortconv_macaron_block"


def rmsnorm(x, g):
    xf = x.astype(jnp.float32)
    y = xf * lax.rsqrt(jnp.mean(xf * xf, axis=-1, keepdims=True) + EPS)
    return (y * g.astype(jnp.float32)).astype(x.dtype)


def swiglu(h, w_in, w_out):
    gate, up = jnp.split(h @ w_in, 2, axis=-1)
    return (jax.nn.silu(gate) * up) @ w_out


def forgetting_attention(q, k, v, f_logit, b_forget, q_norm, k_norm):
    b, l, _ = q.shape
    q = rmsnorm(q.reshape(b, l, ATTN_HEADS, HEAD_DIM), q_norm)
    k = rmsnorm(k.reshape(b, l, ATTN_HEADS, HEAD_DIM), k_norm)
    v = v.reshape(b, l, ATTN_HEADS, HEAD_DIM)
    log_f = jax.nn.log_sigmoid((f_logit + b_forget).astype(jnp.float32))
    cum = jnp.cumsum(log_f, axis=1)
    lp = -(-l // Q_BLOCK) * Q_BLOCK
    pad = lp - l
    nb = lp // Q_BLOCK
    pad4 = ((0, 0), (0, pad), (0, 0), (0, 0))
    qh = jnp.pad(q, pad4).transpose(0, 2, 1, 3).astype(jnp.float32)
    kh = jnp.pad(k, pad4).transpose(0, 2, 1, 3).astype(jnp.float32)
    vh = jnp.pad(v, pad4).transpose(0, 2, 1, 3)
    cum_h = jnp.pad(cum, ((0, 0), (0, pad), (0, 0))).transpose(0, 2, 1)
    q_blocks = qh.reshape(b, ATTN_HEADS, nb, Q_BLOCK, HEAD_DIM).transpose(2, 0, 1, 3, 4)
    cq_blocks = cum_h.reshape(b, ATTN_HEADS, nb, Q_BLOCK).transpose(2, 0, 1, 3)
    kpos = jnp.arange(lp)
    scale = HEAD_DIM ** -0.5

    def one_block(args):
        qb, cqb, blk = args
        s = jnp.einsum('bhqd,bhkd->bhqk', qb, kh) * scale \
            + cqb[..., :, None] - cum_h[..., None, :]
        qpos = blk * Q_BLOCK + jnp.arange(Q_BLOCK)
        s = jnp.where(kpos[None, :] <= qpos[:, None], s, -jnp.inf)
        p = jax.nn.softmax(s, axis=-1)
        return jnp.einsum('bhqk,bhkd->bhqd', p.astype(vh.dtype), vh)

    o = lax.map(one_block, (q_blocks, cq_blocks, jnp.arange(nb)))
    o = o.transpose(1, 0, 3, 2, 4).reshape(b, lp, D_ATTN)[:, :l]
    return o.astype(q.dtype)


def gated_short_conv(gate_b, gate_c, u, conv_w):
    z = gate_c * u
    l = z.shape[1]
    zp = jnp.pad(z, ((0, 0), (CONV_WIDTH - 1, 0), (0, 0)))
    y = sum(zp[:, i:i + l] * conv_w[i] for i in range(CONV_WIDTH))
    return gate_b * y


def token_mixing(h, w_mix_in, b_forget, q_norm, k_norm, conv_w, attn_out_norm, conv_out_norm, w_mix_out):
    proj = h @ w_mix_in
    q, k, v, f_logit, gate_b, gate_c, u = jnp.split(proj, MIX_IN_SPLITS, axis=-1)
    o_attn = forgetting_attention(q, k, v, f_logit, b_forget, q_norm, k_norm)
    o_conv = gated_short_conv(gate_b, gate_c, u, conv_w)
    merged = jnp.concatenate([rmsnorm(o_attn, attn_out_norm), rmsnorm(o_conv, conv_out_norm)], axis=-1)
    return merged @ w_mix_out


def setup_inputs(seed: int = 0) -> dict:
    key = jax.random.key(seed)
    ks = jax.random.split(key, 20)
    f32 = jnp.float32
    nrm = lambda k, shape, s: jax.random.normal(k, shape, f32) * s
    gain = lambda k, shape: 1.0 + 0.02 * jax.random.normal(k, shape, f32)
    L = DEPTH
    return {
        "x": jax.random.normal(ks[0], (BATCH, SEQ, D_MODEL), f32),
        "meta_tokens": nrm(ks[1], (N_META, D_MODEL), 1.0),
        "ffn1_norm": gain(ks[2], (L, D_MODEL)),
        "ffn1_w_in": nrm(ks[3], (L, D_MODEL, 2 * D_FF), D_MODEL ** -0.5),
        "ffn1_w_out": nrm(ks[4], (L, D_FF, D_MODEL), D_FF ** -0.5),
        "mix_norm": gain(ks[5], (L, D_MODEL)),
        "w_mix_in": nrm(ks[6], (L, D_MODEL, MIX_IN_WIDTH), D_MODEL ** -0.5),
        "b_forget": nrm(ks[7], (L, ATTN_HEADS), 0.1),
        "q_norm": gain(ks[8], (L, HEAD_DIM)),
        "k_norm": gain(ks[9], (L, HEAD_DIM)),
        "conv_w": nrm(ks[10], (L, CONV_WIDTH, D_CONV), CONV_WIDTH ** -0.5),
        "attn_out_norm": gain(ks[11], (L, D_ATTN)),
        "conv_out_norm": gain(ks[12], (L, D_CONV)),
        "w_mix_out": nrm(ks[13], (L, D_MIX, D_MODEL), D_MIX ** -0.5),
        "ffn2_norm": gain(ks[14], (L, D_MODEL)),
        "ffn2_w_in": nrm(ks[15], (L, D_MODEL, 2 * D_FF), D_MODEL ** -0.5),
        "ffn2_w_out": nrm(ks[16], (L, D_FF, D_MODEL), D_FF ** -0.5),
        "final_norm": gain(ks[17], (L, D_MODEL)),
    }


def reference(x, meta_tokens, ffn1_norm, ffn1_w_in, ffn1_w_out, mix_norm, w_mix_in, b_forget,
              q_norm, k_norm, conv_w, attn_out_norm, conv_out_norm, w_mix_out,
              ffn2_norm, ffn2_w_in, ffn2_w_out, final_norm):
    b = x.shape[0]
    meta = jnp.broadcast_to(meta_tokens[None].astype(x.dtype), (b, N_META, D_MODEL))
    h = jnp.concatenate([meta, x], axis=1)
    for i in range(DEPTH):
        h = h + 0.5 * swiglu(rmsnorm(h, ffn1_norm[i]), ffn1_w_in[i], ffn1_w_out[i])
        h = h + token_mixing(rmsnorm(h, mix_norm[i]), w_mix_in[i], b_forget[i], q_norm[i], k_norm[i],
                             conv_w[i], attn_out_norm[i], conv_out_norm[i], w_mix_out[i])
        h = h + 0.5 * swiglu(rmsnorm(h, ffn2_norm[i]), ffn2_w_in[i], ffn2_w_out[i])
        h = rmsnorm(h, final_norm[i])
    return h[:, N_META:]
```

```cpp
#include <hip/hip_runtime.h>
#include <hip/hip_cooperative_groups.h>
#include <cstdio>
#include <cstdint>
#include <cmath>
namespace cg = cooperative_groups;
namespace pg8 {
#define PG8_LAS __attribute__((address_space(3)))
typedef unsigned short bf16_t;
typedef short bf16x8 __attribute__((ext_vector_type(8)));
typedef float f32x4 __attribute__((ext_vector_type(4)));
typedef unsigned u32x4 __attribute__((ext_vector_type(4)));
constexpr int BM = 256, BK = 64, HALF = 128, HTB = HALF * BK * 2  , STAGE_BYTES = 8 * HTB, NXCD = 8, WGM = 8;

__host__ __device__ __forceinline__ int lds_byte(int r, int c) { const int st = (r >> 4) * 2 + (c >> 5), rr = r & 15, cc = c & 31, ob = rr * 64 + cc * 2; return st * 1024 + (ob ^ (((ob >> 9) & 1) << 5)); }
__host__ __device__ __forceinline__ void stage_rc(int b, int& R, int& C) { const int st = b / 1024, sb = b % 1024, swz = sb ^ (((sb >> 9) & 1) << 5); R = (st >> 1) * 16 + swz / 64; C = (st & 1) * 32 + (swz % 64) / 2; }
__host__ __device__ __forceinline__ int perm32(int rho) { const int n = rho >> 4, i = rho & 15; return 8 * (i >> 2) + 4 * n + (i & 3); }

struct Unit { int pm, pn; };
struct Gemm { const bf16_t* A; const bf16_t* Bt; int M, N, K; };

struct StaticOrder {
    int nM, nN, nwg, G, c;
    __host__ __device__ void init(int M, int N, int G_, int c_) { nM = M / BM; nN = N / BM; nwg = nM * nN; G = G_; c = c_; }
    __host__ __device__ bool next(int i, Unit& u) const {
        const long L = (long)i * G + c; if (L >= nwg) return false;
        int wgid = (int)L; { const int q = nwg / NXCD, r = nwg % NXCD, xcd = wgid % NXCD, off = wgid / NXCD; wgid = (xcd < r ? xcd * (q + 1) : r * (q + 1) + (xcd - r) * q) + off; }
        const int nig = WGM * nN, gid = wgid / nig, fm = gid * WGM, gsz = (nM - fm) < WGM ? (nM - fm) : WGM;
        u.pm = fm + ((wgid % nig) % gsz); u.pn = (wgid % nig) / gsz; return true;
    }
    __device__ __forceinline__ void a_ready(const Unit&) const {}
    __device__ __forceinline__ void done(const Unit&) const {}
};

__device__ __forceinline__ unsigned cvt_pk_bf16(float lo, float hi) { unsigned r; asm volatile("v_cvt_pk_bf16_f32 %0, %1, %2" : "=v"(r) : "v"(lo), "v"(hi)); return r; }
typedef float f32x2 __attribute__((ext_vector_type(2)));
template <class Epi, class Sched, bool ALIGN_EPI = false, bool SP2 = false>
__device__ __forceinline__ void gemm_phase(PG8_LAS unsigned char* lds, const Gemm g, const Sched& S, const Epi& E) {
    const int tid = threadIdx.x, wid = __builtin_amdgcn_readfirstlane(tid >> 6), lane = tid & 63, wr = wid >> 2, wc = wid & 3, fr = lane & 15, fq = lane >> 4;
    const int K = g.K, nt = K / BK;
    unsigned voffA[2], voffB[2];
#pragma unroll
    for (int i = 0; i < 2; ++i) { int R, C; stage_rc(tid * 16 + i * 8192, R, C); const int Rb = Epi::PERM ? ((R & ~31) + perm32(R & 31)) : R;
        voffA[i] = (unsigned)(R * K + C) * 2u; voffB[i] = (unsigned)(Rb * K + C) * 2u; }
    const size_t kstep = (size_t)(BK * 2);
    const size_t hstep = (size_t)HALF * K * 2;
    const size_t tstep = 2 * hstep;
    const unsigned ldsw = (unsigned)wid * 1024u;
    const int aoff = lds_byte(wr * 64 + fr, fq * 8), boff = lds_byte(wc * 32 + fr, fq * 8);
#define PG8_SA(b, h) (((b) * 2 + (h)) * HTB)
#define PG8_SB(b, h) ((4 + (b) * 2 + (h)) * HTB)
#define PG8_STAGE(bufoff, gbase, voff) do { _Pragma("unroll") for (int _i = 0; _i < 2; ++_i) \
        __builtin_amdgcn_global_load_lds((const unsigned*)((const char*)(gbase) + (voff)[_i]), (PG8_LAS unsigned*)(lds + (bufoff) + ldsw + _i * 8192), 16, 0, 0); } while (0)
#define PG8_LDA(dst, b, h) do { _Pragma("unroll") for (int m = 0; m < 4; ++m) _Pragma("unroll") for (int k = 0; k < 2; ++k) dst[m][k] = *(const PG8_LAS bf16x8*)(lds + PG8_SA(b, h) + aoff + m * 2048 + k * 1024); } while (0)
#define PG8_LDB(dst, b, h) do { _Pragma("unroll") for (int n = 0; n < 2; ++n) _Pragma("unroll") for (int k = 0; k < 2; ++k) dst[n][k] = *(const PG8_LAS bf16x8*)(lds + PG8_SB(b, h) + boff + n * 2048 + k * 1024); } while (0)
#define PG8_MMA(ai, bj, At, Bt) do { __builtin_amdgcn_s_setprio(1); _Pragma("unroll") for (int m = 0; m < 4; ++m) _Pragma("unroll") for (int n = 0; n < 2; ++n) _Pragma("unroll") for (int k = 0; k < 2; ++k) \
        acc[ai][bj][m][n] = __builtin_amdgcn_mfma_f32_16x16x32_bf16(Bt[n][k], At[m][k], acc[ai][bj][m][n], 0, 0, 0); __builtin_amdgcn_s_setprio(0); } while (0)
#define PG8_WAIT_V(n) asm volatile("s_waitcnt vmcnt(" #n ")" ::: "memory")
#define PG8_WAIT_L(n) asm volatile("s_waitcnt lgkmcnt(" #n ")" ::: "memory")
#define PG8_BAR __builtin_amdgcn_s_barrier()
#define PG8_SCHED __builtin_amdgcn_sched_barrier(0)
    Unit cur, nxt; int ui = 0;
    if (!S.next(0, cur)) return;
    f32x4 acc[2][2][4][2];
#pragma unroll
    for (int a = 0; a < 2; ++a)
#pragma unroll
        for (int b = 0; b < 2; ++b)
#pragma unroll
            for (int m = 0; m < 4; ++m)
#pragma unroll
                for (int n = 0; n < 2; ++n) acc[a][b][m][n] = (f32x4){0.f, 0.f, 0.f, 0.f};
    bf16x8 At[4][2], B0[2][2], B1[2][2];
    const char* cA = (const char*)g.A + (size_t)cur.pm * tstep; const char* cB = (const char*)g.Bt + (size_t)cur.pn * tstep;
    S.a_ready(cur);
    if constexpr (SP2) {
        PG8_STAGE(PG8_SB(0, 0), cB, voffB); PG8_STAGE(PG8_SB(0, 1), cB + hstep, voffB); PG8_STAGE(PG8_SA(0, 0), cA, voffA); PG8_STAGE(PG8_SA(0, 1), cA + hstep, voffA);
        if (wr == 1) PG8_BAR;
        PG8_WAIT_V(2); PG8_BAR;
        PG8_STAGE(PG8_SB(1, 0), cB + kstep, voffB); PG8_STAGE(PG8_SA(1, 0), cA + kstep, voffA); PG8_STAGE(PG8_SB(1, 1), cB + hstep + kstep, voffB);
        PG8_WAIT_V(6); PG8_BAR;
    } else {
        PG8_STAGE(PG8_SB(0, 0), cB, voffB); PG8_STAGE(PG8_SA(0, 0), cA, voffA); PG8_STAGE(PG8_SB(0, 1), cB + hstep, voffB); PG8_STAGE(PG8_SA(0, 1), cA + hstep, voffA);
        if (wr == 1) PG8_BAR;
        PG8_WAIT_V(4); PG8_BAR;
        PG8_STAGE(PG8_SB(1, 0), cB + kstep, voffB); PG8_STAGE(PG8_SA(1, 0), cA + kstep, voffA); PG8_STAGE(PG8_SB(1, 1), cB + hstep + kstep, voffB);
        PG8_WAIT_V(6); PG8_BAR;
    }
    for (;;) {
        const bool has_next = S.next(ui + 1, nxt);
        const char* nA = has_next ? (const char*)g.A + (size_t)nxt.pm * tstep : cA; const char* nB = has_next ? (const char*)g.Bt + (size_t)nxt.pn * tstep : cB;
        for (int t = 0; t < nt; t += 2) {
            const bool last = (t == nt - 2);
            const char* a1 = cA + (size_t)(t + 1) * kstep;
            const char* a2 = last ? nA : cA + (size_t)(t + 2) * kstep; const char* b2 = last ? nB : cB + (size_t)(t + 2) * kstep;
            const char* a3 = a2 + kstep; const char* b3 = b2 + kstep;
            if (last && has_next) S.a_ready(nxt);
            if constexpr (SP2) {
            PG8_LDB(B0, 0, 0); PG8_LDB(B1, 0, 1); PG8_SCHED; PG8_LDA(At, 0, 0); PG8_STAGE(PG8_SA(1, 1), a1 + hstep, voffA);
            PG8_WAIT_V(8); PG8_WAIT_L(0); PG8_BAR; PG8_MMA(0, 0, At, B0); PG8_MMA(0, 1, At, B1); PG8_BAR; PG8_SCHED;
            PG8_LDA(At, 0, 1); PG8_STAGE(PG8_SB(0, 0), b2, voffB); PG8_STAGE(PG8_SB(0, 1), b2 + hstep, voffB); PG8_STAGE(PG8_SA(0, 0), a2, voffA);
            PG8_WAIT_V(8); PG8_WAIT_L(0); PG8_BAR; PG8_MMA(1, 0, At, B0); PG8_MMA(1, 1, At, B1); PG8_BAR; PG8_SCHED;
            PG8_LDB(B0, 1, 0); PG8_LDB(B1, 1, 1); PG8_SCHED; PG8_LDA(At, 1, 0); PG8_STAGE(PG8_SA(0, 1), a2 + hstep, voffA);
            PG8_WAIT_V(8); PG8_WAIT_L(0); PG8_BAR; PG8_MMA(0, 0, At, B0); PG8_MMA(0, 1, At, B1); PG8_BAR; PG8_SCHED;
            PG8_LDA(At, 1, 1); PG8_STAGE(PG8_SB(1, 0), b3, voffB); PG8_STAGE(PG8_SB(1, 1), b3 + hstep, voffB); PG8_STAGE(PG8_SA(1, 0), a3, voffA);
            PG8_WAIT_V(8); PG8_WAIT_L(0); PG8_BAR; PG8_MMA(1, 0, At, B0); PG8_MMA(1, 1, At, B1); PG8_BAR; PG8_SCHED;
            } else {
            PG8_LDB(B0, 0, 0); PG8_SCHED; PG8_LDA(At, 0, 0); PG8_STAGE(PG8_SA(1, 1), a1 + hstep, voffA);
            PG8_WAIT_L(8); PG8_BAR; PG8_WAIT_L(0); PG8_MMA(0, 0, At, B0); PG8_BAR; PG8_SCHED;
            PG8_LDB(B1, 0, 1); PG8_STAGE(PG8_SB(0, 0), b2, voffB);
            PG8_BAR; PG8_WAIT_L(0); PG8_MMA(0, 1, At, B1); PG8_BAR;
            PG8_LDA(At, 0, 1); PG8_STAGE(PG8_SA(0, 0), a2, voffA);
            PG8_BAR; PG8_WAIT_L(0); PG8_MMA(1, 0, At, B0); PG8_BAR; PG8_SCHED;
            PG8_STAGE(PG8_SB(0, 1), b2 + hstep, voffB);
            PG8_WAIT_V(6); PG8_BAR; PG8_MMA(1, 1, At, B1); PG8_BAR;
            PG8_LDB(B0, 1, 0); PG8_SCHED; PG8_LDA(At, 1, 0); PG8_STAGE(PG8_SA(0, 1), a2 + hstep, voffA);
            PG8_WAIT_L(8); PG8_BAR; PG8_WAIT_L(0); PG8_MMA(0, 0, At, B0); PG8_BAR; PG8_SCHED;
            PG8_LDB(B1, 1, 1); PG8_STAGE(PG8_SB(1, 0), b3, voffB);
            PG8_BAR; PG8_WAIT_L(0); PG8_MMA(0, 1, At, B1); PG8_BAR;
            PG8_LDA(At, 1, 1); PG8_STAGE(PG8_SA(1, 0), a3, voffA);
            PG8_BAR; PG8_WAIT_L(0); PG8_MMA(1, 0, At, B0); PG8_BAR; PG8_SCHED;
            PG8_STAGE(PG8_SB(1, 1), b3 + hstep, voffB);
            PG8_WAIT_V(6); PG8_BAR; PG8_MMA(1, 1, At, B1); PG8_BAR;
            }
        }
        if constexpr (ALIGN_EPI) { if (wr == 0) PG8_BAR; }
        if constexpr (!Epi::AFTER_DRAIN) { E(acc, cur, wr, wc, fr, fq); S.done(cur); }
        if (!has_next) break;
#pragma unroll
        for (int a = 0; a < 2; ++a)
#pragma unroll
            for (int b = 0; b < 2; ++b)
#pragma unroll
                for (int m = 0; m < 4; ++m)
#pragma unroll
                    for (int n = 0; n < 2; ++n) acc[a][b][m][n] = (f32x4){0.f, 0.f, 0.f, 0.f};
        cur = nxt; cA = nA; cB = nB; ++ui;
        if constexpr (ALIGN_EPI) { if (wr == 1) PG8_BAR; }
    }
    PG8_WAIT_V(0);
    if constexpr (!ALIGN_EPI) { if (wr == 0) PG8_BAR; }
    PG8_BAR;
    if constexpr (Epi::AFTER_DRAIN) { E.fused(acc, cur, wr, wc, fr, fq, lds, wid, lane); S.done(cur); }
#undef PG8_SA
#undef PG8_SB
#undef PG8_STAGE
#undef PG8_LDA
#undef PG8_LDB
#undef PG8_MMA
#undef PG8_WAIT_V
#undef PG8_WAIT_L
#undef PG8_BAR
#undef PG8_SCHED
}
}

using pg8::bf16_t; using pg8::bf16x8; using pg8::f32x4; using pg8::u32x4;
typedef float f32x16 __attribute__((ext_vector_type(16)));
typedef unsigned u32x2 __attribute__((ext_vector_type(2)));
#define LAS __attribute__((address_space(3)))
constexpr int D = 1024, BATCH = 4, SEQ = 8192, DFF = 2816, DH = 512, NH = 8;
constexpr int M = BATCH * SEQ;
constexpr int MP = M + 256;
constexpr int NMI = 3328;
constexpr float EPS = 1e-6f, LOG2E = 1.4426950408889634f;
constexpr int NWAVES = 8, LDS_BYTES = 147456;

constexpr size_t MiB = 1u << 20;
constexpr size_t WS_W1 = 2 * MiB, WS_W1O = 13 * MiB, WS_WMI = 19 * MiB, WS_WMO = 26 * MiB, WS_W2 = 28 * MiB, WS_W2O = 39 * MiB;
constexpr size_t WS_PART = 45 * MiB, PART_STRIDE = 2304 * 1024;
constexpr size_t WS_LOGF = 54 * MiB;
constexpr size_t WS_RESM = 56 * MiB;
constexpr size_t WS_XA = 58 * MiB;
constexpr size_t WS_XB = 123 * MiB;
constexpr size_t WS_ACT = 187 * MiB;
constexpr size_t QKV_STRIDE = (size_t)MP * DH * 2;
constexpr size_t WS_END = WS_ACT + (size_t)MP * DFF * 2;
static_assert(5 * QKV_STRIDE <= (size_t)MP * DFF * 2, "P3 outputs overlay the activation buffer");
static_assert((size_t)MP * 16 * 4 <= PART_STRIDE && WS_PART + 4 * PART_STRIDE <= WS_LOGF, "ws map");

__device__ __forceinline__ unsigned cvtpk(float lo, float hi) { return pg8::cvt_pk_bf16(lo, hi); }
__device__ __forceinline__ float bf_lo(unsigned u) { return __uint_as_float(u << 16); }
__device__ __forceinline__ float bf_hi(unsigned u) { return __uint_as_float(u & 0xffff0000u); }
__device__ __forceinline__ float wave_sum(float v) {
#pragma unroll
    for (int o = 1; o < 64; o <<= 1) v += __shfl_xor(v, o);
    return v;
}
__device__ __forceinline__ float row_rstd(const float* part, int row) {
    const f32x4* p = (const f32x4*)(part + (size_t)row * 16);
    const f32x4 a = p[0], b = p[1], c = p[2], d = p[3];
    const f32x4 s = (a + b) + (c + d);
    const float t = (s[0] + s[1]) + (s[2] + s[3]);
    return 1.0f / sqrtf(t * (1.0f / 1024.0f) + EPS);
}


struct EpiSwiGLU {
    static constexpr bool PERM = true, AFTER_DRAIN = false;
    bf16_t* O; const float* part;
    __device__ __forceinline__ void operator()(const f32x4 (&acc)[2][2][4][2], const pg8::Unit& u, int wr, int wc, int fr, int fq) const {
        const int row0 = u.pm * 256 + wr * 64 + fr, col0 = u.pn * 128 + wc * 32 + 8 * fq;
#pragma unroll
        for (int ai = 0; ai < 2; ++ai)
#pragma unroll
            for (int m = 0; m < 4; ++m) {
                const int row = row0 + ai * 128 + m * 16; const float rs = row_rstd(part, row);
                float a[8];
#pragma unroll
                for (int n = 0; n < 2; ++n)
#pragma unroll
                    for (int i = 0; i < 4; ++i) { const float g = acc[ai][0][m][n][i] * rs, up = acc[ai][1][m][n][i] * rs;
                        const float sg = __builtin_amdgcn_rcpf(1.0f + __builtin_amdgcn_exp2f(-g * LOG2E)); a[n * 4 + i] = g * sg * up; }
                u32x4 w; w.x = cvtpk(a[0], a[1]); w.y = cvtpk(a[2], a[3]); w.z = cvtpk(a[4], a[5]); w.w = cvtpk(a[6], a[7]);
                *(u32x4*)(O + (size_t)row * DFF + col0) = w;
            }
    }
};

template <bool HAS_HB> struct EpiResid {
    static constexpr bool PERM = true, AFTER_DRAIN = false;
    const float* res; const float* resm; float* out; bf16_t* hb; float* part; float alpha;
    __device__ __forceinline__ void operator()(const f32x4 (&acc)[2][2][4][2], const pg8::Unit& u, int wr, int wc, int fr, int fq) const {
        const int row0 = u.pm * 256 + wr * 64 + fr, col0 = u.pn * 256 + wc * 32 + 8 * fq;
        const bool meta = u.pm >= M / 256;
#pragma unroll
        for (int ai = 0; ai < 2; ++ai)
#pragma unroll
            for (int m = 0; m < 4; ++m) {
                const int row = row0 + ai * 128 + m * 16;
                const float* rp = meta ? resm + (size_t)(row - M) * D : res + (size_t)row * D;
                float ss = 0.f;
#pragma unroll
                for (int bj = 0; bj < 2; ++bj) { const int c = col0 + 128 * bj;
                    const f32x4 r0 = *(const f32x4*)(rp + c), r1 = *(const f32x4*)(rp + c + 4);
                    const f32x4 v0 = r0 + acc[ai][bj][m][0] * alpha, v1 = r1 + acc[ai][bj][m][1] * alpha;
                    if (!meta) { float* op = out + (size_t)row * D + c; *(f32x4*)op = v0; *(f32x4*)(op + 4) = v1; }
                    if (HAS_HB) { u32x4 w; w.x = cvtpk(v0[0], v0[1]); w.y = cvtpk(v0[2], v0[3]); w.z = cvtpk(v1[0], v1[1]); w.w = cvtpk(v1[2], v1[3]);
                        *(u32x4*)(hb + (size_t)row * D + c) = w; }
                    ss += (v0[0] * v0[0] + v0[1] * v0[1]) + (v0[2] * v0[2] + v0[3] * v0[3]) + (v1[0] * v1[0] + v1[1] * v1[1]) + (v1[2] * v1[2] + v1[3] * v1[3]); }
                ss += __shfl_xor(ss, 16); ss += __shfl_xor(ss, 32);
                if (fq == 0) part[(size_t)row * 16 + u.pn * 4 + wc] = ss;
            }
    }
};

struct EpiMixIn {
    static constexpr bool PERM = true, AFTER_DRAIN = false;
    bf16_t *Q, *K, *V, *B, *Z; float* logfT; const float* part; const float *qn, *kn, *bfg;
    __device__ __forceinline__ void operator()(const f32x4 (&acc)[2][2][4][2], const pg8::Unit& u, int wr, int wc, int fr, int fq) const {
        const int row0 = u.pm * 256 + wr * 64 + fr, pn = u.pn;
        if (pn < 4) {
            const float* gp = (pn < 2 ? qn : kn) + 8 * fq; bf16_t* base = pn < 2 ? Q : K; const float sc = pn < 2 ? 0.125f * LOG2E : 1.0f;
            const int head = (pn & 1) * 4 + wc;
            float g[2][8];
#pragma unroll
            for (int bj = 0; bj < 2; ++bj)
#pragma unroll
                for (int i = 0; i < 8; ++i) g[bj][i] = gp[bj * 32 + i] * sc;
#pragma unroll
            for (int ai = 0; ai < 2; ++ai)
#pragma unroll
                for (int m = 0; m < 4; ++m) {
                    const int row = row0 + ai * 128 + m * 16; const float rs = row_rstd(part, row);
                    float a[2][8]; float ss = 0.f;
#pragma unroll
                    for (int bj = 0; bj < 2; ++bj)
#pragma unroll
                        for (int i = 0; i < 8; ++i) { a[bj][i] = acc[ai][bj][m][i >> 2][i & 3] * rs; ss += a[bj][i] * a[bj][i]; }
                    ss += __shfl_xor(ss, 16); ss += __shfl_xor(ss, 32);
                    const float rr = 1.0f / sqrtf(ss * (1.0f / 64.0f) + EPS);
#pragma unroll
                    for (int bj = 0; bj < 2; ++bj) { u32x4 w;
                        w.x = cvtpk(a[bj][0] * rr * g[bj][0], a[bj][1] * rr * g[bj][1]); w.y = cvtpk(a[bj][2] * rr * g[bj][2], a[bj][3] * rr * g[bj][3]);
                        w.z = cvtpk(a[bj][4] * rr * g[bj][4], a[bj][5] * rr * g[bj][5]); w.w = cvtpk(a[bj][6] * rr * g[bj][6], a[bj][7] * rr * g[bj][7]);
                        *(u32x4*)(base + (size_t)row * DH + head * 64 + bj * 32 + 8 * fq) = w; }
                }
        } else if (pn < 8) {
            bf16_t* base = pn < 6 ? V : B; const int col0 = (pn & 1) * 256 + wc * 32 + 8 * fq;
#pragma unroll
            for (int ai = 0; ai < 2; ++ai)
#pragma unroll
                for (int m = 0; m < 4; ++m) {
                    const int row = row0 + ai * 128 + m * 16; const float rs = row_rstd(part, row);
#pragma unroll
                    for (int bj = 0; bj < 2; ++bj) { const f32x4 v0 = acc[ai][bj][m][0] * rs, v1 = acc[ai][bj][m][1] * rs; u32x4 w;
                        w.x = cvtpk(v0[0], v0[1]); w.y = cvtpk(v0[2], v0[3]); w.z = cvtpk(v1[0], v1[1]); w.w = cvtpk(v1[2], v1[3]);
                        *(u32x4*)(base + (size_t)row * DH + col0 + 128 * bj) = w; }
                }
        } else if (pn < 12) {
            const int col0 = (pn - 8) * 128 + wc * 32 + 8 * fq;
#pragma unroll
            for (int ai = 0; ai < 2; ++ai)
#pragma unroll
                for (int m = 0; m < 4; ++m) {
                    const int row = row0 + ai * 128 + m * 16; const float rs = row_rstd(part, row); const float r2 = rs * rs;
                    const f32x4 v0 = acc[ai][0][m][0] * acc[ai][1][m][0] * r2, v1 = acc[ai][0][m][1] * acc[ai][1][m][1] * r2; u32x4 w;
                    w.x = cvtpk(v0[0], v0[1]); w.y = cvtpk(v0[2], v0[3]); w.z = cvtpk(v1[0], v1[1]); w.w = cvtpk(v1[2], v1[3]);
                    *(u32x4*)(Z + (size_t)row * DH + col0) = w;
                }
        } else {
            if (wc == 0 && fq == 0) {
                float bf[8];
#pragma unroll
                for (int i = 0; i < 8; ++i) bf[i] = bfg[i];
#pragma unroll
                for (int ai = 0; ai < 2; ++ai)
#pragma unroll
                    for (int m = 0; m < 4; ++m) {
                        const int row = row0 + ai * 128 + m * 16; const float rs = row_rstd(part, row);
#pragma unroll
                        for (int i = 0; i < 8; ++i) { const float x = acc[ai][0][m][i >> 2][i & 3] * rs + bf[i];
                            const float ls = fminf(x, 0.f) - __logf(1.0f + __expf(-fabsf(x)));
                            logfT[(size_t)i * MP + row] = ls; }
                    }
            }
        }
    }
};

__device__ __forceinline__ void conv_item(const float* W, int N, int K, bf16_t* WT, int dr0, int sc0, int nvalid, const float* ks, int kb, LAS float* scr, int lane) {
    const int k0 = 64 * kb, n = lane & 31;
#pragma unroll 8
    for (int i = 0; i < 32; ++i) { const int kk = 2 * i + (lane >> 5);
        float v = 0.f; if (n < nvalid) { v = W[(size_t)(k0 + kk) * N + sc0 + n]; if (ks) v *= ks[k0 + kk]; }
        scr[kk * 33 + n] = v; }
    asm volatile("s_waitcnt lgkmcnt(0)" ::: "memory");
    const int c = lane & 7;
#pragma unroll
    for (int j = 0; j < 4; ++j) { const int nn = (lane >> 3) + 8 * j; const LAS float* s = scr + (8 * c) * 33 + nn;
        u32x4 o; o.x = cvtpk(s[0 * 33], s[1 * 33]); o.y = cvtpk(s[2 * 33], s[3 * 33]); o.z = cvtpk(s[4 * 33], s[5 * 33]); o.w = cvtpk(s[6 * 33], s[7 * 33]);
        *(u32x4*)(WT + (size_t)(dr0 + nn) * K + k0 + 8 * c) = o; }
    asm volatile("s_waitcnt lgkmcnt(0)" ::: "memory");
}

struct Args { const float* in[18]; float* out; unsigned char* ws; };
enum { I_X = 0, I_META, I_F1N, I_F1WI, I_F1WO, I_MIXN, I_WMI, I_BF, I_QN, I_KN, I_CW, I_AON, I_CON, I_WMO, I_F2N, I_F2WI, I_F2WO, I_FN };

__device__ __forceinline__ void p0_prologue(const Args& a, LAS unsigned char* lds, int gw, int NGW, int wave, int lane) {
    unsigned char* ws = a.ws;
    LAS float* scr = (LAS float*)(lds + wave * 16384);
    constexpr int I_IN = (2 * DFF / 32) * (D / 64), I_OUT = (D / 32) * (DFF / 64), I_MI = (NMI / 32) * (D / 64), I_MO = (D / 32) * (D / 64);
    constexpr int NITEMS = 2 * I_IN + 2 * I_OUT + I_MI + I_MO;
    for (int it = gw; it < NITEMS; it += NGW) {
        int r = it;
        if (r < 2 * I_IN) { const int which = r >= I_IN; r -= which * I_IN; const int nblk = 2 * DFF / 32, kb = r / nblk, dr0 = (r % nblk) * 32;
            const int pn = dr0 >> 8, within = dr0 & 255, bj = within >> 7, i0 = within & 127;
            conv_item(a.in[which ? I_F2WI : I_F1WI], 2 * DFF, D, (bf16_t*)(ws + (which ? WS_W2 : WS_W1)), dr0, bj * DFF + pn * 128 + i0, 32, a.in[which ? I_F2N : I_F1N], kb, scr, lane); continue; }
        r -= 2 * I_IN;
        if (r < 2 * I_OUT) { const int which = r >= I_OUT; r -= which * I_OUT; const int nblk = D / 32, kb = r / nblk, dr0 = (r % nblk) * 32;
            conv_item(a.in[which ? I_F2WO : I_F1WO], D, DFF, (bf16_t*)(ws + (which ? WS_W2O : WS_W1O)), dr0, dr0, 32, nullptr, kb, scr, lane); continue; }
        r -= 2 * I_OUT;
        if (r < I_MI) { const int nblk = NMI / 32, kb = r / nblk, dr0 = (r % nblk) * 32;
            const int pn = dr0 >> 8, within = dr0 & 255, bj = within >> 7, i0 = within & 127, wcw = i0 >> 5;
            int sc0, nv = 32;
            if (pn < 4) sc0 = (pn >> 1) * 512 + ((pn & 1) * 4 + wcw) * 64 + bj * 32;
            else if (pn < 6) sc0 = dr0;
            else if (pn < 8) sc0 = 1544 + (dr0 - 1536);
            else if (pn < 12) sc0 = (bj ? 2568 : 2056) + 128 * (pn - 8) + i0;
            else { sc0 = 1536; nv = (dr0 == 3072) ? 8 : 0; }
            conv_item(a.in[I_WMI], 3080, D, (bf16_t*)(ws + WS_WMI), dr0, sc0, nv, a.in[I_MIXN], kb, scr, lane); continue; }
        r -= I_MI;
        { const int nblk = D / 32, kb = r / nblk, dr0 = (r % nblk) * 32;
          const float* ks = (kb < 8) ? a.in[I_AON] : a.in[I_CON] - 512;
          conv_item(a.in[I_WMO], D, D, (bf16_t*)(ws + WS_WMO), dr0, dr0, 32, ks, kb, scr, lane); }
    }
    bf16_t* XA = (bf16_t*)(ws + WS_XA); float* part0 = (float*)(ws + WS_PART); float* resm = (float*)(ws + WS_RESM);
    for (int row = gw; row < MP; row += NGW) {
        const float* src = row < M ? a.in[I_X] + (size_t)row * D : (row < M + 16 ? a.in[I_META] + (size_t)(row - M) * D : nullptr);
        f32x4 v[4]; float ss = 0.f;
#pragma unroll
        for (int j = 0; j < 4; ++j) { v[j] = src ? ((const f32x4*)src)[lane + 64 * j] : (f32x4){0.f, 0.f, 0.f, 0.f}; ss += (v[j][0] * v[j][0] + v[j][1] * v[j][1]) + (v[j][2] * v[j][2] + v[j][3] * v[j][3]); }
        ss = wave_sum(ss);
#pragma unroll
        for (int j = 0; j < 4; ++j) { u32x2 w; w.x = cvtpk(v[j][0], v[j][1]); w.y = cvtpk(v[j][2], v[j][3]); *(u32x2*)(XA + (size_t)row * D + 4 * (lane + 64 * j)) = w; }
        if (lane < 16) part0[(size_t)row * 16 + lane] = lane == 0 ? ss : 0.f;
        if (row >= M) {
#pragma unroll
            for (int j = 0; j < 4; ++j) ((f32x4*)(resm + (size_t)(row - M) * D))[lane + 64 * j] = v[j]; }
    }
}

struct MixP { const bf16_t *Q, *K, *V, *B, *Z; const float* logfT; const float* cw; bf16_t* out; float thresh; };

__device__ __forceinline__ void mixer_unit(const MixP& p, int b, int t0, LAS unsigned char* lds, int wave, int lane) {
    const int r32 = lane & 31, hi = lane >> 5, h = wave;
    LAS float* sc = (LAS float*)lds + wave * 64;
    LAS float* ssq = (LAS float*)(lds + 4096);
    const size_t rowq = (size_t)b * SEQ + t0;
    bf16x8 qf[4];
    { const bf16_t* qp = p.Q + (rowq + r32) * DH + h * 64 + 8 * hi;
#pragma unroll
      for (int ks = 0; ks < 4; ++ks) qf[ks] = *(const bf16x8*)(qp + 16 * ks); }
    float mrun = -INFINITY, l = 0.f; f32x16 o0, o1;
#pragma unroll
    for (int r = 0; r < 16; ++r) { o0[r] = 0.f; o1[r] = 0.f; }
    const int jd = t0 >> 6, T0 = jd << 6;
    float base = 0.f;
    for (int j = jd; j >= -1; --j) {
        if (j < jd && base < -p.thresh) break;
        const int nvalid = j >= 0 ? 64 : 16;
        const size_t krow0 = j >= 0 ? (size_t)b * SEQ + 64 * j : (size_t)M;
        const float Lv = lane < nvalid ? p.logfT[(size_t)h * MP + krow0 + lane] * LOG2E : 0.f;
        float P = Lv;
#pragma unroll
        for (int o = 1; o < 64; o <<= 1) { const float t = __shfl_up(P, o); if (lane >= o) P += t; }
        const float tot = __int_as_float(__builtin_amdgcn_readlane(__float_as_int(P), 63));
        const float p31 = __int_as_float(__builtin_amdgcn_readlane(__float_as_int(P), 31));
        const float bj = (j == jd) ? ((t0 > T0) ? p31 : 0.f) : base + tot;
        sc[lane] = bj - P; base = bj;
        f32x16 s0, s1;
#pragma unroll
        for (int r = 0; r < 16; ++r) { s0[r] = 0.f; s1[r] = 0.f; }
        { const bf16_t* kp = p.K + (krow0 + r32) * DH + h * 64 + 8 * hi;
#pragma unroll
          for (int ks = 0; ks < 4; ++ks) { const bf16x8 k0 = *(const bf16x8*)(kp + 16 * ks), k1 = *(const bf16x8*)(kp + 32 * DH + 16 * ks);
              s0 = __builtin_amdgcn_mfma_f32_32x32x16_bf16(k0, qf[ks], s0, 0, 0, 0); s1 = __builtin_amdgcn_mfma_f32_32x32x16_bf16(k1, qf[ks], s1, 0, 0, 0); } }
        asm volatile("s_waitcnt lgkmcnt(0)" ::: "memory");
#pragma unroll
        for (int g = 0; g < 4; ++g) { const f32x4 b0 = *(const LAS f32x4*)(sc + 8 * g + 4 * hi), b1 = *(const LAS f32x4*)(sc + 32 + 8 * g + 4 * hi);
#pragma unroll
            for (int i = 0; i < 4; ++i) { s0[4 * g + i] += b0[i]; s1[4 * g + i] += b1[i]; } }
        if (j == jd) { const int qa = t0 + r32 - T0;
#pragma unroll
            for (int r = 0; r < 16; ++r) { const int key = (r & 3) + 8 * (r >> 2) + 4 * hi; if (key > qa) s0[r] = -INFINITY; if (key + 32 > qa) s1[r] = -INFINITY; } }
        if (j < 0) {
#pragma unroll
            for (int r = 0; r < 16; ++r) { const int key = (r & 3) + 8 * (r >> 2) + 4 * hi; if (key >= 16) s0[r] = -INFINITY; s1[r] = -INFINITY; } }
        float mt = fmaxf(s0[0], s1[0]);
#pragma unroll
        for (int r = 1; r < 16; ++r) mt = fmaxf(mt, fmaxf(s0[r], s1[r]));
        mt = fmaxf(mt, __shfl_xor(mt, 32));
        const float mn = fmaxf(mrun, mt), al = __builtin_amdgcn_exp2f(mrun - mn); mrun = mn;
        float ps = 0.f;
#pragma unroll
        for (int r = 0; r < 16; ++r) { s0[r] = __builtin_amdgcn_exp2f(s0[r] - mn); s1[r] = __builtin_amdgcn_exp2f(s1[r] - mn); ps += s0[r] + s1[r]; }
        l = l * al + ps;
#pragma unroll
        for (int r = 0; r < 16; ++r) { o0[r] *= al; o1[r] *= al; }
#pragma unroll
        for (int g4 = 0; g4 < 4; ++g4) {
            const int sub = g4 & 1; u32x4 pw;
            if (g4 < 2) { pw.x = cvtpk(s0[8 * sub + 0], s0[8 * sub + 1]); pw.y = cvtpk(s0[8 * sub + 2], s0[8 * sub + 3]); pw.z = cvtpk(s0[8 * sub + 4], s0[8 * sub + 5]); pw.w = cvtpk(s0[8 * sub + 6], s0[8 * sub + 7]); }
            else        { pw.x = cvtpk(s1[8 * sub + 0], s1[8 * sub + 1]); pw.y = cvtpk(s1[8 * sub + 2], s1[8 * sub + 3]); pw.z = cvtpk(s1[8 * sub + 4], s1[8 * sub + 5]); pw.w = cvtpk(s1[8 * sub + 6], s1[8 * sub + 7]); }
            const bf16x8 pf = __builtin_bit_cast(bf16x8, pw);
            const bf16_t* vp = p.V + (krow0 + 16 * g4 + 4 * hi) * DH + h * 64 + r32;
            bf16x8 v0, v1;
#pragma unroll
            for (int i = 0; i < 4; ++i) { v0[i] = (short)vp[i * DH]; v0[4 + i] = (short)vp[(8 + i) * DH]; v1[i] = (short)vp[i * DH + 32]; v1[4 + i] = (short)vp[(8 + i) * DH + 32]; }
            o0 = __builtin_amdgcn_mfma_f32_32x32x16_bf16(v0, pf, o0, 0, 0, 0); o1 = __builtin_amdgcn_mfma_f32_32x32x16_bf16(v1, pf, o1, 0, 0, 0);
        }
    }
    l += __shfl_xor(l, 32);
    const float inv = 1.0f / l; float ss = 0.f;
#pragma unroll
    for (int r = 0; r < 16; ++r) { o0[r] *= inv; o1[r] *= inv; ss += o0[r] * o0[r] + o1[r] * o1[r]; }
    ss += __shfl_xor(ss, 32);
    if (hi == 0) ssq[r32 * 8 + h] = ss;
    { const int c0 = lane * 8;
      float w0[8], w1[8], w2[8];
#pragma unroll
      for (int i = 0; i < 8; ++i) { w0[i] = p.cw[c0 + i]; w1[i] = p.cw[DH + c0 + i]; w2[i] = p.cw[2 * DH + c0 + i]; }
#pragma unroll 1
      for (int rr = 0; rr < 4; ++rr) { const int t = t0 + wave + 8 * rr; const size_t row = (size_t)b * SEQ + t;
          const size_t row1 = t >= 1 ? row - 1 : (size_t)M + 15, row2 = t >= 2 ? row - 2 : (size_t)M + 14 + t;
          const u32x4 z0 = *(const u32x4*)(p.Z + row * DH + c0), z1 = *(const u32x4*)(p.Z + row1 * DH + c0), z2 = *(const u32x4*)(p.Z + row2 * DH + c0), bv = *(const u32x4*)(p.B + row * DH + c0);
          float y[8]; float s2 = 0.f;
#pragma unroll
          for (int i = 0; i < 4; ++i) {
              y[2 * i] = bf_lo(bv[i]) * (w0[2 * i] * bf_lo(z2[i]) + w1[2 * i] * bf_lo(z1[i]) + w2[2 * i] * bf_lo(z0[i]));
              y[2 * i + 1] = bf_hi(bv[i]) * (w0[2 * i + 1] * bf_hi(z2[i]) + w1[2 * i + 1] * bf_hi(z1[i]) + w2[2 * i + 1] * bf_hi(z0[i]));
              s2 += y[2 * i] * y[2 * i] + y[2 * i + 1] * y[2 * i + 1]; }
          s2 = wave_sum(s2); const float rs = 1.0f / sqrtf(s2 * (1.0f / 512.0f) + EPS);
          u32x4 w; w.x = cvtpk(y[0] * rs, y[1] * rs); w.y = cvtpk(y[2] * rs, y[3] * rs); w.z = cvtpk(y[4] * rs, y[5] * rs); w.w = cvtpk(y[6] * rs, y[7] * rs);
          *(u32x4*)(p.out + row * D + DH + c0) = w; } }
    __syncthreads();
    { const f32x4 a = *(const LAS f32x4*)(ssq + r32 * 8), c = *(const LAS f32x4*)(ssq + r32 * 8 + 4);
      const float tot = ((a[0] + a[1]) + (a[2] + a[3])) + ((c[0] + c[1]) + (c[2] + c[3]));
      const float rs = 1.0f / sqrtf(tot * (1.0f / 512.0f) + EPS);
      bf16_t* op = p.out + (rowq + r32) * D + h * 64 + 4 * hi;
#pragma unroll
      for (int g = 0; g < 4; ++g) { u32x2 w;
          w.x = cvtpk(o0[4 * g] * rs, o0[4 * g + 1] * rs); w.y = cvtpk(o0[4 * g + 2] * rs, o0[4 * g + 3] * rs); *(u32x2*)(op + 8 * g) = w;
          w.x = cvtpk(o1[4 * g] * rs, o1[4 * g + 1] * rs); w.y = cvtpk(o1[4 * g + 2] * rs, o1[4 * g + 3] * rs); *(u32x2*)(op + 32 + 8 * g) = w; } }
    __syncthreads();
}

__global__ void __launch_bounds__(NWAVES * 64, 2) fwd_mega(Args a) {
    extern __shared__ __attribute__((aligned(16))) unsigned char lds_raw[];
    LAS unsigned char* lds = (LAS unsigned char*)lds_raw;
    cg::grid_group grid = cg::this_grid();
    const int tid = threadIdx.x, lane = tid & 63, wave = __builtin_amdgcn_readfirstlane(tid >> 6);
    const int G = gridDim.x, bx = blockIdx.x;
    const int vcu = (G % 8 == 0) ? (bx % 8) * (G / 8) + bx / 8 : bx;
    const int gw = vcu * NWAVES + wave, NGW = G * NWAVES;
    unsigned char* ws = a.ws;
    bf16_t *W1 = (bf16_t*)(ws + WS_W1), *W1O = (bf16_t*)(ws + WS_W1O), *WMI = (bf16_t*)(ws + WS_WMI), *WMO = (bf16_t*)(ws + WS_WMO), *W2 = (bf16_t*)(ws + WS_W2), *W2O = (bf16_t*)(ws + WS_W2O);
    bf16_t *XA = (bf16_t*)(ws + WS_XA), *XB = (bf16_t*)(ws + WS_XB), *ACT = (bf16_t*)(ws + WS_ACT);
    bf16_t *Qb = ACT, *Kb = (bf16_t*)(ws + WS_ACT + QKV_STRIDE), *Vb = (bf16_t*)(ws + WS_ACT + 2 * QKV_STRIDE), *Bb = (bf16_t*)(ws + WS_ACT + 3 * QKV_STRIDE), *Zb = (bf16_t*)(ws + WS_ACT + 4 * QKV_STRIDE);
    float *part0 = (float*)(ws + WS_PART), *part1 = (float*)(ws + WS_PART + PART_STRIDE), *part2 = (float*)(ws + WS_PART + 2 * PART_STRIDE), *part3 = (float*)(ws + WS_PART + 3 * PART_STRIDE);
    float *logfT = (float*)(ws + WS_LOGF), *resm = (float*)(ws + WS_RESM);

    p0_prologue(a, lds, gw, NGW, wave, lane);
    grid.sync();
    { pg8::Gemm g{XA, W1, MP, 2 * DFF, D}; pg8::StaticOrder S; S.init(MP, 2 * DFF, G, bx); EpiSwiGLU E{ACT, part0};
      pg8::gemm_phase<EpiSwiGLU, pg8::StaticOrder, true, true>(lds, g, S, E); }
    grid.sync();
    { pg8::Gemm g{ACT, W1O, MP, D, DFF}; pg8::StaticOrder S; S.init(MP, D, G, bx); EpiResid<true> E{a.in[I_X], resm, a.out, XA, part1, 0.5f};
      pg8::gemm_phase<EpiResid<true>, pg8::StaticOrder, true, true>(lds, g, S, E); }
    grid.sync();
    { pg8::Gemm g{XA, WMI, MP, NMI, D}; pg8::StaticOrder S; S.init(MP, NMI, G, bx); EpiMixIn E{Qb, Kb, Vb, Bb, Zb, logfT, part1, a.in[I_QN], a.in[I_KN], a.in[I_BF]};
      pg8::gemm_phase<EpiMixIn, pg8::StaticOrder, true, true>(lds, g, S, E); }
    grid.sync();
    { float gq = fabsf(a.in[I_QN][lane]), gk = fabsf(a.in[I_KN][lane]);
#pragma unroll
      for (int o = 1; o < 64; o <<= 1) { gq = fmaxf(gq, __shfl_xor(gq, o)); gk = fmaxf(gk, __shfl_xor(gk, o)); }
      MixP mp{Qb, Kb, Vb, Bb, Zb, logfT, a.in[I_CW], XA, 2.0f * (8.0f * gq * gk * LOG2E * 1.05f) + 170.0f};
      constexpr int NU = M / 32;
      for (int u = vcu; u < NU; u += G) { const int b = u / (SEQ / 32), t0 = (u % (SEQ / 32)) * 32; mixer_unit(mp, b, t0, lds, wave, lane); } }
    grid.sync();
    { pg8::Gemm g{XA, WMO, M, D, D}; pg8::StaticOrder S; S.init(M, D, G, bx); EpiResid<true> E{a.out, resm, a.out, XB, part2, 1.0f};
      pg8::gemm_phase<EpiResid<true>, pg8::StaticOrder, true, true>(lds, g, S, E); }
    grid.sync();
    { pg8::Gemm g{XB, W2, M, 2 * DFF, D}; pg8::StaticOrder S; S.init(M, 2 * DFF, G, bx); EpiSwiGLU E{ACT, part2};
      pg8::gemm_phase<EpiSwiGLU, pg8::StaticOrder, true, true>(lds, g, S, E); }
    grid.sync();
    { pg8::Gemm g{ACT, W2O, M, D, DFF}; pg8::StaticOrder S; S.init(M, D, G, bx); EpiResid<false> E{a.out, resm, a.out, nullptr, part3, 0.5f};
      pg8::gemm_phase<EpiResid<false>, pg8::StaticOrder, true, true>(lds, g, S, E); }
    grid.sync();
    { const float* gfn = a.in[I_FN]; f32x4 gv[4];
#pragma unroll
      for (int j = 0; j < 4; ++j) gv[j] = ((const f32x4*)gfn)[lane + 64 * j];
      for (int row = gw; row < M; row += NGW) { const float rs = row_rstd(part3, row); f32x4* rp = (f32x4*)(a.out + (size_t)row * D);
#pragma unroll
          for (int j = 0; j < 4; ++j) { f32x4 v = rp[lane + 64 * j]; rp[lane + 64 * j] = v * rs * gv[j]; } } }
}

extern "C" void kernel_launch(void* const* d_in, const int* in_sizes, int n_in, void* d_out, int out_size, void* d_ws, size_t ws_size, hipStream_t stream) {
    static int grid = 0;
    if (grid == 0) {
        if (n_in != 18 || in_sizes[0] != M * D || out_size != M * D || ws_size < WS_END) { fprintf(stderr, "kernel_launch: unexpected shapes (n_in %d, in0 %d, out %d, ws %zu < %zu)\n", n_in, n_in > 0 ? in_sizes[0] : -1, out_size, ws_size, (size_t)WS_END); grid = -1; return; }
        int dev = 0, cus = 0, per_cu = 0;
        if (hipGetDevice(&dev) != hipSuccess || hipDeviceGetAttribute(&cus, hipDeviceAttributeMultiprocessorCount, dev) != hipSuccess) { grid = -1; return; }
        if (hipFuncSetAttribute((const void*)fwd_mega, hipFuncAttributeMaxDynamicSharedMemorySize, LDS_BYTES) != hipSuccess) { fprintf(stderr, "kernel_launch: hipFuncSetAttribute failed\n"); grid = -1; return; }
        if (hipOccupancyMaxActiveBlocksPerMultiprocessor(&per_cu, (const void*)fwd_mega, NWAVES * 64, LDS_BYTES) != hipSuccess || per_cu < 1) { fprintf(stderr, "kernel_launch: occupancy query gave %d\n", per_cu); (void)hipGetLastError(); grid = -1; return; }
        grid = cus * per_cu;
    }
    if (grid < 0) return;
    Args a{};
    for (int i = 0; i < 18; ++i) a.in[i] = (const float*)d_in[i];
    a.out = (float*)d_out; a.ws = (unsigned char*)d_ws;
    void* args[] = {&a};
    const hipError_t e = hipLaunchCooperativeKernel((const void*)fwd_mega, dim3(grid), dim3(NWAVES * 64), args, LDS_BYTES, stream);
    if (e != hipSuccess) fprintf(stderr, "kernel_launch: cooperative launch failed: %s (grid %d)\n", hipGetErrorString(e), grid);
}
```

```cpp
#include <hip/hip_runtime.h>
#include <hip/hip_cooperative_groups.h>
#include <cstdio>
#include <cstdint>
#include <cmath>
namespace cg = cooperative_groups;
namespace pg8 {
#define PG8_LAS __attribute__((address_space(3)))
typedef unsigned short bf16_t;
typedef short bf16x8 __attribute__((ext_vector_type(8)));
typedef float f32x4 __attribute__((ext_vector_type(4)));
typedef unsigned u32x4 __attribute__((ext_vector_type(4)));
constexpr int BM = 256, BK = 64, HALF = 128, HTB = HALF * BK * 2  , STAGE_BYTES = 8 * HTB, NXCD = 8, WGM = 8;

__host__ __device__ __forceinline__ int lds_byte(int r, int c) { const int st = (r >> 4) * 2 + (c >> 5), rr = r & 15, cc = c & 31, ob = rr * 64 + cc * 2; return st * 1024 + (ob ^ (((ob >> 9) & 1) << 5)); }
__host__ __device__ __forceinline__ void stage_rc(int b, int& R, int& C) { const int st = b / 1024, sb = b % 1024, swz = sb ^ (((sb >> 9) & 1) << 5); R = (st >> 1) * 16 + swz / 64; C = (st & 1) * 32 + (swz % 64) / 2; }
__host__ __device__ __forceinline__ int perm32(int rho) { const int n = rho >> 4, i = rho & 15; return 8 * (i >> 2) + 4 * n + (i & 3); }

struct Unit { int pm, pn; };
struct Gemm { const bf16_t* A; const bf16_t* Bt; int M, N, K; };

struct StaticOrder {
    int nM, nN, nwg, G, c;
    __host__ __device__ void init(int M, int N, int G_, int c_) { nM = M / BM; nN = N / BM; nwg = nM * nN; G = G_; c = c_; }
    __host__ __device__ bool next(int i, Unit& u) const {
        const long L = (long)i * G + c; if (L >= nwg) return false;
        int wgid = (int)L; { const int q = nwg / NXCD, r = nwg % NXCD, xcd = wgid % NXCD, off = wgid / NXCD; wgid = (xcd < r ? xcd * (q + 1) : r * (q + 1) + (xcd - r) * q) + off; }
        const int nig = WGM * nN, gid = wgid / nig, fm = gid * WGM, gsz = (nM - fm) < WGM ? (nM - fm) : WGM;
        u.pm = fm + ((wgid % nig) % gsz); u.pn = (wgid % nig) / gsz; return true;
    }
    __device__ __forceinline__ void a_ready(const Unit&) const {}
    __device__ __forceinline__ void done(const Unit&) const {}
};

__device__ __forceinline__ unsigned cvt_pk_bf16(float lo, float hi) { unsigned r; asm volatile("v_cvt_pk_bf16_f32 %0, %1, %2" : "=v"(r) : "v"(lo), "v"(hi)); return r; }
typedef float f32x2 __attribute__((ext_vector_type(2)));
template <class Epi, class Sched, bool ALIGN_EPI = false, bool SP2 = false>
__device__ __forceinline__ void gemm_phase(PG8_LAS unsigned char* lds, const Gemm g, const Sched& S, const Epi& E) {
    const int tid = threadIdx.x, wid = __builtin_amdgcn_readfirstlane(tid >> 6), lane = tid & 63, wr = wid >> 2, wc = wid & 3, fr = lane & 15, fq = lane >> 4;
    const int K = g.K, nt = K / BK;
    unsigned voffA[2], voffB[2];
#pragma unroll
    for (int i = 0; i < 2; ++i) { int R, C; stage_rc(tid * 16 + i * 8192, R, C); const int Rb = Epi::PERM ? ((R & ~31) + perm32(R & 31)) : R;
        voffA[i] = (unsigned)(R * K + C) * 2u; voffB[i] = (unsigned)(Rb * K + C) * 2u; }
    const size_t kstep = (size_t)(BK * 2);
    const size_t hstep = (size_t)HALF * K * 2;
    const size_t tstep = 2 * hstep;
    const unsigned ldsw = (unsigned)wid * 1024u;
    const int aoff = lds_byte(wr * 64 + fr, fq * 8), boff = lds_byte(wc * 32 + fr, fq * 8);
#define PG8_SA(b, h) (((b) * 2 + (h)) * HTB)
#define PG8_SB(b, h) ((4 + (b) * 2 + (h)) * HTB)
#define PG8_STAGE(bufoff, gbase, voff) do { _Pragma("unroll") for (int _i = 0; _i < 2; ++_i) \
        __builtin_amdgcn_global_load_lds((const unsigned*)((const char*)(gbase) + (voff)[_i]), (PG8_LAS unsigned*)(lds + (bufoff) + ldsw + _i * 8192), 16, 0, 0); } while (0)
#define PG8_LDA(dst, b, h) do { _Pragma("unroll") for (int m = 0; m < 4; ++m) _Pragma("unroll") for (int k = 0; k < 2; ++k) dst[m][k] = *(const PG8_LAS bf16x8*)(lds + PG8_SA(b, h) + aoff + m * 2048 + k * 1024); } while (0)
#define PG8_LDB(dst, b, h) do { _Pragma("unroll") for (int n = 0; n < 2; ++n) _Pragma("unroll") for (int k = 0; k < 2; ++k) dst[n][k] = *(const PG8_LAS bf16x8*)(lds + PG8_SB(b, h) + boff + n * 2048 + k * 1024); } while (0)
#define PG8_MMA(ai, bj, At, Bt) do { __builtin_amdgcn_s_setprio(1); _Pragma("unroll") for (int m = 0; m < 4; ++m) _Pragma("unroll") for (int n = 0; n < 2; ++n) _Pragma("unroll") for (int k = 0; k < 2; ++k) \
        acc[ai][bj][m][n] = __builtin_amdgcn_mfma_f32_16x16x32_bf16(Bt[n][k], At[m][k], acc[ai][bj][m][n], 0, 0, 0); __builtin_amdgcn_s_setprio(0); } while (0)
#define PG8_WAIT_V(n) asm volatile("s_waitcnt vmcnt(" #n ")" ::: "memory")
#define PG8_WAIT_L(n) asm volatile("s_waitcnt lgkmcnt(" #n ")" ::: "memory")
#define PG8_BAR __builtin_amdgcn_s_barrier()
#define PG8_SCHED __builtin_amdgcn_sched_barrier(0)
    Unit cur, nxt; int ui = 0;
    if (!S.next(0, cur)) return;
    f32x4 acc[2][2][4][2];
#pragma unroll
    for (int a = 0; a < 2; ++a)
#pragma unroll
        for (int b = 0; b < 2; ++b)
#pragma unroll
            for (int m = 0; m < 4; ++m)
#pragma unroll
                for (int n = 0; n < 2; ++n) acc[a][b][m][n] = (f32x4){0.f, 0.f, 0.f, 0.f};
    bf16x8 At[4][2], B0[2][2], B1[2][2];
    const char* cA = (const char*)g.A + (size_t)cur.pm * tstep; const char* cB = (const char*)g.Bt + (size_t)cur.pn * tstep;
    S.a_ready(cur);
    if constexpr (SP2) {
        PG8_STAGE(PG8_SB(0, 0), cB, voffB); PG8_STAGE(PG8_SB(0, 1), cB + hstep, voffB); PG8_STAGE(PG8_SA(0, 0), cA, voffA); PG8_STAGE(PG8_SA(0, 1), cA + hstep, voffA);
        if (wr == 1) PG8_BAR;
        PG8_WAIT_V(2); PG8_BAR;
        PG8_STAGE(PG8_SB(1, 0), cB + kstep, voffB); PG8_STAGE(PG8_SA(1, 0), cA + kstep, voffA); PG8_STAGE(PG8_SB(1, 1), cB + hstep + kstep, voffB);
        PG8_WAIT_V(6); PG8_BAR;
    } else {
        PG8_STAGE(PG8_SB(0, 0), cB, voffB); PG8_STAGE(PG8_SA(0, 0), cA, voffA); PG8_STAGE(PG8_SB(0, 1), cB + hstep, voffB); PG8_STAGE(PG8_SA(0, 1), cA + hstep, voffA);
        if (wr == 1) PG8_BAR;
        PG8_WAIT_V(4); PG8_BAR;
        PG8_STAGE(PG8_SB(1, 0), cB + kstep, voffB); PG8_STAGE(PG8_SA(1, 0), cA + kstep, voffA); PG8_STAGE(PG8_SB(1, 1), cB + hstep + kstep, voffB);
        PG8_WAIT_V(6); PG8_BAR;
    }
    for (;;) {
        const bool has_next = S.next(ui + 1, nxt);
        const char* nA = has_next ? (const char*)g.A + (size_t)nxt.pm * tstep : cA; const char* nB = has_next ? (const char*)g.Bt + (size_t)nxt.pn * tstep : cB;
        for (int t = 0; t < nt; t += 2) {
            const bool last = (t == nt - 2);
            const char* a1 = cA + (size_t)(t + 1) * kstep;
            const char* a2 = last ? nA : cA + (size_t)(t + 2) * kstep; const char* b2 = last ? nB : cB + (size_t)(t + 2) * kstep;
            const char* a3 = a2 + kstep; const char* b3 = b2 + kstep;
            if (last && has_next) S.a_ready(nxt);
            if constexpr (SP2) {
            PG8_LDB(B0, 0, 0); PG8_LDB(B1, 0, 1); PG8_SCHED; PG8_LDA(At, 0, 0); PG8_STAGE(PG8_SA(1, 1), a1 + hstep, voffA);
            PG8_WAIT_V(8); PG8_WAIT_L(0); PG8_BAR; PG8_MMA(0, 0, At, B0); PG8_MMA(0, 1, At, B1); PG8_BAR; PG8_SCHED;
            PG8_LDA(At, 0, 1); PG8_STAGE(PG8_SB(0, 0), b2, voffB); PG8_STAGE(PG8_SB(0, 1), b2 + hstep, voffB); PG8_STAGE(PG8_SA(0, 0), a2, voffA);
            PG8_WAIT_V(8); PG8_WAIT_L(0); PG8_BAR; PG8_MMA(1, 0, At, B0); PG8_MMA(1, 1, At, B1); PG8_BAR; PG8_SCHED;
            PG8_LDB(B0, 1, 0); PG8_LDB(B1, 1, 1); PG8_SCHED; PG8_LDA(At, 1, 0); PG8_STAGE(PG8_SA(0, 1), a2 + hstep, voffA);
            PG8_WAIT_V(8); PG8_WAIT_L(0); PG8_BAR; PG8_MMA(0, 0, At, B0); PG8_MMA(0, 1, At, B1); PG8_BAR; PG8_SCHED;
            PG8_LDA(At, 1, 1); PG8_STAGE(PG8_SB(1, 0), b3, voffB); PG8_STAGE(PG8_SB(1, 1), b3 + hstep, voffB); PG8_STAGE(PG8_SA(1, 0), a3, voffA);
            PG8_WAIT_V(8); PG8_WAIT_L(0); PG8_BAR; PG8_MMA(1, 0, At, B0); PG8_MMA(1, 1, At, B1); PG8_BAR; PG8_SCHED;
            } else {
            PG8_LDB(B0, 0, 0); PG8_SCHED; PG8_LDA(At, 0, 0); PG8_STAGE(PG8_SA(1, 1), a1 + hstep, voffA);
            PG8_WAIT_L(8); PG8_BAR; PG8_WAIT_L(0); PG8_MMA(0, 0, At, B0); PG8_BAR; PG8_SCHED;
            PG8_LDB(B1, 0, 1); PG8_STAGE(PG8_SB(0, 0), b2, voffB);
            PG8_BAR; PG8_WAIT_L(0); PG8_MMA(0, 1, At, B1); PG8_BAR;
            PG8_LDA(At, 0, 1); PG8_STAGE(PG8_SA(0, 0), a2, voffA);
            PG8_BAR; PG8_WAIT_L(0); PG8_MMA(1, 0, At, B0); PG8_BAR; PG8_SCHED;
            PG8_STAGE(PG8_SB(0, 1), b2 + hstep, voffB);
            PG8_WAIT_V(6); PG8_BAR; PG8_MMA(1, 1, At, B1); PG8_BAR;
            PG8_LDB(B0, 1, 0); PG8_SCHED; PG8_LDA(At, 1, 0); PG8_STAGE(PG8_SA(0, 1), a2 + hstep, voffA);
            PG8_WAIT_L(8); PG8_BAR; PG8_WAIT_L(0); PG8_MMA(0, 0, At, B0); PG8_BAR; PG8_SCHED;
            PG8_LDB(B1, 1, 1); PG8_STAGE(PG8_SB(1, 0), b3, voffB);
            PG8_BAR; PG8_WAIT_L(0); PG8_MMA(0, 1, At, B1); PG8_BAR;
            PG8_LDA(At, 1, 1); PG8_STAGE(PG8_SA(1, 0), a3, voffA);
            PG8_BAR; PG8_WAIT_L(0); PG8_MMA(1, 0, At, B0); PG8_BAR; PG8_SCHED;
            PG8_STAGE(PG8_SB(1, 1), b3 + hstep, voffB);
            PG8_WAIT_V(6); PG8_BAR; PG8_MMA(1, 1, At, B1); PG8_BAR;
            }
        }
        if constexpr (ALIGN_EPI) { if (wr == 0) PG8_BAR; }
        if constexpr (!Epi::AFTER_DRAIN) { E(acc, cur, wr, wc, fr, fq); S.done(cur); }
        if (!has_next) break;
#pragma unroll
        for (int a = 0; a < 2; ++a)
#pragma unroll
            for (int b = 0; b < 2; ++b)
#pragma unroll
                for (int m = 0; m < 4; ++m)
#pragma unroll
                    for (int n = 0; n < 2; ++n) acc[a][b][m][n] = (f32x4){0.f, 0.f, 0.f, 0.f};
        cur = nxt; cA = nA; cB = nB; ++ui;
        if constexpr (ALIGN_EPI) { if (wr == 1) PG8_BAR; }
    }
    PG8_WAIT_V(0);
    if constexpr (!ALIGN_EPI) { if (wr == 0) PG8_BAR; }
    PG8_BAR;
    if constexpr (Epi::AFTER_DRAIN) { E.fused(acc, cur, wr, wc, fr, fq, lds, wid, lane); S.done(cur); }
#undef PG8_SA
#undef PG8_SB
#undef PG8_STAGE
#undef PG8_LDA
#undef PG8_LDB
#undef PG8_MMA
#undef PG8_WAIT_V
#undef PG8_WAIT_L
#undef PG8_BAR
#undef PG8_SCHED
}
}

using pg8::bf16_t; using pg8::bf16x8; using pg8::f32x4; using pg8::u32x4;
typedef float f32x16 __attribute__((ext_vector_type(16)));
typedef unsigned u32x2 __attribute__((ext_vector_type(2)));
#define LAS __attribute__((address_space(3)))
constexpr int D = 1024, BATCH = 4, SEQ = 8192, DFF = 2816, DH = 512, NH = 8;
constexpr int M = BATCH * SEQ;
constexpr int MP = M + 256;
constexpr int NMI = 3328;
constexpr float EPS = 1e-6f, LOG2E = 1.4426950408889634f;
constexpr int NWAVES = 8, LDS_BYTES = 147456;

constexpr size_t MiB = 1u << 20;
constexpr size_t WS_CTL = 0;
constexpr size_t WS_W1 = 2 * MiB, WS_W1O = 13 * MiB, WS_WMI = 19 * MiB, WS_WMO = 26 * MiB, WS_W2 = 28 * MiB, WS_W2O = 39 * MiB;
constexpr size_t WS_PART = 45 * MiB, PART_STRIDE = 2304 * 1024;
constexpr size_t WS_LOGF = 54 * MiB;
constexpr size_t WS_RESM = 56 * MiB;
constexpr size_t WS_XA = 58 * MiB;
constexpr size_t WS_XB = 123 * MiB;
constexpr size_t WS_ACT = 187 * MiB;
constexpr size_t QKV_STRIDE = (size_t)MP * DH * 2;
constexpr size_t WS_END = WS_ACT + (size_t)MP * DFF * 2;
static_assert(5 * QKV_STRIDE <= (size_t)MP * DFF * 2, "P3 outputs overlay the activation buffer");
static_assert((size_t)MP * 16 * 4 <= PART_STRIDE && WS_PART + 4 * PART_STRIDE <= WS_LOGF, "ws map");

__device__ __forceinline__ unsigned cvtpk(float lo, float hi) { return pg8::cvt_pk_bf16(lo, hi); }
__device__ __forceinline__ float bf_lo(unsigned u) { return __uint_as_float(u << 16); }
__device__ __forceinline__ float bf_hi(unsigned u) { return __uint_as_float(u & 0xffff0000u); }
__device__ __forceinline__ float wave_sum(float v) {
#pragma unroll
    for (int o = 1; o < 64; o <<= 1) v += __shfl_xor(v, o);
    return v;
}
__device__ __forceinline__ float row_rstd(const float* part, int row) {
    const f32x4* p = (const f32x4*)(part + (size_t)row * 16);
    const f32x4 a = p[0], b = p[1], c = p[2], d = p[3];
    const f32x4 s = (a + b) + (c + d);
    const float t = (s[0] + s[1]) + (s[2] + s[3]);
    return 1.0f / sqrtf(t * (1.0f / 1024.0f) + EPS);
}


struct EpiSwiGLU {
    static constexpr bool PERM = true, AFTER_DRAIN = false;
    bf16_t* O; const float* part;
    __device__ __forceinline__ void operator()(const f32x4 (&acc)[2][2][4][2], const pg8::Unit& u, int wr, int wc, int fr, int fq) const {
        const int row0 = u.pm * 256 + wr * 64 + fr, col0 = u.pn * 128 + wc * 32 + 8 * fq;
#pragma unroll
        for (int ai = 0; ai < 2; ++ai)
#pragma unroll
            for (int m = 0; m < 4; ++m) {
                const int row = row0 + ai * 128 + m * 16; const float rs = row_rstd(part, row);
                float a[8];
#pragma unroll
                for (int n = 0; n < 2; ++n)
#pragma unroll
                    for (int i = 0; i < 4; ++i) { const float g = acc[ai][0][m][n][i] * rs, up = acc[ai][1][m][n][i] * rs;
                        const float sg = __builtin_amdgcn_rcpf(1.0f + __builtin_amdgcn_exp2f(-g * LOG2E)); a[n * 4 + i] = g * sg * up; }
                u32x4 w; w.x = cvtpk(a[0], a[1]); w.y = cvtpk(a[2], a[3]); w.z = cvtpk(a[4], a[5]); w.w = cvtpk(a[6], a[7]);
                *(u32x4*)(O + (size_t)row * DFF + col0) = w;
            }
    }
};

template <bool HAS_HB> struct EpiResid {
    static constexpr bool PERM = true, AFTER_DRAIN = false;
    const float* res; const float* resm; float* out; bf16_t* hb; float* part; float alpha;
    __device__ __forceinline__ void operator()(const f32x4 (&acc)[2][2][4][2], const pg8::Unit& u, int wr, int wc, int fr, int fq) const {
        const int row0 = u.pm * 256 + wr * 64 + fr, col0 = u.pn * 256 + wc * 32 + 8 * fq;
        const bool meta = u.pm >= M / 256;
#pragma unroll
        for (int ai = 0; ai < 2; ++ai)
#pragma unroll
            for (int m = 0; m < 4; ++m) {
                const int row = row0 + ai * 128 + m * 16;
                const float* rp = meta ? resm + (size_t)(row - M) * D : res + (size_t)row * D;
                float ss = 0.f;
#pragma unroll
                for (int bj = 0; bj < 2; ++bj) { const int c = col0 + 128 * bj;
                    const f32x4 r0 = *(const f32x4*)(rp + c), r1 = *(const f32x4*)(rp + c + 4);
                    const f32x4 v0 = r0 + acc[ai][bj][m][0] * alpha, v1 = r1 + acc[ai][bj][m][1] * alpha;
                    if (!meta) { float* op = out + (size_t)row * D + c; *(f32x4*)op = v0; *(f32x4*)(op + 4) = v1; }
                    if (HAS_HB) { u32x4 w; w.x = cvtpk(v0[0], v0[1]); w.y = cvtpk(v0[2], v0[3]); w.z = cvtpk(v1[0], v1[1]); w.w = cvtpk(v1[2], v1[3]);
                        *(u32x4*)(hb + (size_t)row * D + c) = w; }
                    ss += (v0[0] * v0[0] + v0[1] * v0[1]) + (v0[2] * v0[2] + v0[3] * v0[3]) + (v1[0] * v1[0] + v1[1] * v1[1]) + (v1[2] * v1[2] + v1[3] * v1[3]); }
                ss += __shfl_xor(ss, 16); ss += __shfl_xor(ss, 32);
                if (fq == 0) part[(size_t)row * 16 + u.pn * 4 + wc] = ss;
            }
    }
};

struct EpiMixIn {
    static constexpr bool PERM = true, AFTER_DRAIN = false;
    bf16_t *Q, *K, *V, *B, *Z; float* logfT; const float* part; const float *qn, *kn, *bfg;
    __device__ __forceinline__ void operator()(const f32x4 (&acc)[2][2][4][2], const pg8::Unit& u, int wr, int wc, int fr, int fq) const {
        const int row0 = u.pm * 256 + wr * 64 + fr, pn = u.pn;
        if (pn < 4) {
            const float* gp = (pn < 2 ? qn : kn) + 8 * fq; bf16_t* base = pn < 2 ? Q : K; const float sc = pn < 2 ? 0.125f * LOG2E : 1.0f;
            const int head = (pn & 1) * 4 + wc;
            float g[2][8];
#pragma unroll
            for (int bj = 0; bj < 2; ++bj)
#pragma unroll
                for (int i = 0; i < 8; ++i) g[bj][i] = gp[bj * 32 + i] * sc;
#pragma unroll
            for (int ai = 0; ai < 2; ++ai)
#pragma unroll
                for (int m = 0; m < 4; ++m) {
                    const int row = row0 + ai * 128 + m * 16; const float rs = row_rstd(part, row);
                    float a[2][8]; float ss = 0.f;
#pragma unroll
                    for (int bj = 0; bj < 2; ++bj)
#pragma unroll
                        for (int i = 0; i < 8; ++i) { a[bj][i] = acc[ai][bj][m][i >> 2][i & 3] * rs; ss += a[bj][i] * a[bj][i]; }
                    ss += __shfl_xor(ss, 16); ss += __shfl_xor(ss, 32);
                    const float rr = 1.0f / sqrtf(ss * (1.0f / 64.0f) + EPS);
#pragma unroll
                    for (int bj = 0; bj < 2; ++bj) { u32x4 w;
                        w.x = cvtpk(a[bj][0] * rr * g[bj][0], a[bj][1] * rr * g[bj][1]); w.y = cvtpk(a[bj][2] * rr * g[bj][2], a[bj][3] * rr * g[bj][3]);
                        w.z = cvtpk(a[bj][4] * rr * g[bj][4], a[bj][5] * rr * g[bj][5]); w.w = cvtpk(a[bj][6] * rr * g[bj][6], a[bj][7] * rr * g[bj][7]);
                        *(u32x4*)(base + (size_t)row * DH + head * 64 + bj * 32 + 8 * fq) = w; }
                }
        } else if (pn < 8) {
            bf16_t* base = pn < 6 ? V : B; const int col0 = (pn & 1) * 256 + wc * 32 + 8 * fq;
#pragma unroll
            for (int ai = 0; ai < 2; ++ai)
#pragma unroll
                for (int m = 0; m < 4; ++m) {
                    const int row = row0 + ai * 128 + m * 16; const float rs = row_rstd(part, row);
#pragma unroll
                    for (int bj = 0; bj < 2; ++bj) { const f32x4 v0 = acc[ai][bj][m][0] * rs, v1 = acc[ai][bj][m][1] * rs; u32x4 w;
                        w.x = cvtpk(v0[0], v0[1]); w.y = cvtpk(v0[2], v0[3]); w.z = cvtpk(v1[0], v1[1]); w.w = cvtpk(v1[2], v1[3]);
                        *(u32x4*)(base + (size_t)row * DH + col0 + 128 * bj) = w; }
                }
        } else if (pn < 12) {
            const int col0 = (pn - 8) * 128 + wc * 32 + 8 * fq;
#pragma unroll
            for (int ai = 0; ai < 2; ++ai)
#pragma unroll
                for (int m = 0; m < 4; ++m) {
                    const int row = row0 + ai * 128 + m * 16; const float rs = row_rstd(part, row); const float r2 = rs * rs;
                    const f32x4 v0 = acc[ai][0][m][0] * acc[ai][1][m][0] * r2, v1 = acc[ai][0][m][1] * acc[ai][1][m][1] * r2; u32x4 w;
                    w.x = cvtpk(v0[0], v0[1]); w.y = cvtpk(v0[2], v0[3]); w.z = cvtpk(v1[0], v1[1]); w.w = cvtpk(v1[2], v1[3]);
                    *(u32x4*)(Z + (size_t)row * DH + col0) = w;
                }
        } else {
            if (wc == 0 && fq == 0) {
                float bf[8];
#pragma unroll
                for (int i = 0; i < 8; ++i) bf[i] = bfg[i];
#pragma unroll
                for (int ai = 0; ai < 2; ++ai)
#pragma unroll
                    for (int m = 0; m < 4; ++m) {
                        const int row = row0 + ai * 128 + m * 16; const float rs = row_rstd(part, row);
#pragma unroll
                        for (int i = 0; i < 8; ++i) { const float x = acc[ai][0][m][i >> 2][i & 3] * rs + bf[i];
                            const float ls = fminf(x, 0.f) - __logf(1.0f + __expf(-fabsf(x)));
                            logfT[(size_t)i * MP + row] = ls; }
                    }
            }
        }
    }
};

__device__ __forceinline__ void conv_item(const float* W, int N, int K, bf16_t* WT, int dr0, int sc0, int nvalid, const float* ks, int kb, LAS float* scr, int lane) {
    const int k0 = 64 * kb, n = lane & 31;
#pragma unroll 8
    for (int i = 0; i < 32; ++i) { const int kk = 2 * i + (lane >> 5);
        float v = 0.f; if (n < nvalid) { v = W[(size_t)(k0 + kk) * N + sc0 + n]; if (ks) v *= ks[k0 + kk]; }
        scr[kk * 33 + n] = v; }
    asm volatile("s_waitcnt lgkmcnt(0)" ::: "memory");
    const int c = lane & 7;
#pragma unroll
    for (int j = 0; j < 4; ++j) { const int nn = (lane >> 3) + 8 * j; const LAS float* s = scr + (8 * c) * 33 + nn;
        u32x4 o; o.x = cvtpk(s[0 * 33], s[1 * 33]); o.y = cvtpk(s[2 * 33], s[3 * 33]); o.z = cvtpk(s[4 * 33], s[5 * 33]); o.w = cvtpk(s[6 * 33], s[7 * 33]);
        *(u32x4*)(WT + (size_t)(dr0 + nn) * K + k0 + 8 * c) = o; }
    asm volatile("s_waitcnt lgkmcnt(0)" ::: "memory");
}

struct Args { const float* in[18]; float* out; unsigned char* ws; };
enum { I_X = 0, I_META, I_F1N, I_F1WI, I_F1WO, I_MIXN, I_WMI, I_BF, I_QN, I_KN, I_CW, I_AON, I_CON, I_WMO, I_F2N, I_F2WI, I_F2WO, I_FN };

__device__ __forceinline__ void p0_prologue(const Args& a, LAS unsigned char* lds, int gw, int NGW, int wave, int lane) {
    unsigned char* ws = a.ws;
    LAS float* scr = (LAS float*)(lds + wave * 16384);
    constexpr int I_IN = (2 * DFF / 32) * (D / 64), I_OUT = (D / 32) * (DFF / 64), I_MI = (NMI / 32) * (D / 64), I_MO = (D / 32) * (D / 64);
    constexpr int NITEMS = 2 * I_IN + 2 * I_OUT + I_MI + I_MO;
    for (int it = gw; it < NITEMS; it += NGW) {
        int r = it;
        if (r < 2 * I_IN) { const int which = r >= I_IN; r -= which * I_IN; const int nblk = 2 * DFF / 32, kb = r / nblk, dr0 = (r % nblk) * 32;
            const int pn = dr0 >> 8, within = dr0 & 255, bj = within >> 7, i0 = within & 127;
            conv_item(a.in[which ? I_F2WI : I_F1WI], 2 * DFF, D, (bf16_t*)(ws + (which ? WS_W2 : WS_W1)), dr0, bj * DFF + pn * 128 + i0, 32, a.in[which ? I_F2N : I_F1N], kb, scr, lane); continue; }
        r -= 2 * I_IN;
        if (r < 2 * I_OUT) { const int which = r >= I_OUT; r -= which * I_OUT; const int nblk = D / 32, kb = r / nblk, dr0 = (r % nblk) * 32;
            conv_item(a.in[which ? I_F2WO : I_F1WO], D, DFF, (bf16_t*)(ws + (which ? WS_W2O : WS_W1O)), dr0, dr0, 32, nullptr, kb, scr, lane); continue; }
        r -= 2 * I_OUT;
        if (r < I_MI) { const int nblk = NMI / 32, kb = r / nblk, dr0 = (r % nblk) * 32;
            const int pn = dr0 >> 8, within = dr0 & 255, bj = within >> 7, i0 = within & 127, wcw = i0 >> 5;
            int sc0, nv = 32;
            if (pn < 4) sc0 = (pn >> 1) * 512 + ((pn & 1) * 4 + wcw) * 64 + bj * 32;
            else if (pn < 6) sc0 = dr0;
            else if (pn < 8) sc0 = 1544 + (dr0 - 1536);
            else if (pn < 12) sc0 = (bj ? 2568 : 2056) + 128 * (pn - 8) + i0;
            else { sc0 = 1536; nv = (dr0 == 3072) ? 8 : 0; }
            conv_item(a.in[I_WMI], 3080, D, (bf16_t*)(ws + WS_WMI), dr0, sc0, nv, a.in[I_MIXN], kb, scr, lane); continue; }
        r -= I_MI;
        { const int nblk = D / 32, kb = r / nblk, dr0 = (r % nblk) * 32;
          const float* ks = (kb < 8) ? a.in[I_AON] : a.in[I_CON] - 512;
          conv_item(a.in[I_WMO], D, D, (bf16_t*)(ws + WS_WMO), dr0, dr0, 32, ks, kb, scr, lane); }
    }
    bf16_t* XA = (bf16_t*)(ws + WS_XA); float* part0 = (float*)(ws + WS_PART); float* resm = (float*)(ws + WS_RESM);
    for (int row = gw; row < MP; row += NGW) {
        const float* src = row < M ? a.in[I_X] + (size_t)row * D : (row < M + 16 ? a.in[I_META] + (size_t)(row - M) * D : nullptr);
        f32x4 v[4]; float ss = 0.f;
#pragma unroll
        for (int j = 0; j < 4; ++j) { v[j] = src ? ((const f32x4*)src)[lane + 64 * j] : (f32x4){0.f, 0.f, 0.f, 0.f}; ss += (v[j][0] * v[j][0] + v[j][1] * v[j][1]) + (v[j][2] * v[j][2] + v[j][3] * v[j][3]); }
        ss = wave_sum(ss);
#pragma unroll
        for (int j = 0; j < 4; ++j) { u32x2 w; w.x = cvtpk(v[j][0], v[j][1]); w.y = cvtpk(v[j][2], v[j][3]); *(u32x2*)(XA + (size_t)row * D + 4 * (lane + 64 * j)) = w; }
        if (lane < 16) part0[(size_t)row * 16 + lane] = lane == 0 ? ss : 0.f;
        if (row >= M) {
#pragma unroll
            for (int j = 0; j < 4; ++j) ((f32x4*)(resm + (size_t)(row - M) * D))[lane + 64 * j] = v[j]; }
    }
}

struct MixP { const bf16_t *Q, *K, *V, *B, *Z; const float* logfT; const float* cw; bf16_t* out; float thresh; };

__device__ __forceinline__ void mixer_unit(const MixP& p, int b, int t0, LAS unsigned char* lds, int wave, int lane) {
    const int r32 = lane & 31, hi = lane >> 5, h = wave;
    LAS float* sc = (LAS float*)lds + wave * 64;
    LAS float* ssq = (LAS float*)(lds + 4096);
    const size_t rowq = (size_t)b * SEQ + t0;
    bf16x8 qf[4];
    { const bf16_t* qp = p.Q + (rowq + r32) * DH + h * 64 + 8 * hi;
#pragma unroll
      for (int ks = 0; ks < 4; ++ks) qf[ks] = *(const bf16x8*)(qp + 16 * ks); }
    float mrun = -INFINITY, l = 0.f; f32x16 o0, o1;
#pragma unroll
    for (int r = 0; r < 16; ++r) { o0[r] = 0.f; o1[r] = 0.f; }
    const int jd = t0 >> 6, T0 = jd << 6;
    float base = 0.f;
    for (int j = jd; j >= -1; --j) {
        if (j < jd && base < -p.thresh) break;
        const int nvalid = j >= 0 ? 64 : 16;
        const size_t krow0 = j >= 0 ? (size_t)b * SEQ + 64 * j : (size_t)M;
        const float Lv = lane < nvalid ? p.logfT[(size_t)h * MP + krow0 + lane] * LOG2E : 0.f;
        float P = Lv;
#pragma unroll
        for (int o = 1; o < 64; o <<= 1) { const float t = __shfl_up(P, o); if (lane >= o) P += t; }
        const float tot = __int_as_float(__builtin_amdgcn_readlane(__float_as_int(P), 63));
        const float p31 = __int_as_float(__builtin_amdgcn_readlane(__float_as_int(P), 31));
        const float bj = (j == jd) ? ((t0 > T0) ? p31 : 0.f) : base + tot;
        sc[lane] = bj - P; base = bj;
        f32x16 s0, s1;
#pragma unroll
        for (int r = 0; r < 16; ++r) { s0[r] = 0.f; s1[r] = 0.f; }
        { const bf16_t* kp = p.K + (krow0 + r32) * DH + h * 64 + 8 * hi;
#pragma unroll
          for (int ks = 0; ks < 4; ++ks) { const bf16x8 k0 = *(const bf16x8*)(kp + 16 * ks), k1 = *(const bf16x8*)(kp + 32 * DH + 16 * ks);
              s0 = __builtin_amdgcn_mfma_f32_32x32x16_bf16(k0, qf[ks], s0, 0, 0, 0); s1 = __builtin_amdgcn_mfma_f32_32x32x16_bf16(k1, qf[ks], s1, 0, 0, 0); } }
        asm volatile("s_waitcnt lgkmcnt(0)" ::: "memory");
#pragma unroll
        for (int g = 0; g < 4; ++g) { const f32x4 b0 = *(const LAS f32x4*)(sc + 8 * g + 4 * hi), b1 = *(const LAS f32x4*)(sc + 32 + 8 * g + 4 * hi);
#pragma unroll
            for (int i = 0; i < 4; ++i) { s0[4 * g + i] += b0[i]; s1[4 * g + i] += b1[i]; } }
        if (j == jd) { const int qa = t0 + r32 - T0;
#pragma unroll
            for (int r = 0; r < 16; ++r) { const int key = (r & 3) + 8 * (r >> 2) + 4 * hi; if (key > qa) s0[r] = -INFINITY; if (key + 32 > qa) s1[r] = -INFINITY; } }
        if (j < 0) {
#pragma unroll
            for (int r = 0; r < 16; ++r) { const int key = (r & 3) + 8 * (r >> 2) + 4 * hi; if (key >= 16) s0[r] = -INFINITY; s1[r] = -INFINITY; } }
        float mt = fmaxf(s0[0], s1[0]);
#pragma unroll
        for (int r = 1; r < 16; ++r) mt = fmaxf(mt, fmaxf(s0[r], s1[r]));
        mt = fmaxf(mt, __shfl_xor(mt, 32));
        const float mn = fmaxf(mrun, mt), al = __builtin_amdgcn_exp2f(mrun - mn); mrun = mn;
        float ps = 0.f;
#pragma unroll
        for (int r = 0; r < 16; ++r) { s0[r] = __builtin_amdgcn_exp2f(s0[r] - mn); s1[r] = __builtin_amdgcn_exp2f(s1[r] - mn); ps += s0[r] + s1[r]; }
        l = l * al + ps;
#pragma unroll
        for (int r = 0; r < 16; ++r) { o0[r] *= al; o1[r] *= al; }
#pragma unroll
        for (int g4 = 0; g4 < 4; ++g4) {
            const int sub = g4 & 1; u32x4 pw;
            if (g4 < 2) { pw.x = cvtpk(s0[8 * sub + 0], s0[8 * sub + 1]); pw.y = cvtpk(s0[8 * sub + 2], s0[8 * sub + 3]); pw.z = cvtpk(s0[8 * sub + 4], s0[8 * sub + 5]); pw.w = cvtpk(s0[8 * sub + 6], s0[8 * sub + 7]); }
            else        { pw.x = cvtpk(s1[8 * sub + 0], s1[8 * sub + 1]); pw.y = cvtpk(s1[8 * sub + 2], s1[8 * sub + 3]); pw.z = cvtpk(s1[8 * sub + 4], s1[8 * sub + 5]); pw.w = cvtpk(s1[8 * sub + 6], s1[8 * sub + 7]); }
            const bf16x8 pf = __builtin_bit_cast(bf16x8, pw);
            const bf16_t* vp = p.V + (krow0 + 16 * g4 + 4 * hi) * DH + h * 64 + r32;
            bf16x8 v0, v1;
#pragma unroll
            for (int i = 0; i < 4; ++i) { v0[i] = (short)vp[i * DH]; v0[4 + i] = (short)vp[(8 + i) * DH]; v1[i] = (short)vp[i * DH + 32]; v1[4 + i] = (short)vp[(8 + i) * DH + 32]; }
            o0 = __builtin_amdgcn_mfma_f32_32x32x16_bf16(v0, pf, o0, 0, 0, 0); o1 = __builtin_amdgcn_mfma_f32_32x32x16_bf16(v1, pf, o1, 0, 0, 0);
        }
    }
    l += __shfl_xor(l, 32);
    const float inv = 1.0f / l; float ss = 0.f;
#pragma unroll
    for (int r = 0; r < 16; ++r) { o0[r] *= inv; o1[r] *= inv; ss += o0[r] * o0[r] + o1[r] * o1[r]; }
    ss += __shfl_xor(ss, 32);
    if (hi == 0) ssq[r32 * 8 + h] = ss;
    { const int c0 = lane * 8;
      float w0[8], w1[8], w2[8];
#pragma unroll
      for (int i = 0; i < 8; ++i) { w0[i] = p.cw[c0 + i]; w1[i] = p.cw[DH + c0 + i]; w2[i] = p.cw[2 * DH + c0 + i]; }
#pragma unroll 1
      for (int rr = 0; rr < 4; ++rr) { const int t = t0 + wave + 8 * rr; const size_t row = (size_t)b * SEQ + t;
          const size_t row1 = t >= 1 ? row - 1 : (size_t)M + 15, row2 = t >= 2 ? row - 2 : (size_t)M + 14 + t;
          const u32x4 z0 = *(const u32x4*)(p.Z + row * DH + c0), z1 = *(const u32x4*)(p.Z + row1 * DH + c0), z2 = *(const u32x4*)(p.Z + row2 * DH + c0), bv = *(const u32x4*)(p.B + row * DH + c0);
          float y[8]; float s2 = 0.f;
#pragma unroll
          for (int i = 0; i < 4; ++i) {
              y[2 * i] = bf_lo(bv[i]) * (w0[2 * i] * bf_lo(z2[i]) + w1[2 * i] * bf_lo(z1[i]) + w2[2 * i] * bf_lo(z0[i]));
              y[2 * i + 1] = bf_hi(bv[i]) * (w0[2 * i + 1] * bf_hi(z2[i]) + w1[2 * i + 1] * bf_hi(z1[i]) + w2[2 * i + 1] * bf_hi(z0[i]));
              s2 += y[2 * i] * y[2 * i] + y[2 * i + 1] * y[2 * i + 1]; }
          s2 = wave_sum(s2); const float rs = 1.0f / sqrtf(s2 * (1.0f / 512.0f) + EPS);
          u32x4 w; w.x = cvtpk(y[0] * rs, y[1] * rs); w.y = cvtpk(y[2] * rs, y[3] * rs); w.z = cvtpk(y[4] * rs, y[5] * rs); w.w = cvtpk(y[6] * rs, y[7] * rs);
          *(u32x4*)(p.out + row * D + DH + c0) = w; } }
    __syncthreads();
    { const f32x4 a = *(const LAS f32x4*)(ssq + r32 * 8), c = *(const LAS f32x4*)(ssq + r32 * 8 + 4);
      const float tot = ((a[0] + a[1]) + (a[2] + a[3])) + ((c[0] + c[1]) + (c[2] + c[3]));
      const float rs = 1.0f / sqrtf(tot * (1.0f / 512.0f) + EPS);
      bf16_t* op = p.out + (rowq + r32) * D + h * 64 + 4 * hi;
#pragma unroll
      for (int g = 0; g < 4; ++g) { u32x2 w;
          w.x = cvtpk(o0[4 * g] * rs, o0[4 * g + 1] * rs); w.y = cvtpk(o0[4 * g + 2] * rs, o0[4 * g + 3] * rs); *(u32x2*)(op + 8 * g) = w;
          w.x = cvtpk(o1[4 * g] * rs, o1[4 * g + 1] * rs); w.y = cvtpk(o1[4 * g + 2] * rs, o1[4 * g + 3] * rs); *(u32x2*)(op + 32 + 8 * g) = w; } }
    __syncthreads();
}

#define RLX_AGENT __ATOMIC_RELAXED, __HIP_MEMORY_SCOPE_AGENT
#define XB_TMO      128
#define XB_XCNT(j)  (256  + 64 * (j))
#define XB_XSUB(j)  (1280 + 64 * (j))
#define XB_XGEN(j)  (2304 + 64 * (j))
#define XB_TOP      3328
#define XB_TOPGEN   3392
#define XCD_BAR_WORDS 3456
#define XB_SPIN_CAP (1u << 18)

__device__ __forceinline__ unsigned xb_ld(unsigned* p)              { return __hip_atomic_load(p, __ATOMIC_RELAXED, __HIP_MEMORY_SCOPE_AGENT); }
__device__ __forceinline__ unsigned xb_add(unsigned* p, unsigned v) { return __hip_atomic_fetch_add(p, v, __ATOMIC_RELAXED, __HIP_MEMORY_SCOPE_AGENT); }
__device__ __forceinline__ unsigned xb_xcc_id() { return (unsigned)__builtin_amdgcn_s_getreg((3 << 11) | 20) & 0xFu; }
#define XB_SPIN(cond, bar) do { unsigned _sp = 0; while (cond) { __builtin_amdgcn_s_sleep(1); \
    if ((++_sp & 255u) == 0u) { if (xb_ld(&(bar)[XB_TMO])) break; if (_sp > XB_SPIN_CAP) { atomicAdd(&(bar)[XB_TMO], 1u); break; } } } } while (0)

struct XcdBarrier {
    unsigned* bar; unsigned x;
    volatile LAS unsigned* st;
};

__device__ __forceinline__ XcdBarrier xcd_barrier_post(unsigned* bar, volatile LAS unsigned* st) {
    XcdBarrier b; b.bar = bar; b.x = xb_xcc_id(); b.st = st;
    if (threadIdx.x == 0) (void)xb_add(&bar[XB_XCNT(b.x)], 1u);
    return b;
}
__device__ __forceinline__ void xcd_barrier_complete(unsigned* bar, unsigned x, unsigned& nloc, unsigned& nx) {
    const unsigned G = gridDim.x * gridDim.y * gridDim.z;
    unsigned sum, cnt, mine, sp = 0u;
    for (;;) {
        sum = 0u; cnt = 0u; mine = 0u;
#pragma unroll
        for (unsigned j = 0; j < 16; ++j) { const unsigned c = xb_ld(&bar[XB_XCNT(j)]); sum += c; cnt += (c > 0u) ? 1u : 0u; mine = (j == x) ? c : mine; }
        if (sum == G) break;
        __builtin_amdgcn_s_sleep(1);
        if ((++sp & 255u) == 0u) { if (xb_ld(&bar[XB_TMO])) break; if (sp > XB_SPIN_CAP) { atomicAdd(&bar[XB_TMO], 1u); break; } }
    }
    nloc = mine > 0u ? mine : 1u; nx = cnt > 0u ? cnt : 1u;
}

__device__ __forceinline__ void xcd_barrier(const XcdBarrier& b) {
    asm volatile("s_waitcnt vmcnt(0)" ::: "memory");
    __syncthreads();
    if (threadIdx.x == 0) {
        unsigned* bar = b.bar;
        __builtin_amdgcn_s_waitcnt(0);
        unsigned nloc = b.st[0], nx = b.st[1];
        if (nloc == 0u) { xcd_barrier_complete(bar, b.x, nloc, nx); b.st[0] = nloc; b.st[1] = nx; }
        const unsigned old = xb_add(&bar[XB_XSUB(b.x)], 1u);
        const unsigned gen = old / nloc;
        if (old + 1u == (gen + 1u) * nloc) {
            __builtin_amdgcn_fence(__ATOMIC_RELEASE, "agent");
            asm volatile("s_waitcnt vmcnt(0)" ::: "memory");
            const unsigned og = xb_add(&bar[XB_TOP], 1u);
            const unsigned tg = og / nx;
            if (og + 1u == (tg + 1u) * nx) xb_add(&bar[XB_TOPGEN], 1u);
            else XB_SPIN(xb_ld(&bar[XB_TOPGEN]) == tg, bar);
            __builtin_amdgcn_fence(__ATOMIC_ACQUIRE, "agent");
            xb_add(&bar[XB_XGEN(b.x)], 1u);
            asm volatile("s_waitcnt vmcnt(0)" ::: "memory");
        } else {
            XB_SPIN(xb_ld(&bar[XB_XGEN(b.x)]) == gen, bar);
            __builtin_amdgcn_fence(__ATOMIC_ACQUIRE, "agent");
            asm volatile("s_waitcnt vmcnt(0)" ::: "memory");
        }
    }
    __syncthreads();
}

__global__ void __launch_bounds__(NWAVES * 64, 2) fwd_mega(Args a) {
    extern __shared__ __attribute__((aligned(16))) unsigned char lds_raw[];
    LAS unsigned char* lds = (LAS unsigned char*)lds_raw;
    cg::grid_group grid = cg::this_grid();
    const int tid = threadIdx.x, lane = tid & 63, wave = __builtin_amdgcn_readfirstlane(tid >> 6);
    const int G = gridDim.x, bx = blockIdx.x;
    const int vcu = (G % 8 == 0) ? (bx % 8) * (G / 8) + bx / 8 : bx;
    const int gw = vcu * NWAVES + wave, NGW = G * NWAVES;
    unsigned char* ws = a.ws;
    bf16_t *W1 = (bf16_t*)(ws + WS_W1), *W1O = (bf16_t*)(ws + WS_W1O), *WMI = (bf16_t*)(ws + WS_WMI), *WMO = (bf16_t*)(ws + WS_WMO), *W2 = (bf16_t*)(ws + WS_W2), *W2O = (bf16_t*)(ws + WS_W2O);
    bf16_t *XA = (bf16_t*)(ws + WS_XA), *XB = (bf16_t*)(ws + WS_XB), *ACT = (bf16_t*)(ws + WS_ACT);
    bf16_t *Qb = ACT, *Kb = (bf16_t*)(ws + WS_ACT + QKV_STRIDE), *Vb = (bf16_t*)(ws + WS_ACT + 2 * QKV_STRIDE), *Bb = (bf16_t*)(ws + WS_ACT + 3 * QKV_STRIDE), *Zb = (bf16_t*)(ws + WS_ACT + 4 * QKV_STRIDE);
    float *part0 = (float*)(ws + WS_PART), *part1 = (float*)(ws + WS_PART + PART_STRIDE), *part2 = (float*)(ws + WS_PART + 2 * PART_STRIDE), *part3 = (float*)(ws + WS_PART + 3 * PART_STRIDE);
    float *logfT = (float*)(ws + WS_LOGF), *resm = (float*)(ws + WS_RESM);

    volatile LAS unsigned* bst = (volatile LAS unsigned*)(lds + 131072 + 64);
    if (tid < 2) bst[tid] = 0u;
    unsigned* barw = (unsigned*)(ws + WS_CTL);
    if (bx == 0) for (int i = tid; i < XCD_BAR_WORDS; i += NWAVES * 64) __hip_atomic_store(barw + i, 0u, __ATOMIC_RELAXED, __HIP_MEMORY_SCOPE_AGENT);
    __syncthreads();
    p0_prologue(a, lds, gw, NGW, wave, lane);
    grid.sync();
    const XcdBarrier bar = xcd_barrier_post(barw, bst);
    { pg8::Gemm g{XA, W1, MP, 2 * DFF, D}; pg8::StaticOrder S; S.init(MP, 2 * DFF, G, bx); EpiSwiGLU E{ACT, part0};
      pg8::gemm_phase<EpiSwiGLU, pg8::StaticOrder, true, true>(lds, g, S, E); }
    xcd_barrier(bar);
    { pg8::Gemm g{ACT, W1O, MP, D, DFF}; pg8::StaticOrder S; S.init(MP, D, G, bx); EpiResid<true> E{a.in[I_X], resm, a.out, XA, part1, 0.5f};
      pg8::gemm_phase<EpiResid<true>, pg8::StaticOrder, true, true>(lds, g, S, E); }
    xcd_barrier(bar);
    { pg8::Gemm g{XA, WMI, MP, NMI, D}; pg8::StaticOrder S; S.init(MP, NMI, G, bx); EpiMixIn E{Qb, Kb, Vb, Bb, Zb, logfT, part1, a.in[I_QN], a.in[I_KN], a.in[I_BF]};
      pg8::gemm_phase<EpiMixIn, pg8::StaticOrder, true, true>(lds, g, S, E); }
    xcd_barrier(bar);
    { float gq = fabsf(a.in[I_QN][lane]), gk = fabsf(a.in[I_KN][lane]);
#pragma unroll
      for (int o = 1; o < 64; o <<= 1) { gq = fmaxf(gq, __shfl_xor(gq, o)); gk = fmaxf(gk, __shfl_xor(gk, o)); }
      MixP mp{Qb, Kb, Vb, Bb, Zb, logfT, a.in[I_CW], XA, 2.0f * (8.0f * gq * gk * LOG2E * 1.05f) + 170.0f};
      constexpr int NU = M / 32;
      for (int u = vcu; u < NU; u += G) { const int b = u / (SEQ / 32), t0 = (u % (SEQ / 32)) * 32; mixer_unit(mp, b, t0, lds, wave, lane); } }
    xcd_barrier(bar);
    { pg8::Gemm g{XA, WMO, M, D, D}; pg8::StaticOrder S; S.init(M, D, G, bx); EpiResid<true> E{a.out, resm, a.out, XB, part2, 1.0f};
      pg8::gemm_phase<EpiResid<true>, pg8::StaticOrder, true, true>(lds, g, S, E); }
    xcd_barrier(bar);
    { pg8::Gemm g{XB, W2, M, 2 * DFF, D}; pg8::StaticOrder S; S.init(M, 2 * DFF, G, bx); EpiSwiGLU E{ACT, part2};
      pg8::gemm_phase<EpiSwiGLU, pg8::StaticOrder, true, true>(lds, g, S, E); }
    xcd_barrier(bar);
    { pg8::Gemm g{ACT, W2O, M, D, DFF}; pg8::StaticOrder S; S.init(M, D, G, bx); EpiResid<false> E{a.out, resm, a.out, nullptr, part3, 0.5f};
      pg8::gemm_phase<EpiResid<false>, pg8::StaticOrder, true, true>(lds, g, S, E); }
    xcd_barrier(bar);
    { const float* gfn = a.in[I_FN]; f32x4 gv[4];
#pragma unroll
      for (int j = 0; j < 4; ++j) gv[j] = ((const f32x4*)gfn)[lane + 64 * j];
      for (int row = gw; row < M; row += NGW) { const float rs = row_rstd(part3, row); f32x4* rp = (f32x4*)(a.out + (size_t)row * D);
#pragma unroll
          for (int j = 0; j < 4; ++j) { f32x4 v = rp[lane + 64 * j]; rp[lane + 64 * j] = v * rs * gv[j]; } } }
}

extern "C" void kernel_launch(void* const* d_in, const int* in_sizes, int n_in, void* d_out, int out_size, void* d_ws, size_t ws_size, hipStream_t stream) {
    static int grid = 0;
    if (grid == 0) {
        if (n_in != 18 || in_sizes[0] != M * D || out_size != M * D || ws_size < WS_END) { fprintf(stderr, "kernel_launch: unexpected shapes (n_in %d, in0 %d, out %d, ws %zu < %zu)\n", n_in, n_in > 0 ? in_sizes[0] : -1, out_size, ws_size, (size_t)WS_END); grid = -1; return; }
        int dev = 0, cus = 0, per_cu = 0;
        if (hipGetDevice(&dev) != hipSuccess || hipDeviceGetAttribute(&cus, hipDeviceAttributeMultiprocessorCount, dev) != hipSuccess) { grid = -1; return; }
        if (hipFuncSetAttribute((const void*)fwd_mega, hipFuncAttributeMaxDynamicSharedMemorySize, LDS_BYTES) != hipSuccess) { fprintf(stderr, "kernel_launch: hipFuncSetAttribute failed\n"); grid = -1; return; }
        if (hipOccupancyMaxActiveBlocksPerMultiprocessor(&per_cu, (const void*)fwd_mega, NWAVES * 64, LDS_BYTES) != hipSuccess || per_cu < 1) { fprintf(stderr, "kernel_launch: occupancy query gave %d\n", per_cu); (void)hipGetLastError(); grid = -1; return; }
        grid = cus * per_cu;
    }
    if (grid < 0) return;
    Args a{};
    for (int i = 0; i < 18; ++i) a.in[i] = (const float*)d_in[i];
    a.out = (float*)d_out; a.ws = (unsigned char*)d_ws;
    void* args[] = {&a};
    const hipError_t e = hipLaunchCooperativeKernel((const void*)fwd_mega, dim3(grid), dim3(NWAVES * 64), args, LDS_BYTES, stream);
    if (e != hipSuccess) fprintf(stderr, "kernel_launch: cooperative launch failed: %s (grid %d)\n", hipGetErrorString(e), grid);
}
```

```cpp
#include <hip/hip_runtime.h>
#include <hip/hip_cooperative_groups.h>
#include <cstdio>
#include <cstdint>
#include <cmath>
namespace cg = cooperative_groups;
namespace pg8 {
#define PG8_LAS __attribute__((address_space(3)))
typedef unsigned short bf16_t;
typedef short bf16x8 __attribute__((ext_vector_type(8)));
typedef float f32x4 __attribute__((ext_vector_type(4)));
typedef unsigned u32x4 __attribute__((ext_vector_type(4)));
constexpr int BM = 256, BK = 64, HALF = 128, HTB = HALF * BK * 2  , STAGE_BYTES = 8 * HTB, NXCD = 8, WGM = 8;

__host__ __device__ __forceinline__ int lds_byte(int r, int c) { const int st = (r >> 4) * 2 + (c >> 5), rr = r & 15, cc = c & 31, ob = rr * 64 + cc * 2; return st * 1024 + (ob ^ (((ob >> 9) & 1) << 5)); }
__host__ __device__ __forceinline__ void stage_rc(int b, int& R, int& C) { const int st = b / 1024, sb = b % 1024, swz = sb ^ (((sb >> 9) & 1) << 5); R = (st >> 1) * 16 + swz / 64; C = (st & 1) * 32 + (swz % 64) / 2; }
__host__ __device__ __forceinline__ int perm32(int rho) { const int n = rho >> 4, i = rho & 15; return 8 * (i >> 2) + 4 * n + (i & 3); }

struct Unit { int pm, pn; };
struct Gemm { const bf16_t* A; const bf16_t* Bt; int M, N, K; };

struct StaticOrder {
    int nM, nN, nwg, G, c;
    __host__ __device__ void init(int M, int N, int G_, int c_) { nM = M / BM; nN = N / BM; nwg = nM * nN; G = G_; c = c_; }
    __host__ __device__ bool next(int i, Unit& u) const {
        const long L = (long)i * G + c; if (L >= nwg) return false;
        int wgid = (int)L; { const int q = nwg / NXCD, r = nwg % NXCD, xcd = wgid % NXCD, off = wgid / NXCD; wgid = (xcd < r ? xcd * (q + 1) : r * (q + 1) + (xcd - r) * q) + off; }
        const int nig = WGM * nN, gid = wgid / nig, fm = gid * WGM, gsz = (nM - fm) < WGM ? (nM - fm) : WGM;
        u.pm = fm + ((wgid % nig) % gsz); u.pn = (wgid % nig) / gsz; return true;
    }
    __device__ __forceinline__ void a_ready(const Unit&) const {}
    __device__ __forceinline__ void done(const Unit&) const {}
};

__device__ __forceinline__ unsigned cvt_pk_bf16(float lo, float hi) { unsigned r; asm volatile("v_cvt_pk_bf16_f32 %0, %1, %2" : "=v"(r) : "v"(lo), "v"(hi)); return r; }
typedef float f32x2 __attribute__((ext_vector_type(2)));
template <class Epi, class Sched, bool ALIGN_EPI = false, bool SP2 = false>
__device__ __forceinline__ void gemm_phase(PG8_LAS unsigned char* lds, const Gemm g, const Sched& S, const Epi& E) {
    const int tid = threadIdx.x, wid = __builtin_amdgcn_readfirstlane(tid >> 6), lane = tid & 63, wr = wid >> 2, wc = wid & 3, fr = lane & 15, fq = lane >> 4;
    const int K = g.K, nt = K / BK;
    unsigned voffA[2], voffB[2];
#pragma unroll
    for (int i = 0; i < 2; ++i) { int R, C; stage_rc(tid * 16 + i * 8192, R, C); const int Rb = Epi::PERM ? ((R & ~31) + perm32(R & 31)) : R;
        voffA[i] = (unsigned)(R * K + C) * 2u; voffB[i] = (unsigned)(Rb * K + C) * 2u; }
    const size_t kstep = (size_t)(BK * 2);
    const size_t hstep = (size_t)HALF * K * 2;
    const size_t tstep = 2 * hstep;
    const unsigned ldsw = (unsigned)wid * 1024u;
    const int aoff = lds_byte(wr * 64 + fr, fq * 8), boff = lds_byte(wc * 32 + fr, fq * 8);
#define PG8_SA(b, h) (((b) * 2 + (h)) * HTB)
#define PG8_SB(b, h) ((4 + (b) * 2 + (h)) * HTB)
#define PG8_STAGE(bufoff, gbase, voff) do { _Pragma("unroll") for (int _i = 0; _i < 2; ++_i) \
        __builtin_amdgcn_global_load_lds((const unsigned*)((const char*)(gbase) + (voff)[_i]), (PG8_LAS unsigned*)(lds + (bufoff) + ldsw + _i * 8192), 16, 0, 0); } while (0)
#define PG8_LDA(dst, b, h) do { _Pragma("unroll") for (int m = 0; m < 4; ++m) _Pragma("unroll") for (int k = 0; k < 2; ++k) dst[m][k] = *(const PG8_LAS bf16x8*)(lds + PG8_SA(b, h) + aoff + m * 2048 + k * 1024); } while (0)
#define PG8_LDB(dst, b, h) do { _Pragma("unroll") for (int n = 0; n < 2; ++n) _Pragma("unroll") for (int k = 0; k < 2; ++k) dst[n][k] = *(const PG8_LAS bf16x8*)(lds + PG8_SB(b, h) + boff + n * 2048 + k * 1024); } while (0)
#define PG8_MMA(ai, bj, At, Bt) do { __builtin_amdgcn_s_setprio(1); _Pragma("unroll") for (int m = 0; m < 4; ++m) _Pragma("unroll") for (int n = 0; n < 2; ++n) _Pragma("unroll") for (int k = 0; k < 2; ++k) \
        acc[ai][bj][m][n] = __builtin_amdgcn_mfma_f32_16x16x32_bf16(Bt[n][k], At[m][k], acc[ai][bj][m][n], 0, 0, 0); __builtin_amdgcn_s_setprio(0); } while (0)
#define PG8_WAIT_V(n) asm volatile("s_waitcnt vmcnt(" #n ")" ::: "memory")
#define PG8_WAIT_L(n) asm volatile("s_waitcnt lgkmcnt(" #n ")" ::: "memory")
#define PG8_BAR __builtin_amdgcn_s_barrier()
#define PG8_SCHED __builtin_amdgcn_sched_barrier(0)
    Unit cur, nxt; int ui = 0;
    if (!S.next(0, cur)) return;
    f32x4 acc[2][2][4][2];
#pragma unroll
    for (int a = 0; a < 2; ++a)
#pragma unroll
        for (int b = 0; b < 2; ++b)
#pragma unroll
            for (int m = 0; m < 4; ++m)
#pragma unroll
                for (int n = 0; n < 2; ++n) acc[a][b][m][n] = (f32x4){0.f, 0.f, 0.f, 0.f};
    bf16x8 At[4][2], B0[2][2], B1[2][2];
    const char* cA = (const char*)g.A + (size_t)cur.pm * tstep; const char* cB = (const char*)g.Bt + (size_t)cur.pn * tstep;
    S.a_ready(cur);
    if constexpr (SP2) {
        PG8_STAGE(PG8_SB(0, 0), cB, voffB); PG8_STAGE(PG8_SB(0, 1), cB + hstep, voffB); PG8_STAGE(PG8_SA(0, 0), cA, voffA); PG8_STAGE(PG8_SA(0, 1), cA + hstep, voffA);
        if (wr == 1) PG8_BAR;
        PG8_WAIT_V(2); PG8_BAR;
        PG8_STAGE(PG8_SB(1, 0), cB + kstep, voffB); PG8_STAGE(PG8_SA(1, 0), cA + kstep, voffA); PG8_STAGE(PG8_SB(1, 1), cB + hstep + kstep, voffB);
        PG8_WAIT_V(6); PG8_BAR;
    } else {
        PG8_STAGE(PG8_SB(0, 0), cB, voffB); PG8_STAGE(PG8_SA(0, 0), cA, voffA); PG8_STAGE(PG8_SB(0, 1), cB + hstep, voffB); PG8_STAGE(PG8_SA(0, 1), cA + hstep, voffA);
        if (wr == 1) PG8_BAR;
        PG8_WAIT_V(4); PG8_BAR;
        PG8_STAGE(PG8_SB(1, 0), cB + kstep, voffB); PG8_STAGE(PG8_SA(1, 0), cA + kstep, voffA); PG8_STAGE(PG8_SB(1, 1), cB + hstep + kstep, voffB);
        PG8_WAIT_V(6); PG8_BAR;
    }
    for (;;) {
        const bool has_next = S.next(ui + 1, nxt);
        const char* nA = has_next ? (const char*)g.A + (size_t)nxt.pm * tstep : cA; const char* nB = has_next ? (const char*)g.Bt + (size_t)nxt.pn * tstep : cB;
        for (int t = 0; t < nt; t += 2) {
            const bool last = (t == nt - 2);
            const char* a1 = cA + (size_t)(t + 1) * kstep;
            const char* a2 = last ? nA : cA + (size_t)(t + 2) * kstep; const char* b2 = last ? nB : cB + (size_t)(t + 2) * kstep;
            const char* a3 = a2 + kstep; const char* b3 = b2 + kstep;
            if (last && has_next) S.a_ready(nxt);
            if constexpr (SP2) {
            PG8_LDB(B0, 0, 0); PG8_LDB(B1, 0, 1); PG8_SCHED; PG8_LDA(At, 0, 0); PG8_STAGE(PG8_SA(1, 1), a1 + hstep, voffA);
            PG8_WAIT_V(8); PG8_WAIT_L(0); PG8_BAR; PG8_MMA(0, 0, At, B0); PG8_MMA(0, 1, At, B1); PG8_BAR; PG8_SCHED;
            PG8_LDA(At, 0, 1); PG8_STAGE(PG8_SB(0, 0), b2, voffB); PG8_STAGE(PG8_SB(0, 1), b2 + hstep, voffB); PG8_STAGE(PG8_SA(0, 0), a2, voffA);
            PG8_WAIT_V(8); PG8_WAIT_L(0); PG8_BAR; PG8_MMA(1, 0, At, B0); PG8_MMA(1, 1, At, B1); PG8_BAR; PG8_SCHED;
            PG8_LDB(B0, 1, 0); PG8_LDB(B1, 1, 1); PG8_SCHED; PG8_LDA(At, 1, 0); PG8_STAGE(PG8_SA(0, 1), a2 + hstep, voffA);
            PG8_WAIT_V(8); PG8_WAIT_L(0); PG8_BAR; PG8_MMA(0, 0, At, B0); PG8_MMA(0, 1, At, B1); PG8_BAR; PG8_SCHED;
            PG8_LDA(At, 1, 1); PG8_STAGE(PG8_SB(1, 0), b3, voffB); PG8_STAGE(PG8_SB(1, 1), b3 + hstep, voffB); PG8_STAGE(PG8_SA(1, 0), a3, voffA);
            PG8_WAIT_V(8); PG8_WAIT_L(0); PG8_BAR; PG8_MMA(1, 0, At, B0); PG8_MMA(1, 1, At, B1); PG8_BAR; PG8_SCHED;
            } else {
            PG8_LDB(B0, 0, 0); PG8_SCHED; PG8_LDA(At, 0, 0); PG8_STAGE(PG8_SA(1, 1), a1 + hstep, voffA);
            PG8_WAIT_L(8); PG8_BAR; PG8_WAIT_L(0); PG8_MMA(0, 0, At, B0); PG8_BAR; PG8_SCHED;
            PG8_LDB(B1, 0, 1); PG8_STAGE(PG8_SB(0, 0), b2, voffB);
            PG8_BAR; PG8_WAIT_L(0); PG8_MMA(0, 1, At, B1); PG8_BAR;
            PG8_LDA(At, 0, 1); PG8_STAGE(PG8_SA(0, 0), a2, voffA);
            PG8_BAR; PG8_WAIT_L(0); PG8_MMA(1, 0, At, B0); PG8_BAR; PG8_SCHED;
            PG8_STAGE(PG8_SB(0, 1), b2 + hstep, voffB);
            PG8_WAIT_V(6); PG8_BAR; PG8_MMA(1, 1, At, B1); PG8_BAR;
            PG8_LDB(B0, 1, 0); PG8_SCHED; PG8_LDA(At, 1, 0); PG8_STAGE(PG8_SA(0, 1), a2 + hstep, voffA);
            PG8_WAIT_L(8); PG8_BAR; PG8_WAIT_L(0); PG8_MMA(0, 0, At, B0); PG8_BAR; PG8_SCHED;
            PG8_LDB(B1, 1, 1); PG8_STAGE(PG8_SB(1, 0), b3, voffB);
            PG8_BAR; PG8_WAIT_L(0); PG8_MMA(0, 1, At, B1); PG8_BAR;
            PG8_LDA(At, 1, 1); PG8_STAGE(PG8_SA(1, 0), a3, voffA);
            PG8_BAR; PG8_WAIT_L(0); PG8_MMA(1, 0, At, B0); PG8_BAR; PG8_SCHED;
            PG8_STAGE(PG8_SB(1, 1), b3 + hstep, voffB);
            PG8_WAIT_V(6); PG8_BAR; PG8_MMA(1, 1, At, B1); PG8_BAR;
            }
        }
        if constexpr (ALIGN_EPI) { if (wr == 0) PG8_BAR; }
        if constexpr (!Epi::AFTER_DRAIN) { E(acc, cur, wr, wc, fr, fq); S.done(cur); }
        if (!has_next) break;
#pragma unroll
        for (int a = 0; a < 2; ++a)
#pragma unroll
            for (int b = 0; b < 2; ++b)
#pragma unroll
                for (int m = 0; m < 4; ++m)
#pragma unroll
                    for (int n = 0; n < 2; ++n) acc[a][b][m][n] = (f32x4){0.f, 0.f, 0.f, 0.f};
        cur = nxt; cA = nA; cB = nB; ++ui;
        if constexpr (ALIGN_EPI) { if (wr == 1) PG8_BAR; }
    }
    PG8_WAIT_V(0);
    if constexpr (!ALIGN_EPI) { if (wr == 0) PG8_BAR; }
    PG8_BAR;
    if constexpr (Epi::AFTER_DRAIN) { E.fused(acc, cur, wr, wc, fr, fq, lds, wid, lane); S.done(cur); }
#undef PG8_SA
#undef PG8_SB
#undef PG8_STAGE
#undef PG8_LDA
#undef PG8_LDB
#undef PG8_MMA
#undef PG8_WAIT_V
#undef PG8_WAIT_L
#undef PG8_BAR
#undef PG8_SCHED
}
}

using pg8::bf16_t; using pg8::bf16x8; using pg8::f32x4; using pg8::u32x4;
typedef float f32x16 __attribute__((ext_vector_type(16)));
typedef unsigned u32x2 __attribute__((ext_vector_type(2)));
#define LAS __attribute__((address_space(3)))
constexpr int D = 1024, BATCH = 4, SEQ = 8192, DFF = 2816, DH = 512, NH = 8;
constexpr int M = BATCH * SEQ;
constexpr int MP = M + 256;
constexpr int NMI = 3328;
constexpr float EPS = 1e-6f, LOG2E = 1.4426950408889634f;
constexpr int NWAVES = 8, LDS_BYTES = 147456;

constexpr size_t MiB = 1u << 20;
constexpr size_t WS_CTL = 0;
constexpr size_t WS_W1 = 2 * MiB, WS_W1O = 13 * MiB, WS_WMI = 19 * MiB, WS_WMO = 26 * MiB, WS_W2 = 28 * MiB, WS_W2O = 39 * MiB;
constexpr size_t WS_PART = 45 * MiB, PART_STRIDE = 2304 * 1024;
constexpr size_t WS_LOGF = 54 * MiB;
constexpr size_t WS_RESM = 56 * MiB;
constexpr size_t WS_XA = 58 * MiB;
constexpr size_t WS_XB = 123 * MiB;
constexpr size_t WS_ACT = 187 * MiB;
constexpr size_t QKV_STRIDE = (size_t)MP * DH * 2;
constexpr size_t WS_END = WS_ACT + (size_t)MP * DFF * 2;
static_assert(5 * QKV_STRIDE <= (size_t)MP * DFF * 2, "P3 outputs overlay the activation buffer");
static_assert((size_t)MP * 16 * 4 <= PART_STRIDE && WS_PART + 4 * PART_STRIDE <= WS_LOGF, "ws map");

__device__ __forceinline__ unsigned cvtpk(float lo, float hi) { return pg8::cvt_pk_bf16(lo, hi); }
__device__ __forceinline__ float bf_lo(unsigned u) { return __uint_as_float(u << 16); }
__device__ __forceinline__ float bf_hi(unsigned u) { return __uint_as_float(u & 0xffff0000u); }
__device__ __forceinline__ float wave_sum(float v) {
#pragma unroll
    for (int o = 1; o < 64; o <<= 1) v += __shfl_xor(v, o);
    return v;
}
__device__ __forceinline__ float row_rstd(const float* part, int row) {
    const f32x4* p = (const f32x4*)(part + (size_t)row * 16);
    const f32x4 a = p[0], b = p[1], c = p[2], d = p[3];
    const f32x4 s = (a + b) + (c + d);
    const float t = (s[0] + s[1]) + (s[2] + s[3]);
    return 1.0f / sqrtf(t * (1.0f / 1024.0f) + EPS);
}


struct EpiSwiGLU {
    static constexpr bool PERM = true, AFTER_DRAIN = false;
    bf16_t* O; const float* part;
    __device__ __forceinline__ void operator()(const f32x4 (&acc)[2][2][4][2], const pg8::Unit& u, int wr, int wc, int fr, int fq) const {
        const int row0 = u.pm * 256 + wr * 64 + fr, col0 = u.pn * 128 + wc * 32 + 8 * fq;
#pragma unroll
        for (int ai = 0; ai < 2; ++ai)
#pragma unroll
            for (int m = 0; m < 4; ++m) {
                const int row = row0 + ai * 128 + m * 16; const float rs = row_rstd(part, row);
                float a[8];
#pragma unroll
                for (int n = 0; n < 2; ++n)
#pragma unroll
                    for (int i = 0; i < 4; ++i) { const float g = acc[ai][0][m][n][i] * rs, up = acc[ai][1][m][n][i] * rs;
                        const float sg = __builtin_amdgcn_rcpf(1.0f + __builtin_amdgcn_exp2f(-g * LOG2E)); a[n * 4 + i] = g * sg * up; }
                u32x4 w; w.x = cvtpk(a[0], a[1]); w.y = cvtpk(a[2], a[3]); w.z = cvtpk(a[4], a[5]); w.w = cvtpk(a[6], a[7]);
                *(u32x4*)(O + (size_t)row * DFF + col0) = w;
            }
    }
};

template <bool F32OUT> struct EpiResid {
    static constexpr bool PERM = true, AFTER_DRAIN = false;
    const bf16_t* res; float* out; bf16_t* hb; float* part; float alpha;
    __device__ __forceinline__ void operator()(const f32x4 (&acc)[2][2][4][2], const pg8::Unit& u, int wr, int wc, int fr, int fq) const {
        const int row0 = u.pm * 256 + wr * 64 + fr, col0 = u.pn * 256 + wc * 32 + 8 * fq;
#pragma unroll
        for (int ai = 0; ai < 2; ++ai)
#pragma unroll
            for (int m = 0; m < 4; ++m) {
                const int row = row0 + ai * 128 + m * 16;
                float ss = 0.f;
#pragma unroll
                for (int bj = 0; bj < 2; ++bj) { const int c = col0 + 128 * bj;
                    const u32x4 rb = *(const u32x4*)(res + (size_t)row * D + c);
                    const f32x4 r0 = (f32x4){bf_lo(rb.x), bf_hi(rb.x), bf_lo(rb.y), bf_hi(rb.y)}, r1 = (f32x4){bf_lo(rb.z), bf_hi(rb.z), bf_lo(rb.w), bf_hi(rb.w)};
                    const f32x4 v0 = r0 + acc[ai][bj][m][0] * alpha, v1 = r1 + acc[ai][bj][m][1] * alpha;
                    if (F32OUT) { float* op = out + (size_t)row * D + c; *(f32x4*)op = v0; *(f32x4*)(op + 4) = v1; }
                    else { u32x4 w; w.x = cvtpk(v0[0], v0[1]); w.y = cvtpk(v0[2], v0[3]); w.z = cvtpk(v1[0], v1[1]); w.w = cvtpk(v1[2], v1[3]);
                        *(u32x4*)(hb + (size_t)row * D + c) = w; }
                    ss += (v0[0] * v0[0] + v0[1] * v0[1]) + (v0[2] * v0[2] + v0[3] * v0[3]) + (v1[0] * v1[0] + v1[1] * v1[1]) + (v1[2] * v1[2] + v1[3] * v1[3]); }
                ss += __shfl_xor(ss, 16); ss += __shfl_xor(ss, 32);
                if (fq == 0) part[(size_t)row * 16 + u.pn * 4 + wc] = ss;
            }
    }
};

struct EpiMixIn {
    static constexpr bool PERM = true, AFTER_DRAIN = false;
    bf16_t *Q, *K, *V, *B, *Z; float* logfT; const float* part; const float *qn, *kn, *bfg;
    __device__ __forceinline__ void operator()(const f32x4 (&acc)[2][2][4][2], const pg8::Unit& u, int wr, int wc, int fr, int fq) const {
        const int row0 = u.pm * 256 + wr * 64 + fr, pn = u.pn;
        if (pn < 4) {
            const float* gp = (pn < 2 ? qn : kn) + 8 * fq; bf16_t* base = pn < 2 ? Q : K; const float sc = pn < 2 ? 0.125f * LOG2E : 1.0f;
            const int head = (pn & 1) * 4 + wc;
            float g[2][8];
#pragma unroll
            for (int bj = 0; bj < 2; ++bj)
#pragma unroll
                for (int i = 0; i < 8; ++i) g[bj][i] = gp[bj * 32 + i] * sc;
#pragma unroll
            for (int ai = 0; ai < 2; ++ai)
#pragma unroll
                for (int m = 0; m < 4; ++m) {
                    const int row = row0 + ai * 128 + m * 16; const float rs = row_rstd(part, row);
                    float a[2][8]; float ss = 0.f;
#pragma unroll
                    for (int bj = 0; bj < 2; ++bj)
#pragma unroll
                        for (int i = 0; i < 8; ++i) { a[bj][i] = acc[ai][bj][m][i >> 2][i & 3] * rs; ss += a[bj][i] * a[bj][i]; }
                    ss += __shfl_xor(ss, 16); ss += __shfl_xor(ss, 32);
                    const float rr = 1.0f / sqrtf(ss * (1.0f / 64.0f) + EPS);
#pragma unroll
                    for (int bj = 0; bj < 2; ++bj) { u32x4 w;
                        w.x = cvtpk(a[bj][0] * rr * g[bj][0], a[bj][1] * rr * g[bj][1]); w.y = cvtpk(a[bj][2] * rr * g[bj][2], a[bj][3] * rr * g[bj][3]);
                        w.z = cvtpk(a[bj][4] * rr * g[bj][4], a[bj][5] * rr * g[bj][5]); w.w = cvtpk(a[bj][6] * rr * g[bj][6], a[bj][7] * rr * g[bj][7]);
                        *(u32x4*)(base + (size_t)row * DH + head * 64 + bj * 32 + 8 * fq) = w; }
                }
        } else if (pn < 8) {
            bf16_t* base = pn < 6 ? V : B; const int col0 = (pn & 1) * 256 + wc * 32 + 8 * fq;
#pragma unroll
            for (int ai = 0; ai < 2; ++ai)
#pragma unroll
                for (int m = 0; m < 4; ++m) {
                    const int row = row0 + ai * 128 + m * 16; const float rs = row_rstd(part, row);
#pragma unroll
                    for (int bj = 0; bj < 2; ++bj) { const f32x4 v0 = acc[ai][bj][m][0] * rs, v1 = acc[ai][bj][m][1] * rs; u32x4 w;
                        w.x = cvtpk(v0[0], v0[1]); w.y = cvtpk(v0[2], v0[3]); w.z = cvtpk(v1[0], v1[1]); w.w = cvtpk(v1[2], v1[3]);
                        *(u32x4*)(base + (size_t)row * DH + col0 + 128 * bj) = w; }
                }
        } else if (pn < 12) {
            const int col0 = (pn - 8) * 128 + wc * 32 + 8 * fq;
#pragma unroll
            for (int ai = 0; ai < 2; ++ai)
#pragma unroll
                for (int m = 0; m < 4; ++m) {
                    const int row = row0 + ai * 128 + m * 16; const float rs = row_rstd(part, row); const float r2 = rs * rs;
                    const f32x4 v0 = acc[ai][0][m][0] * acc[ai][1][m][0] * r2, v1 = acc[ai][0][m][1] * acc[ai][1][m][1] * r2; u32x4 w;
                    w.x = cvtpk(v0[0], v0[1]); w.y = cvtpk(v0[2], v0[3]); w.z = cvtpk(v1[0], v1[1]); w.w = cvtpk(v1[2], v1[3]);
                    *(u32x4*)(Z + (size_t)row * DH + col0) = w;
                }
        }
    }
};

__device__ __forceinline__ void conv_item(const float* W, int N, int K, bf16_t* WT, int dr0, int sc0, int nvalid, const float* ks, int kb, LAS float* scr, int lane) {
    const int k0 = 64 * kb, n = lane & 31;
#pragma unroll 8
    for (int i = 0; i < 32; ++i) { const int kk = 2 * i + (lane >> 5);
        float v = 0.f; if (n < nvalid) { v = W[(size_t)(k0 + kk) * N + sc0 + n]; if (ks) v *= ks[k0 + kk]; }
        scr[kk * 33 + n] = v; }
    asm volatile("s_waitcnt lgkmcnt(0)" ::: "memory");
    const int c = lane & 7;
#pragma unroll
    for (int j = 0; j < 4; ++j) { const int nn = (lane >> 3) + 8 * j; const LAS float* s = scr + (8 * c) * 33 + nn;
        u32x4 o; o.x = cvtpk(s[0 * 33], s[1 * 33]); o.y = cvtpk(s[2 * 33], s[3 * 33]); o.z = cvtpk(s[4 * 33], s[5 * 33]); o.w = cvtpk(s[6 * 33], s[7 * 33]);
        *(u32x4*)(WT + (size_t)(dr0 + nn) * K + k0 + 8 * c) = o; }
    asm volatile("s_waitcnt lgkmcnt(0)" ::: "memory");
}

struct Args { const float* in[18]; float* out; unsigned char* ws; };
enum { I_X = 0, I_META, I_F1N, I_F1WI, I_F1WO, I_MIXN, I_WMI, I_BF, I_QN, I_KN, I_CW, I_AON, I_CON, I_WMO, I_F2N, I_F2WI, I_F2WO, I_FN };

__device__ __forceinline__ void p0_prologue(const Args& a, LAS unsigned char* lds, int gw, int NGW, int wave, int lane) {
    unsigned char* ws = a.ws;
    LAS float* scr = (LAS float*)(lds + wave * 16384);
    constexpr int I_IN = (2 * DFF / 32) * (D / 64), I_OUT = (D / 32) * (DFF / 64), I_MI = (NMI / 32) * (D / 64), I_MO = (D / 32) * (D / 64);
    constexpr int NITEMS = 2 * I_IN + 2 * I_OUT + I_MI + I_MO;
    for (int it = gw; it < NITEMS; it += NGW) {
        int r = it;
        if (r < 2 * I_IN) { const int which = r >= I_IN; r -= which * I_IN; const int nblk = 2 * DFF / 32, kb = r / nblk, dr0 = (r % nblk) * 32;
            const int pn = dr0 >> 8, within = dr0 & 255, bj = within >> 7, i0 = within & 127;
            conv_item(a.in[which ? I_F2WI : I_F1WI], 2 * DFF, D, (bf16_t*)(ws + (which ? WS_W2 : WS_W1)), dr0, bj * DFF + pn * 128 + i0, 32, a.in[which ? I_F2N : I_F1N], kb, scr, lane); continue; }
        r -= 2 * I_IN;
        if (r < 2 * I_OUT) { const int which = r >= I_OUT; r -= which * I_OUT; const int nblk = D / 32, kb = r / nblk, dr0 = (r % nblk) * 32;
            conv_item(a.in[which ? I_F2WO : I_F1WO], D, DFF, (bf16_t*)(ws + (which ? WS_W2O : WS_W1O)), dr0, dr0, 32, nullptr, kb, scr, lane); continue; }
        r -= 2 * I_OUT;
        if (r < I_MI) { const int nblk = NMI / 32, kb = r / nblk, dr0 = (r % nblk) * 32;
            const int pn = dr0 >> 8, within = dr0 & 255, bj = within >> 7, i0 = within & 127, wcw = i0 >> 5;
            int sc0, nv = 32;
            if (pn < 4) sc0 = (pn >> 1) * 512 + ((pn & 1) * 4 + wcw) * 64 + bj * 32;
            else if (pn < 6) sc0 = dr0;
            else if (pn < 8) sc0 = 1544 + (dr0 - 1536);
            else if (pn < 12) sc0 = (bj ? 2568 : 2056) + 128 * (pn - 8) + i0;
            else { sc0 = 1536; nv = (dr0 == 3072) ? 8 : 0; }
            conv_item(a.in[I_WMI], 3080, D, (bf16_t*)(ws + WS_WMI), dr0, sc0, nv, a.in[I_MIXN], kb, scr, lane); continue; }
        r -= I_MI;
        { const int nblk = D / 32, kb = r / nblk, dr0 = (r % nblk) * 32;
          const float* ks = (kb < 8) ? a.in[I_AON] : a.in[I_CON] - 512;
          conv_item(a.in[I_WMO], D, D, (bf16_t*)(ws + WS_WMO), dr0, dr0, 32, ks, kb, scr, lane); }
    }
    bf16_t* XA = (bf16_t*)(ws + WS_XA); float* part0 = (float*)(ws + WS_PART);
    for (int row = gw; row < M + 16; row += NGW) {
        const float* src = row < M ? a.in[I_X] + (size_t)row * D : a.in[I_META] + (size_t)(row - M) * D;
        f32x4 v[4]; float ss = 0.f;
#pragma unroll
        for (int j = 0; j < 4; ++j) { v[j] = ((const f32x4*)src)[lane + 64 * j]; ss += (v[j][0] * v[j][0] + v[j][1] * v[j][1]) + (v[j][2] * v[j][2] + v[j][3] * v[j][3]); }
        ss = wave_sum(ss);
#pragma unroll
        for (int j = 0; j < 4; ++j) { u32x2 w; w.x = cvtpk(v[j][0], v[j][1]); w.y = cvtpk(v[j][2], v[j][3]); *(u32x2*)(XA + (size_t)row * D + 4 * (lane + 64 * j)) = w; }
        if (lane < 16) part0[(size_t)row * 16 + lane] = lane == 0 ? ss : 0.f;
    }
}


template <int NC> __device__ __forceinline__ void mini16(const bf16_t* X, int K, const bf16_t* W, const int (&wr)[NC], f32x4 (&acc)[NC], int lane) {
    const int r = lane & 15, q = lane >> 4;
    const bf16_t* xp = X + (size_t)r * K + 8 * q;
    const bf16_t* wp[NC];
#pragma unroll
    for (int c = 0; c < NC; ++c) { wp[c] = W + (size_t)(wr[c] + r) * K + 8 * q; acc[c] = (f32x4){0.f, 0.f, 0.f, 0.f}; }
#pragma unroll 4
    for (int k = 0; k < K; k += 32) { const bf16x8 xv = *(const bf16x8*)(xp + k);
#pragma unroll
        for (int c = 0; c < NC; ++c) { const bf16x8 wv = *(const bf16x8*)(wp[c] + k); acc[c] = __builtin_amdgcn_mfma_f32_16x16x32_bf16(wv, xv, acc[c], 0, 0, 0); } }
}
__device__ __forceinline__ float log_sigmoid(float x) { return fminf(x, 0.f) - __logf(1.0f + __expf(-fabsf(x))); }
__device__ __forceinline__ float meta_rstd(const float* mpart, int tok) {
    const f32x4* p = (const f32x4*)(mpart + tok * 64); f32x4 s = p[0];
#pragma unroll
    for (int i = 1; i < 16; ++i) s += p[i];
    return 1.0f / sqrtf(((s[0] + s[1]) + (s[2] + s[3])) * (1.0f / 1024.0f) + EPS);
}
__device__ __forceinline__ void meta_up(const bf16_t* XA, const bf16_t* W1, bf16_t* ACT, const float* part0, int item, int lane) {
    const int j0 = item * 16, ng = 256 * (j0 >> 7) + (j0 & 127); const int wr[2] = {ng, ng + 128}; f32x4 acc[2];
    mini16<2>(XA + (size_t)M * D, D, W1, wr, acc, lane);
    const int tok = lane & 15, nq = lane >> 4; const float rs = row_rstd(part0, M + tok); float a[4];
#pragma unroll
    for (int i = 0; i < 4; ++i) { const float g = acc[0][i] * rs, up = acc[1][i] * rs; a[i] = g * __builtin_amdgcn_rcpf(1.0f + __builtin_amdgcn_exp2f(-g * LOG2E)) * up; }
    u32x2 w; w.x = cvtpk(a[0], a[1]); w.y = cvtpk(a[2], a[3]); *(u32x2*)(ACT + (size_t)(M + tok) * DFF + j0 + 4 * nq) = w;
}
__device__ __forceinline__ void meta_down(const bf16_t* ACT, const bf16_t* W1O, const float* meta, bf16_t* XA, float* mpart, int item, int lane) {
    const int c0 = item * 16; const int wr[1] = {c0}; f32x4 acc[1];
    mini16<1>(ACT + (size_t)M * DFF, DFF, W1O, wr, acc, lane);
    const int tok = lane & 15, nq = lane >> 4; const f32x4 r = *(const f32x4*)(meta + (size_t)tok * D + c0 + 4 * nq); const f32x4 v = r + acc[0] * 0.5f;
    u32x2 w; w.x = cvtpk(v[0], v[1]); w.y = cvtpk(v[2], v[3]); *(u32x2*)(XA + (size_t)(M + tok) * D + c0 + 4 * nq) = w;
    float ss = (v[0] * v[0] + v[1] * v[1]) + (v[2] * v[2] + v[3] * v[3]); ss += __shfl_xor(ss, 16); ss += __shfl_xor(ss, 32);
    if (nq == 0) mpart[tok * 64 + item] = ss;
}
__device__ __forceinline__ void meta_mix(const bf16_t* XA, const bf16_t* WMI, bf16_t* K, bf16_t* V, bf16_t* Z, float* logfT, const float* mpart, const float* kn, const float* bfg, int item, int lane) {
    int wr[4];
    if (item < 8) { const int pn = 2 + (item >> 2), wc = item & 3;
#pragma unroll
        for (int c = 0; c < 4; ++c) wr[c] = 256 * pn + 128 * (c >> 1) + 32 * wc + 16 * (c & 1); }
    else if (item < 16) {
#pragma unroll
        for (int c = 0; c < 4; ++c) wr[c] = 1024 + (item - 8) * 64 + 16 * c; }
    else if (item < 32) { const int ch0 = (item - 16) * 32; wr[0] = 2048 + 256 * (ch0 >> 7) + (ch0 & 127); wr[1] = wr[0] + 16; wr[2] = wr[0] + 128; wr[3] = wr[1] + 128; }
    else { wr[0] = 3072; wr[1] = 3072; wr[2] = 3072; wr[3] = 3072; }
    f32x4 acc[4];
    mini16<4>(XA + (size_t)M * D, D, WMI, wr, acc, lane);
    const int tok = lane & 15, nq = lane >> 4; const float rs = meta_rstd(mpart, tok); const size_t row = (size_t)M + tok;
    if (item < 8) { float ss = 0.f;
#pragma unroll
        for (int c = 0; c < 4; ++c) { acc[c] = acc[c] * rs; ss += (acc[c][0] * acc[c][0] + acc[c][1] * acc[c][1]) + (acc[c][2] * acc[c][2] + acc[c][3] * acc[c][3]); }
        ss += __shfl_xor(ss, 16); ss += __shfl_xor(ss, 32); const float rr = 1.0f / sqrtf(ss * (1.0f / 64.0f) + EPS);
#pragma unroll
        for (int c = 0; c < 4; ++c) { const f32x4 g = *(const f32x4*)(kn + 16 * c + 4 * nq); const f32x4 v = acc[c] * rr * g; u32x2 w; w.x = cvtpk(v[0], v[1]); w.y = cvtpk(v[2], v[3]);
            *(u32x2*)(K + row * DH + item * 64 + 16 * c + 4 * nq) = w; } }
    else if (item < 16) {
#pragma unroll
        for (int c = 0; c < 4; ++c) { const f32x4 v = acc[c] * rs; u32x2 w; w.x = cvtpk(v[0], v[1]); w.y = cvtpk(v[2], v[3]); *(u32x2*)(V + row * DH + (item - 8) * 64 + 16 * c + 4 * nq) = w; } }
    else if (item < 32) { const float r2 = rs * rs;
#pragma unroll
        for (int c = 0; c < 2; ++c) { const f32x4 v = acc[c] * acc[2 + c] * r2; u32x2 w; w.x = cvtpk(v[0], v[1]); w.y = cvtpk(v[2], v[3]); *(u32x2*)(Z + row * DH + (item - 16) * 32 + 16 * c + 4 * nq) = w; } }
    else if (nq < 2) {
#pragma unroll
        for (int i = 0; i < 4; ++i) { const int h = 4 * nq + i; logfT[(size_t)h * MP + row] = log_sigmoid(acc[0][i] * rs + bfg[h]); } }
}
__device__ __forceinline__ void flog_rows(const bf16_t* XA, const bf16_t* WMI, float* logfT, const float* part1, const float* bfg, int item, int lane) {
    const int row0 = item * 16; const int wr[1] = {3072}; f32x4 acc[1];
    mini16<1>(XA + (size_t)row0 * D, D, WMI, wr, acc, lane);
    const int tok = lane & 15, nq = lane >> 4; const float rs = row_rstd(part1, row0 + tok);
    if (nq < 2) {
#pragma unroll
        for (int i = 0; i < 4; ++i) { const int h = 4 * nq + i; logfT[(size_t)h * MP + row0 + tok] = log_sigmoid(acc[0][i] * rs + bfg[h]); } }
}

struct MixP { const bf16_t *Q, *K, *V, *B, *Z; const float* logfT; const float* cw; bf16_t* out; float thresh; };

__device__ __forceinline__ void mixer_unit(const MixP& p, int b, int t0, LAS unsigned char* lds, int wave, int lane) {
    const int r32 = lane & 31, hi = lane >> 5, h = wave;
    LAS float* sc = (LAS float*)lds + wave * 64;
    LAS float* ssq = (LAS float*)(lds + 4096);
    const size_t rowq = (size_t)b * SEQ + t0;
    bf16x8 qf[4];
    { const bf16_t* qp = p.Q + (rowq + r32) * DH + h * 64 + 8 * hi;
#pragma unroll
      for (int ks = 0; ks < 4; ++ks) qf[ks] = *(const bf16x8*)(qp + 16 * ks); }
    float mrun = -INFINITY, l = 0.f; f32x16 o0, o1;
#pragma unroll
    for (int r = 0; r < 16; ++r) { o0[r] = 0.f; o1[r] = 0.f; }
    const int jd = t0 >> 6, T0 = jd << 6;
    float base = 0.f;
    for (int j = jd; j >= -1; --j) {
        if (j < jd && base < -p.thresh) break;
        const int nvalid = j >= 0 ? 64 : 16;
        const size_t krow0 = j >= 0 ? (size_t)b * SEQ + 64 * j : (size_t)M;
        const float Lv = lane < nvalid ? p.logfT[(size_t)h * MP + krow0 + lane] * LOG2E : 0.f;
        float P = Lv;
#pragma unroll
        for (int o = 1; o < 64; o <<= 1) { const float t = __shfl_up(P, o); if (lane >= o) P += t; }
        const float tot = __int_as_float(__builtin_amdgcn_readlane(__float_as_int(P), 63));
        const float p31 = __int_as_float(__builtin_amdgcn_readlane(__float_as_int(P), 31));
        const float bj = (j == jd) ? ((t0 > T0) ? p31 : 0.f) : base + tot;
        sc[lane] = bj - P; base = bj;
        f32x16 s0, s1;
#pragma unroll
        for (int r = 0; r < 16; ++r) { s0[r] = 0.f; s1[r] = 0.f; }
        { const bf16_t* kp = p.K + (krow0 + r32) * DH + h * 64 + 8 * hi;
#pragma unroll
          for (int ks = 0; ks < 4; ++ks) { const bf16x8 k0 = *(const bf16x8*)(kp + 16 * ks), k1 = *(const bf16x8*)(kp + 32 * DH + 16 * ks);
              s0 = __builtin_amdgcn_mfma_f32_32x32x16_bf16(k0, qf[ks], s0, 0, 0, 0); s1 = __builtin_amdgcn_mfma_f32_32x32x16_bf16(k1, qf[ks], s1, 0, 0, 0); } }
        asm volatile("s_waitcnt lgkmcnt(0)" ::: "memory");
#pragma unroll
        for (int g = 0; g < 4; ++g) { const f32x4 b0 = *(const LAS f32x4*)(sc + 8 * g + 4 * hi), b1 = *(const LAS f32x4*)(sc + 32 + 8 * g + 4 * hi);
#pragma unroll
            for (int i = 0; i < 4; ++i) { s0[4 * g + i] += b0[i]; s1[4 * g + i] += b1[i]; } }
        if (j == jd) { const int qa = t0 + r32 - T0;
#pragma unroll
            for (int r = 0; r < 16; ++r) { const int key = (r & 3) + 8 * (r >> 2) + 4 * hi; if (key > qa) s0[r] = -INFINITY; if (key + 32 > qa) s1[r] = -INFINITY; } }
        if (j < 0) {
#pragma unroll
            for (int r = 0; r < 16; ++r) { const int key = (r & 3) + 8 * (r >> 2) + 4 * hi; if (key >= 16) s0[r] = -INFINITY; s1[r] = -INFINITY; } }
        float mt = fmaxf(s0[0], s1[0]);
#pragma unroll
        for (int r = 1; r < 16; ++r) mt = fmaxf(mt, fmaxf(s0[r], s1[r]));
        mt = fmaxf(mt, __shfl_xor(mt, 32));
        const float mn = fmaxf(mrun, mt), al = __builtin_amdgcn_exp2f(mrun - mn); mrun = mn;
        float ps = 0.f;
#pragma unroll
        for (int r = 0; r < 16; ++r) { s0[r] = __builtin_amdgcn_exp2f(s0[r] - mn); s1[r] = __builtin_amdgcn_exp2f(s1[r] - mn); ps += s0[r] + s1[r]; }
        l = l * al + ps;
#pragma unroll
        for (int r = 0; r < 16; ++r) { o0[r] *= al; o1[r] *= al; }
#pragma unroll
        for (int g4 = 0; g4 < 4; ++g4) {
            if (j < 0 && g4 > 0) break;
            const int sub = g4 & 1; u32x4 pw;
            if (g4 < 2) { pw.x = cvtpk(s0[8 * sub + 0], s0[8 * sub + 1]); pw.y = cvtpk(s0[8 * sub + 2], s0[8 * sub + 3]); pw.z = cvtpk(s0[8 * sub + 4], s0[8 * sub + 5]); pw.w = cvtpk(s0[8 * sub + 6], s0[8 * sub + 7]); }
            else        { pw.x = cvtpk(s1[8 * sub + 0], s1[8 * sub + 1]); pw.y = cvtpk(s1[8 * sub + 2], s1[8 * sub + 3]); pw.z = cvtpk(s1[8 * sub + 4], s1[8 * sub + 5]); pw.w = cvtpk(s1[8 * sub + 6], s1[8 * sub + 7]); }
            const bf16x8 pf = __builtin_bit_cast(bf16x8, pw);
            const bf16_t* vp = p.V + (krow0 + 16 * g4 + 4 * hi) * DH + h * 64 + r32;
            bf16x8 v0, v1;
#pragma unroll
            for (int i = 0; i < 4; ++i) { v0[i] = (short)vp[i * DH]; v0[4 + i] = (short)vp[(8 + i) * DH]; v1[i] = (short)vp[i * DH + 32]; v1[4 + i] = (short)vp[(8 + i) * DH + 32]; }
            o0 = __builtin_amdgcn_mfma_f32_32x32x16_bf16(v0, pf, o0, 0, 0, 0); o1 = __builtin_amdgcn_mfma_f32_32x32x16_bf16(v1, pf, o1, 0, 0, 0);
        }
    }
    l += __shfl_xor(l, 32);
    const float inv = 1.0f / l; float ss = 0.f;
#pragma unroll
    for (int r = 0; r < 16; ++r) { o0[r] *= inv; o1[r] *= inv; ss += o0[r] * o0[r] + o1[r] * o1[r]; }
    ss += __shfl_xor(ss, 32);
    if (hi == 0) ssq[r32 * 8 + h] = ss;
    { const int c0 = lane * 8;
      float w0[8], w1[8], w2[8];
#pragma unroll
      for (int i = 0; i < 8; ++i) { w0[i] = p.cw[c0 + i]; w1[i] = p.cw[DH + c0 + i]; w2[i] = p.cw[2 * DH + c0 + i]; }
#pragma unroll 1
      for (int rr = 0; rr < 4; ++rr) { const int t = t0 + wave + 8 * rr; const size_t row = (size_t)b * SEQ + t;
          const size_t row1 = t >= 1 ? row - 1 : (size_t)M + 15, row2 = t >= 2 ? row - 2 : (size_t)M + 14 + t;
          const u32x4 z0 = *(const u32x4*)(p.Z + row * DH + c0), z1 = *(const u32x4*)(p.Z + row1 * DH + c0), z2 = *(const u32x4*)(p.Z + row2 * DH + c0), bv = *(const u32x4*)(p.B + row * DH + c0);
          float y[8]; float s2 = 0.f;
#pragma unroll
          for (int i = 0; i < 4; ++i) {
              y[2 * i] = bf_lo(bv[i]) * (w0[2 * i] * bf_lo(z2[i]) + w1[2 * i] * bf_lo(z1[i]) + w2[2 * i] * bf_lo(z0[i]));
              y[2 * i + 1] = bf_hi(bv[i]) * (w0[2 * i + 1] * bf_hi(z2[i]) + w1[2 * i + 1] * bf_hi(z1[i]) + w2[2 * i + 1] * bf_hi(z0[i]));
              s2 += y[2 * i] * y[2 * i] + y[2 * i + 1] * y[2 * i + 1]; }
          s2 = wave_sum(s2); const float rs = 1.0f / sqrtf(s2 * (1.0f / 512.0f) + EPS);
          u32x4 w; w.x = cvtpk(y[0] * rs, y[1] * rs); w.y = cvtpk(y[2] * rs, y[3] * rs); w.z = cvtpk(y[4] * rs, y[5] * rs); w.w = cvtpk(y[6] * rs, y[7] * rs);
          *(u32x4*)(p.out + row * D + DH + c0) = w; } }
    __syncthreads();
    { const f32x4 a = *(const LAS f32x4*)(ssq + r32 * 8), c = *(const LAS f32x4*)(ssq + r32 * 8 + 4);
      const float tot = ((a[0] + a[1]) + (a[2] + a[3])) + ((c[0] + c[1]) + (c[2] + c[3]));
      const float rs = 1.0f / sqrtf(tot * (1.0f / 512.0f) + EPS);
      bf16_t* op = p.out + (rowq + r32) * D + h * 64 + 4 * hi;
#pragma unroll
      for (int g = 0; g < 4; ++g) { u32x2 w;
          w.x = cvtpk(o0[4 * g] * rs, o0[4 * g + 1] * rs); w.y = cvtpk(o0[4 * g + 2] * rs, o0[4 * g + 3] * rs); *(u32x2*)(op + 8 * g) = w;
          w.x = cvtpk(o1[4 * g] * rs, o1[4 * g + 1] * rs); w.y = cvtpk(o1[4 * g + 2] * rs, o1[4 * g + 3] * rs); *(u32x2*)(op + 32 + 8 * g) = w; } }
    __syncthreads();
}

#define RLX_AGENT __ATOMIC_RELAXED, __HIP_MEMORY_SCOPE_AGENT
#define XB_TMO      128
#define XB_XCNT(j)  (256  + 64 * (j))
#define XB_XSUB(j)  (1280 + 64 * (j))
#define XB_XGEN(j)  (2304 + 64 * (j))
#define XB_TOP      3328
#define XB_TOPGEN   3392
#define XCD_BAR_WORDS 3456
#define XB_SPIN_CAP (1u << 18)

__device__ __forceinline__ unsigned xb_ld(unsigned* p)              { return __hip_atomic_load(p, __ATOMIC_RELAXED, __HIP_MEMORY_SCOPE_AGENT); }
__device__ __forceinline__ unsigned xb_add(unsigned* p, unsigned v) { return __hip_atomic_fetch_add(p, v, __ATOMIC_RELAXED, __HIP_MEMORY_SCOPE_AGENT); }
__device__ __forceinline__ unsigned xb_xcc_id() { return (unsigned)__builtin_amdgcn_s_getreg((3 << 11) | 20) & 0xFu; }
#define XB_SPIN(cond, bar) do { unsigned _sp = 0; while (cond) { __builtin_amdgcn_s_sleep(1); \
    if ((++_sp & 255u) == 0u) { if (xb_ld(&(bar)[XB_TMO])) break; if (_sp > XB_SPIN_CAP) { atomicAdd(&(bar)[XB_TMO], 1u); break; } } } } while (0)

struct XcdBarrier {
    unsigned* bar; unsigned x;
    volatile LAS unsigned* st;
};

__device__ __forceinline__ XcdBarrier xcd_barrier_post(unsigned* bar, volatile LAS unsigned* st) {
    XcdBarrier b; b.bar = bar; b.x = xb_xcc_id(); b.st = st;
    if (threadIdx.x == 0) (void)xb_add(&bar[XB_XCNT(b.x)], 1u);
    return b;
}
__device__ __forceinline__ void xcd_barrier_complete(unsigned* bar, unsigned x, unsigned& nloc, unsigned& nx) {
    const unsigned G = gridDim.x * gridDim.y * gridDim.z;
    unsigned sum, cnt, mine, sp = 0u;
    for (;;) {
        sum = 0u; cnt = 0u; mine = 0u;
#pragma unroll
        for (unsigned j = 0; j < 16; ++j) { const unsigned c = xb_ld(&bar[XB_XCNT(j)]); sum += c; cnt += (c > 0u) ? 1u : 0u; mine = (j == x) ? c : mine; }
        if (sum == G) break;
        __builtin_amdgcn_s_sleep(1);
        if ((++sp & 255u) == 0u) { if (xb_ld(&bar[XB_TMO])) break; if (sp > XB_SPIN_CAP) { atomicAdd(&bar[XB_TMO], 1u); break; } }
    }
    nloc = mine > 0u ? mine : 1u; nx = cnt > 0u ? cnt : 1u;
}

__device__ __forceinline__ void xcd_barrier(const XcdBarrier& b) {
    asm volatile("s_waitcnt vmcnt(0)" ::: "memory");
    __syncthreads();
    if (threadIdx.x == 0) {
        unsigned* bar = b.bar;
        __builtin_amdgcn_s_waitcnt(0);
        unsigned nloc = b.st[0], nx = b.st[1];
        if (nloc == 0u) { xcd_barrier_complete(bar, b.x, nloc, nx); b.st[0] = nloc; b.st[1] = nx; }
        const unsigned old = xb_add(&bar[XB_XSUB(b.x)], 1u);
        const unsigned gen = old / nloc;
        if (old + 1u == (gen + 1u) * nloc) {
            __builtin_amdgcn_fence(__ATOMIC_RELEASE, "agent");
            asm volatile("s_waitcnt vmcnt(0)" ::: "memory");
            const unsigned og = xb_add(&bar[XB_TOP], 1u);
            const unsigned tg = og / nx;
            if (og + 1u == (tg + 1u) * nx) xb_add(&bar[XB_TOPGEN], 1u);
            else XB_SPIN(xb_ld(&bar[XB_TOPGEN]) == tg, bar);
            __builtin_amdgcn_fence(__ATOMIC_ACQUIRE, "agent");
            xb_add(&bar[XB_XGEN(b.x)], 1u);
            asm volatile("s_waitcnt vmcnt(0)" ::: "memory");
        } else {
            XB_SPIN(xb_ld(&bar[XB_XGEN(b.x)]) == gen, bar);
            __builtin_amdgcn_fence(__ATOMIC_ACQUIRE, "agent");
            asm volatile("s_waitcnt vmcnt(0)" ::: "memory");
        }
    }
    __syncthreads();
}

__global__ void __launch_bounds__(NWAVES * 64, 2) fwd_mega(Args a) {
    extern __shared__ __attribute__((aligned(16))) unsigned char lds_raw[];
    LAS unsigned char* lds = (LAS unsigned char*)lds_raw;
    cg::grid_group grid = cg::this_grid();
    const int tid = threadIdx.x, lane = tid & 63, wave = __builtin_amdgcn_readfirstlane(tid >> 6);
    const int G = gridDim.x, bx = blockIdx.x;
    const int vcu = (G % 8 == 0) ? (bx % 8) * (G / 8) + bx / 8 : bx;
    const int gw = vcu * NWAVES + wave, NGW = G * NWAVES;
    unsigned char* ws = a.ws;
    bf16_t *W1 = (bf16_t*)(ws + WS_W1), *W1O = (bf16_t*)(ws + WS_W1O), *WMI = (bf16_t*)(ws + WS_WMI), *WMO = (bf16_t*)(ws + WS_WMO), *W2 = (bf16_t*)(ws + WS_W2), *W2O = (bf16_t*)(ws + WS_W2O);
    bf16_t *XA = (bf16_t*)(ws + WS_XA), *XB = (bf16_t*)(ws + WS_XB), *ACT = (bf16_t*)(ws + WS_ACT);
    bf16_t *Qb = ACT, *Kb = (bf16_t*)(ws + WS_ACT + QKV_STRIDE), *Vb = (bf16_t*)(ws + WS_ACT + 2 * QKV_STRIDE), *Bb = (bf16_t*)(ws + WS_ACT + 3 * QKV_STRIDE), *Zb = (bf16_t*)(ws + WS_ACT + 4 * QKV_STRIDE);
    float *part0 = (float*)(ws + WS_PART), *part1 = (float*)(ws + WS_PART + PART_STRIDE), *part2 = (float*)(ws + WS_PART + 2 * PART_STRIDE), *part3 = (float*)(ws + WS_PART + 3 * PART_STRIDE);
    float *logfT = (float*)(ws + WS_LOGF), *mpart = (float*)(ws + WS_RESM);

    volatile LAS unsigned* bst = (volatile LAS unsigned*)(lds + 131072 + 64);
    if (tid < 2) bst[tid] = 0u;
    unsigned* barw = (unsigned*)(ws + WS_CTL);
    if (bx == 0) for (int i = tid; i < XCD_BAR_WORDS; i += NWAVES * 64) __hip_atomic_store(barw + i, 0u, __ATOMIC_RELAXED, __HIP_MEMORY_SCOPE_AGENT);
    __syncthreads();
    p0_prologue(a, lds, gw, NGW, wave, lane);
    grid.sync();
    const XcdBarrier bar = xcd_barrier_post(barw, bst);
    if (gw < 176) meta_up(XA, W1, ACT, part0, gw, lane);
    { pg8::Gemm g{XA, W1, M, 2 * DFF, D}; pg8::StaticOrder S; S.init(M, 2 * DFF, G, bx); EpiSwiGLU E{ACT, part0};
      pg8::gemm_phase<EpiSwiGLU, pg8::StaticOrder, true, true>(lds, g, S, E); }
    xcd_barrier(bar);
    if (gw < 64) meta_down(ACT, W1O, a.in[I_META], XA, mpart, gw, lane);
    { pg8::Gemm g{ACT, W1O, M, D, DFF}; pg8::StaticOrder S; S.init(M, D, G, bx); EpiResid<false> E{XA, nullptr, XA, part1, 0.5f};
      pg8::gemm_phase<EpiResid<false>, pg8::StaticOrder, true, true>(lds, g, S, E); }
    xcd_barrier(bar);
    if (gw < 33) meta_mix(XA, WMI, Kb, Vb, Zb, logfT, mpart, a.in[I_KN], a.in[I_BF], gw, lane);
    for (int it = gw; it < M / 16; it += NGW) flog_rows(XA, WMI, logfT, part1, a.in[I_BF], it, lane);
    { pg8::Gemm g{XA, WMI, M, 3072, D}; pg8::StaticOrder S; S.init(M, 3072, G, bx); EpiMixIn E{Qb, Kb, Vb, Bb, Zb, logfT, part1, a.in[I_QN], a.in[I_KN], a.in[I_BF]};
      pg8::gemm_phase<EpiMixIn, pg8::StaticOrder, true, true>(lds, g, S, E); }
    xcd_barrier(bar);
    { float gq = fabsf(a.in[I_QN][lane]), gk = fabsf(a.in[I_KN][lane]);
#pragma unroll
      for (int o = 1; o < 64; o <<= 1) { gq = fmaxf(gq, __shfl_xor(gq, o)); gk = fmaxf(gk, __shfl_xor(gk, o)); }
      MixP mp{Qb, Kb, Vb, Bb, Zb, logfT, a.in[I_CW], XB, 2.0f * (8.0f * gq * gk * LOG2E * 1.05f) + 170.0f};
      constexpr int NU = M / 32;
      for (int u = vcu; u < NU; u += G) { const int b = u / (SEQ / 32), t0 = (u % (SEQ / 32)) * 32; mixer_unit(mp, b, t0, lds, wave, lane); } }
    xcd_barrier(bar);
    { pg8::Gemm g{XB, WMO, M, D, D}; pg8::StaticOrder S; S.init(M, D, G, bx); EpiResid<false> E{XA, nullptr, XA, part2, 1.0f};
      pg8::gemm_phase<EpiResid<false>, pg8::StaticOrder, true, true>(lds, g, S, E); }
    xcd_barrier(bar);
    { pg8::Gemm g{XA, W2, M, 2 * DFF, D}; pg8::StaticOrder S; S.init(M, 2 * DFF, G, bx); EpiSwiGLU E{ACT, part2};
      pg8::gemm_phase<EpiSwiGLU, pg8::StaticOrder, true, true>(lds, g, S, E); }
    xcd_barrier(bar);
    { pg8::Gemm g{ACT, W2O, M, D, DFF}; pg8::StaticOrder S; S.init(M, D, G, bx); EpiResid<true> E{XA, a.out, nullptr, part3, 0.5f};
      pg8::gemm_phase<EpiResid<true>, pg8::StaticOrder, true, true>(lds, g, S, E); }
    xcd_barrier(bar);
    { const float* gfn = a.in[I_FN]; f32x4 gv[4];
#pragma unroll
      for (int j = 0; j < 4; ++j) gv[j] = ((const f32x4*)gfn)[lane + 64 * j];
      for (int row = gw; row < M; row += NGW) { const float rs = row_rstd(part3, row); f32x4* rp = (f32x4*)(a.out + (size_t)row * D);
#pragma unroll
          for (int j = 0; j < 4; ++j) { f32x4 v = rp[lane + 64 * j]; rp[lane + 64 * j] = v * rs * gv[j]; } } }
}

extern "C" void kernel_launch(void* const* d_in, const int* in_sizes, int n_in, void* d_out, int out_size, void* d_ws, size_t ws_size, hipStream_t stream) {
    static int grid = 0;
    if (grid == 0) {
        if (n_in != 18 || in_sizes[0] != M * D || out_size != M * D || ws_size < WS_END) { fprintf(stderr, "kernel_launch: unexpected shapes (n_in %d, in0 %d, out %d, ws %zu < %zu)\n", n_in, n_in > 0 ? in_sizes[0] : -1, out_size, ws_size, (size_t)WS_END); grid = -1; return; }
        int dev = 0, cus = 0, per_cu = 0;
        if (hipGetDevice(&dev) != hipSuccess || hipDeviceGetAttribute(&cus, hipDeviceAttributeMultiprocessorCount, dev) != hipSuccess) { grid = -1; return; }
        if (hipFuncSetAttribute((const void*)fwd_mega, hipFuncAttributeMaxDynamicSharedMemorySize, LDS_BYTES) != hipSuccess) { fprintf(stderr, "kernel_launch: hipFuncSetAttribute failed\n"); grid = -1; return; }
        if (hipOccupancyMaxActiveBlocksPerMultiprocessor(&per_cu, (const void*)fwd_mega, NWAVES * 64, LDS_BYTES) != hipSuccess || per_cu < 1) { fprintf(stderr, "kernel_launch: occupancy query gave %d\n", per_cu); (void)hipGetLastError(); grid = -1; return; }
        grid = cus * per_cu;
    }
    if (grid < 0) return;
    Args a{};
    for (int i = 0; i < 18; ++i) a.in[i] = (const float*)d_in[i];
    a.out = (float*)d_out; a.ws = (unsigned char*)d_ws;
    void* args[] = {&a};
    const hipError_t e = hipLaunchCooperativeKernel((const void*)fwd_mega, dim3(grid), dim3(NWAVES * 64), args, LDS_BYTES, stream);
    if (e != hipSuccess) fprintf(stderr, "kernel_launch: cooperative launch failed: %s (grid %d)\n", hipGetErrorString(e), grid);
}
```

```cpp
#include <hip/hip_runtime.h>
#include <hip/hip_cooperative_groups.h>
#include <cstdio>
#include <cstdint>
#include <cmath>
namespace cg = cooperative_groups;
namespace pg8 {
#define PG8_LAS __attribute__((address_space(3)))
typedef unsigned short bf16_t;
typedef short bf16x8 __attribute__((ext_vector_type(8)));
typedef float f32x4 __attribute__((ext_vector_type(4)));
typedef unsigned u32x4 __attribute__((ext_vector_type(4)));
constexpr int BM = 256, BK = 64, HALF = 128, HTB = HALF * BK * 2  , STAGE_BYTES = 8 * HTB, NXCD = 8, WGM = 8;

__host__ __device__ __forceinline__ int lds_byte(int r, int c) { const int st = (r >> 4) * 2 + (c >> 5), rr = r & 15, cc = c & 31, ob = rr * 64 + cc * 2; return st * 1024 + (ob ^ (((ob >> 9) & 1) << 5)); }
__host__ __device__ __forceinline__ void stage_rc(int b, int& R, int& C) { const int st = b / 1024, sb = b % 1024, swz = sb ^ (((sb >> 9) & 1) << 5); R = (st >> 1) * 16 + swz / 64; C = (st & 1) * 32 + (swz % 64) / 2; }
__host__ __device__ __forceinline__ int perm32(int rho) { const int n = rho >> 4, i = rho & 15; return 8 * (i >> 2) + 4 * n + (i & 3); }

struct Unit { int pm, pn; };
struct Gemm { const bf16_t* A; const bf16_t* Bt; int M, N, K; };

struct StaticOrder {
    int nM, nN, nwg, G, c;
    __host__ __device__ void init(int M, int N, int G_, int c_) { nM = M / BM; nN = N / BM; nwg = nM * nN; G = G_; c = c_; }
    __host__ __device__ bool next(int i, Unit& u) const {
        const long L = (long)i * G + c; if (L >= nwg) return false;
        int wgid = (int)L; { const int q = nwg / NXCD, r = nwg % NXCD, xcd = wgid % NXCD, off = wgid / NXCD; wgid = (xcd < r ? xcd * (q + 1) : r * (q + 1) + (xcd - r) * q) + off; }
        const int nig = WGM * nN, gid = wgid / nig, fm = gid * WGM, gsz = (nM - fm) < WGM ? (nM - fm) : WGM;
        u.pm = fm + ((wgid % nig) % gsz); u.pn = (wgid % nig) / gsz; return true;
    }
    __device__ __forceinline__ void a_ready(const Unit&) const {}
    __device__ __forceinline__ void done(const Unit&) const {}
};

__device__ __forceinline__ unsigned cvt_pk_bf16(float lo, float hi) { unsigned r; asm volatile("v_cvt_pk_bf16_f32 %0, %1, %2" : "=v"(r) : "v"(lo), "v"(hi)); return r; }
typedef float f32x2 __attribute__((ext_vector_type(2)));
template <class Epi, class Sched, bool ALIGN_EPI = false, bool SP2 = false>
__device__ __forceinline__ void gemm_phase(PG8_LAS unsigned char* lds, const Gemm g, const Sched& S, const Epi& E) {
    const int tid = threadIdx.x, wid = __builtin_amdgcn_readfirstlane(tid >> 6), lane = tid & 63, wr = wid >> 2, wc = wid & 3, fr = lane & 15, fq = lane >> 4;
    const int K = g.K, nt = K / BK;
    unsigned voffA[2], voffB[2];
#pragma unroll
    for (int i = 0; i < 2; ++i) { int R, C; stage_rc(tid * 16 + i * 8192, R, C); const int Rb = Epi::PERM ? ((R & ~31) + perm32(R & 31)) : R;
        voffA[i] = (unsigned)(R * K + C) * 2u; voffB[i] = (unsigned)(Rb * K + C) * 2u; }
    const size_t kstep = (size_t)(BK * 2);
    const size_t hstep = (size_t)HALF * K * 2;
    const size_t tstep = 2 * hstep;
    const unsigned ldsw = (unsigned)wid * 1024u;
    const int aoff = lds_byte(wr * 64 + fr, fq * 8), boff = lds_byte(wc * 32 + fr, fq * 8);
#define PG8_SA(b, h) (((b) * 2 + (h)) * HTB)
#define PG8_SB(b, h) ((4 + (b) * 2 + (h)) * HTB)
#define PG8_STAGE(bufoff, gbase, voff) do { _Pragma("unroll") for (int _i = 0; _i < 2; ++_i) \
        __builtin_amdgcn_global_load_lds((const unsigned*)((const char*)(gbase) + (voff)[_i]), (PG8_LAS unsigned*)(lds + (bufoff) + ldsw + _i * 8192), 16, 0, 0); } while (0)
#define PG8_LDA(dst, b, h) do { _Pragma("unroll") for (int m = 0; m < 4; ++m) _Pragma("unroll") for (int k = 0; k < 2; ++k) dst[m][k] = *(const PG8_LAS bf16x8*)(lds + PG8_SA(b, h) + aoff + m * 2048 + k * 1024); } while (0)
#define PG8_LDB(dst, b, h) do { _Pragma("unroll") for (int n = 0; n < 2; ++n) _Pragma("unroll") for (int k = 0; k < 2; ++k) dst[n][k] = *(const PG8_LAS bf16x8*)(lds + PG8_SB(b, h) + boff + n * 2048 + k * 1024); } while (0)
#define PG8_MMA(ai, bj, At, Bt) do { __builtin_amdgcn_s_setprio(1); _Pragma("unroll") for (int m = 0; m < 4; ++m) _Pragma("unroll") for (int n = 0; n < 2; ++n) _Pragma("unroll") for (int k = 0; k < 2; ++k) \
        acc[ai][bj][m][n] = __builtin_amdgcn_mfma_f32_16x16x32_bf16(Bt[n][k], At[m][k], acc[ai][bj][m][n], 0, 0, 0); __builtin_amdgcn_s_setprio(0); } while (0)
#define PG8_WAIT_V(n) asm volatile("s_waitcnt vmcnt(" #n ")" ::: "memory")
#define PG8_WAIT_L(n) asm volatile("s_waitcnt lgkmcnt(" #n ")" ::: "memory")
#define PG8_BAR __builtin_amdgcn_s_barrier()
#define PG8_SCHED __builtin_amdgcn_sched_barrier(0)
    Unit cur, nxt; int ui = 0;
    if (!S.next(0, cur)) return;
    f32x4 acc[2][2][4][2];
#pragma unroll
    for (int a = 0; a < 2; ++a)
#pragma unroll
        for (int b = 0; b < 2; ++b)
#pragma unroll
            for (int m = 0; m < 4; ++m)
#pragma unroll
                for (int n = 0; n < 2; ++n) acc[a][b][m][n] = (f32x4){0.f, 0.f, 0.f, 0.f};
    bf16x8 At[4][2], B0[2][2], B1[2][2];
    const char* cA = (const char*)g.A + (size_t)cur.pm * tstep; const char* cB = (const char*)g.Bt + (size_t)cur.pn * tstep;
    S.a_ready(cur);
    if constexpr (SP2) {
        PG8_STAGE(PG8_SB(0, 0), cB, voffB); PG8_STAGE(PG8_SB(0, 1), cB + hstep, voffB); PG8_STAGE(PG8_SA(0, 0), cA, voffA); PG8_STAGE(PG8_SA(0, 1), cA + hstep, voffA);
        if (wr == 1) PG8_BAR;
        PG8_WAIT_V(2); PG8_BAR;
        PG8_STAGE(PG8_SB(1, 0), cB + kstep, voffB); PG8_STAGE(PG8_SA(1, 0), cA + kstep, voffA); PG8_STAGE(PG8_SB(1, 1), cB + hstep + kstep, voffB);
        PG8_WAIT_V(6); PG8_BAR;
    } else {
        PG8_STAGE(PG8_SB(0, 0), cB, voffB); PG8_STAGE(PG8_SA(0, 0), cA, voffA); PG8_STAGE(PG8_SB(0, 1), cB + hstep, voffB); PG8_STAGE(PG8_SA(0, 1), cA + hstep, voffA);
        if (wr == 1) PG8_BAR;
        PG8_WAIT_V(4); PG8_BAR;
        PG8_STAGE(PG8_SB(1, 0), cB + kstep, voffB); PG8_STAGE(PG8_SA(1, 0), cA + kstep, voffA); PG8_STAGE(PG8_SB(1, 1), cB + hstep + kstep, voffB);
        PG8_WAIT_V(6); PG8_BAR;
    }
    for (;;) {
        const bool has_next = S.next(ui + 1, nxt);
        const char* nA = has_next ? (const char*)g.A + (size_t)nxt.pm * tstep : cA; const char* nB = has_next ? (const char*)g.Bt + (size_t)nxt.pn * tstep : cB;
        for (int t = 0; t < nt; t += 2) {
            const bool last = (t == nt - 2);
            const char* a1 = cA + (size_t)(t + 1) * kstep;
            const char* a2 = last ? nA : cA + (size_t)(t + 2) * kstep; const char* b2 = last ? nB : cB + (size_t)(t + 2) * kstep;
            const char* a3 = a2 + kstep; const char* b3 = b2 + kstep;
            if (last && has_next) S.a_ready(nxt);
            if constexpr (SP2) {
            PG8_LDB(B0, 0, 0); PG8_LDB(B1, 0, 1); PG8_SCHED; PG8_LDA(At, 0, 0); PG8_STAGE(PG8_SA(1, 1), a1 + hstep, voffA);
            PG8_WAIT_V(8); PG8_WAIT_L(0); PG8_BAR; PG8_MMA(0, 0, At, B0); PG8_MMA(0, 1, At, B1); PG8_BAR; PG8_SCHED;
            PG8_LDA(At, 0, 1); PG8_STAGE(PG8_SB(0, 0), b2, voffB); PG8_STAGE(PG8_SB(0, 1), b2 + hstep, voffB); PG8_STAGE(PG8_SA(0, 0), a2, voffA);
            PG8_WAIT_V(8); PG8_WAIT_L(0); PG8_BAR; PG8_MMA(1, 0, At, B0); PG8_MMA(1, 1, At, B1); PG8_BAR; PG8_SCHED;
            PG8_LDB(B0, 1, 0); PG8_LDB(B1, 1, 1); PG8_SCHED; PG8_LDA(At, 1, 0); PG8_STAGE(PG8_SA(0, 1), a2 + hstep, voffA);
            PG8_WAIT_V(8); PG8_WAIT_L(0); PG8_BAR; PG8_MMA(0, 0, At, B0); PG8_MMA(0, 1, At, B1); PG8_BAR; PG8_SCHED;
            PG8_LDA(At, 1, 1); PG8_STAGE(PG8_SB(1, 0), b3, voffB); PG8_STAGE(PG8_SB(1, 1), b3 + hstep, voffB); PG8_STAGE(PG8_SA(1, 0), a3, voffA);
            PG8_WAIT_V(8); PG8_WAIT_L(0); PG8_BAR; PG8_MMA(1, 0, At, B0); PG8_MMA(1, 1, At, B1); PG8_BAR; PG8_SCHED;
            } else {
            PG8_LDB(B0, 0, 0); PG8_SCHED; PG8_LDA(At, 0, 0); PG8_STAGE(PG8_SA(1, 1), a1 + hstep, voffA);
            PG8_WAIT_L(8); PG8_BAR; PG8_WAIT_L(0); PG8_MMA(0, 0, At, B0); PG8_BAR; PG8_SCHED;
            PG8_LDB(B1, 0, 1); PG8_STAGE(PG8_SB(0, 0), b2, voffB);
            PG8_BAR; PG8_WAIT_L(0); PG8_MMA(0, 1, At, B1); PG8_BAR;
            PG8_LDA(At, 0, 1); PG8_STAGE(PG8_SA(0, 0), a2, voffA);
            PG8_BAR; PG8_WAIT_L(0); PG8_MMA(1, 0, At, B0); PG8_BAR; PG8_SCHED;
            PG8_STAGE(PG8_SB(0, 1), b2 + hstep, voffB);
            PG8_WAIT_V(6); PG8_BAR; PG8_MMA(1, 1, At, B1); PG8_BAR;
            PG8_LDB(B0, 1, 0); PG8_SCHED; PG8_LDA(At, 1, 0); PG8_STAGE(PG8_SA(0, 1), a2 + hstep, voffA);
            PG8_WAIT_L(8); PG8_BAR; PG8_WAIT_L(0); PG8_MMA(0, 0, At, B0); PG8_BAR; PG8_SCHED;
            PG8_LDB(B1, 1, 1); PG8_STAGE(PG8_SB(1, 0), b3, voffB);
            PG8_BAR; PG8_WAIT_L(0); PG8_MMA(0, 1, At, B1); PG8_BAR;
            PG8_LDA(At, 1, 1); PG8_STAGE(PG8_SA(1, 0), a3, voffA);
            PG8_BAR; PG8_WAIT_L(0); PG8_MMA(1, 0, At, B0); PG8_BAR; PG8_SCHED;
            PG8_STAGE(PG8_SB(1, 1), b3 + hstep, voffB);
            PG8_WAIT_V(6); PG8_BAR; PG8_MMA(1, 1, At, B1); PG8_BAR;
            }
        }
        if constexpr (ALIGN_EPI) { if (wr == 0) PG8_BAR; }
        if constexpr (!Epi::AFTER_DRAIN) { E(acc, cur, wr, wc, fr, fq); S.done(cur); }
        if (!has_next) break;
#pragma unroll
        for (int a = 0; a < 2; ++a)
#pragma unroll
            for (int b = 0; b < 2; ++b)
#pragma unroll
                for (int m = 0; m < 4; ++m)
#pragma unroll
                    for (int n = 0; n < 2; ++n) acc[a][b][m][n] = (f32x4){0.f, 0.f, 0.f, 0.f};
        cur = nxt; cA = nA; cB = nB; ++ui;
        if constexpr (ALIGN_EPI) { if (wr == 1) PG8_BAR; }
    }
    PG8_WAIT_V(0);
    if constexpr (!ALIGN_EPI) { if (wr == 0) PG8_BAR; }
    PG8_BAR;
    if constexpr (Epi::AFTER_DRAIN) { E.fused(acc, cur, wr, wc, fr, fq, lds, wid, lane); S.done(cur); }
#undef PG8_SA
#undef PG8_SB
#undef PG8_STAGE
#undef PG8_LDA
#undef PG8_LDB
#undef PG8_MMA
#undef PG8_WAIT_V
#undef PG8_WAIT_L
#undef PG8_BAR
#undef PG8_SCHED
}
}

using pg8::bf16_t; using pg8::bf16x8; using pg8::f32x4; using pg8::u32x4;
typedef float f32x16 __attribute__((ext_vector_type(16)));
typedef unsigned u32x2 __attribute__((ext_vector_type(2)));
#define LAS __attribute__((address_space(3)))
constexpr int D = 1024, BATCH = 4, SEQ = 8192, DFF = 2816, DH = 512, NH = 8;
constexpr int M = BATCH * SEQ;
constexpr int MP = M + 256;
constexpr int NMI = 3328;
constexpr float EPS = 1e-6f, LOG2E = 1.4426950408889634f;
constexpr int NWAVES = 8, LDS_BYTES = 147456;

constexpr size_t MiB = 1u << 20;
constexpr size_t WS_CTL = 0;
constexpr size_t WS_W1 = 2 * MiB, WS_W1O = 13 * MiB, WS_WMI = 19 * MiB, WS_WMO = 26 * MiB, WS_W2 = 28 * MiB, WS_W2O = 39 * MiB;
constexpr size_t WS_PART = 45 * MiB, PART_STRIDE = 2304 * 1024;
constexpr size_t WS_LOGF = 54 * MiB;
constexpr size_t WS_RESM = 56 * MiB;
constexpr size_t WS_XA = 58 * MiB;
constexpr size_t WS_XB = 123 * MiB;
constexpr size_t WS_ACT = 187 * MiB;
constexpr size_t QKV_STRIDE = (size_t)MP * DH * 2;
constexpr size_t WS_END = WS_ACT + (size_t)MP * DFF * 2;
static_assert(5 * QKV_STRIDE <= (size_t)MP * DFF * 2, "P3 outputs overlay the activation buffer");
static_assert((size_t)MP * 16 * 4 <= PART_STRIDE && WS_PART + 4 * PART_STRIDE <= WS_LOGF, "ws map");

__device__ __forceinline__ unsigned cvtpk(float lo, float hi) { return pg8::cvt_pk_bf16(lo, hi); }
__device__ __forceinline__ float bf_lo(unsigned u) { return __uint_as_float(u << 16); }
__device__ __forceinline__ float bf_hi(unsigned u) { return __uint_as_float(u & 0xffff0000u); }
__device__ __forceinline__ float wave_sum(float v) {
#pragma unroll
    for (int o = 1; o < 64; o <<= 1) v += __shfl_xor(v, o);
    return v;
}
__device__ __forceinline__ float row_rstd(const float* part, int row) {
    const f32x4* p = (const f32x4*)(part + (size_t)row * 16);
    const f32x4 a = p[0], b = p[1], c = p[2], d = p[3];
    const f32x4 s = (a + b) + (c + d);
    const float t = (s[0] + s[1]) + (s[2] + s[3]);
    return 1.0f / sqrtf(t * (1.0f / 1024.0f) + EPS);
}


struct EpiSwiGLU {
    static constexpr bool PERM = true, AFTER_DRAIN = false;
    bf16_t* O; const float* part;
    __device__ __forceinline__ void operator()(const f32x4 (&acc)[2][2][4][2], const pg8::Unit& u, int wr, int wc, int fr, int fq) const {
        const int row0 = u.pm * 256 + wr * 64 + fr, col0 = u.pn * 128 + wc * 32 + 8 * fq;
#pragma unroll
        for (int ai = 0; ai < 2; ++ai)
#pragma unroll
            for (int m = 0; m < 4; ++m) {
                const int row = row0 + ai * 128 + m * 16; const float rs = row_rstd(part, row);
                float a[8];
#pragma unroll
                for (int n = 0; n < 2; ++n)
#pragma unroll
                    for (int i = 0; i < 4; ++i) { const float g = acc[ai][0][m][n][i] * rs, up = acc[ai][1][m][n][i] * rs;
                        const float sg = __builtin_amdgcn_rcpf(1.0f + __builtin_amdgcn_exp2f(-g * LOG2E)); a[n * 4 + i] = g * sg * up; }
                u32x4 w; w.x = cvtpk(a[0], a[1]); w.y = cvtpk(a[2], a[3]); w.z = cvtpk(a[4], a[5]); w.w = cvtpk(a[6], a[7]);
                *(u32x4*)(O + (size_t)row * DFF + col0) = w;
            }
    }
};

template <bool F32OUT> struct EpiResid {
    static constexpr bool PERM = true, AFTER_DRAIN = false;
    const bf16_t* res; float* out; bf16_t* hb; float* part; float alpha;
    __device__ __forceinline__ void operator()(const f32x4 (&acc)[2][2][4][2], const pg8::Unit& u, int wr, int wc, int fr, int fq) const {
        const int row0 = u.pm * 256 + wr * 64 + fr, col0 = u.pn * 256 + wc * 32 + 8 * fq;
#pragma unroll
        for (int ai = 0; ai < 2; ++ai)
#pragma unroll
            for (int m = 0; m < 4; ++m) {
                const int row = row0 + ai * 128 + m * 16;
                float ss = 0.f;
#pragma unroll
                for (int bj = 0; bj < 2; ++bj) { const int c = col0 + 128 * bj;
                    const u32x4 rb = *(const u32x4*)(res + (size_t)row * D + c);
                    const f32x4 r0 = (f32x4){bf_lo(rb.x), bf_hi(rb.x), bf_lo(rb.y), bf_hi(rb.y)}, r1 = (f32x4){bf_lo(rb.z), bf_hi(rb.z), bf_lo(rb.w), bf_hi(rb.w)};
                    const f32x4 v0 = r0 + acc[ai][bj][m][0] * alpha, v1 = r1 + acc[ai][bj][m][1] * alpha;
                    if (F32OUT) { float* op = out + (size_t)row * D + c; *(f32x4*)op = v0; *(f32x4*)(op + 4) = v1; }
                    else { u32x4 w; w.x = cvtpk(v0[0], v0[1]); w.y = cvtpk(v0[2], v0[3]); w.z = cvtpk(v1[0], v1[1]); w.w = cvtpk(v1[2], v1[3]);
                        *(u32x4*)(hb + (size_t)row * D + c) = w; }
                    ss += (v0[0] * v0[0] + v0[1] * v0[1]) + (v0[2] * v0[2] + v0[3] * v0[3]) + (v1[0] * v1[0] + v1[1] * v1[1]) + (v1[2] * v1[2] + v1[3] * v1[3]); }
                ss += __shfl_xor(ss, 16); ss += __shfl_xor(ss, 32);
                if (fq == 0) part[(size_t)row * 16 + u.pn * 4 + wc] = ss;
            }
    }
};

struct EpiMixIn {
    static constexpr bool PERM = true, AFTER_DRAIN = false;
    bf16_t *Q, *K, *V, *B, *Z; float* logfT; const float* part; const float *qn, *kn, *bfg;
    __device__ __forceinline__ void operator()(const f32x4 (&acc)[2][2][4][2], const pg8::Unit& u, int wr, int wc, int fr, int fq) const {
        const int row0 = u.pm * 256 + wr * 64 + fr, pn = u.pn;
        if (pn < 4) {
            const float* gp = (pn < 2 ? qn : kn) + 8 * fq; bf16_t* base = pn < 2 ? Q : K; const float sc = pn < 2 ? 0.125f * LOG2E : 1.0f;
            const int head = (pn & 1) * 4 + wc;
            float g[2][8];
#pragma unroll
            for (int bj = 0; bj < 2; ++bj)
#pragma unroll
                for (int i = 0; i < 8; ++i) g[bj][i] = gp[bj * 32 + i] * sc;
#pragma unroll
            for (int ai = 0; ai < 2; ++ai)
#pragma unroll
                for (int m = 0; m < 4; ++m) {
                    const int row = row0 + ai * 128 + m * 16; const float rs = row_rstd(part, row);
                    float a[2][8]; float ss = 0.f;
#pragma unroll
                    for (int bj = 0; bj < 2; ++bj)
#pragma unroll
                        for (int i = 0; i < 8; ++i) { a[bj][i] = acc[ai][bj][m][i >> 2][i & 3] * rs; ss += a[bj][i] * a[bj][i]; }
                    ss += __shfl_xor(ss, 16); ss += __shfl_xor(ss, 32);
                    const float rr = 1.0f / sqrtf(ss * (1.0f / 64.0f) + EPS);
#pragma unroll
                    for (int bj = 0; bj < 2; ++bj) { u32x4 w;
                        w.x = cvtpk(a[bj][0] * rr * g[bj][0], a[bj][1] * rr * g[bj][1]); w.y = cvtpk(a[bj][2] * rr * g[bj][2], a[bj][3] * rr * g[bj][3]);
                        w.z = cvtpk(a[bj][4] * rr * g[bj][4], a[bj][5] * rr * g[bj][5]); w.w = cvtpk(a[bj][6] * rr * g[bj][6], a[bj][7] * rr * g[bj][7]);
                        *(u32x4*)(base + (size_t)row * DH + head * 64 + bj * 32 + 8 * fq) = w; }
                }
        } else if (pn < 8) {
            bf16_t* base = pn < 6 ? V : B; const int col0 = (pn & 1) * 256 + wc * 32 + 8 * fq;
#pragma unroll
            for (int ai = 0; ai < 2; ++ai)
#pragma unroll
                for (int m = 0; m < 4; ++m) {
                    const int row = row0 + ai * 128 + m * 16; const float rs = row_rstd(part, row);
#pragma unroll
                    for (int bj = 0; bj < 2; ++bj) { const f32x4 v0 = acc[ai][bj][m][0] * rs, v1 = acc[ai][bj][m][1] * rs; u32x4 w;
                        w.x = cvtpk(v0[0], v0[1]); w.y = cvtpk(v0[2], v0[3]); w.z = cvtpk(v1[0], v1[1]); w.w = cvtpk(v1[2], v1[3]);
                        *(u32x4*)(base + (size_t)row * DH + col0 + 128 * bj) = w; }
                }
        } else if (pn < 12) {
            const int col0 = (pn - 8) * 128 + wc * 32 + 8 * fq;
#pragma unroll
            for (int ai = 0; ai < 2; ++ai)
#pragma unroll
                for (int m = 0; m < 4; ++m) {
                    const int row = row0 + ai * 128 + m * 16; const float rs = row_rstd(part, row); const float r2 = rs * rs;
                    const f32x4 v0 = acc[ai][0][m][0] * acc[ai][1][m][0] * r2, v1 = acc[ai][0][m][1] * acc[ai][1][m][1] * r2; u32x4 w;
                    w.x = cvtpk(v0[0], v0[1]); w.y = cvtpk(v0[2], v0[3]); w.z = cvtpk(v1[0], v1[1]); w.w = cvtpk(v1[2], v1[3]);
                    *(u32x4*)(Z + (size_t)row * DH + col0) = w;
                }
        }
    }
};

__device__ __forceinline__ void conv_item(const float* W, int N, int K, bf16_t* WT, int dr0, int sc0, int nvalid, const float* ks, int kb, LAS float* scr, int lane) {
    const int k0 = 64 * kb, n = lane & 31;
#pragma unroll 8
    for (int i = 0; i < 32; ++i) { const int kk = 2 * i + (lane >> 5);
        float v = 0.f; if (n < nvalid) { v = W[(size_t)(k0 + kk) * N + sc0 + n]; if (ks) v *= ks[k0 + kk]; }
        scr[kk * 33 + n] = v; }
    asm volatile("s_waitcnt lgkmcnt(0)" ::: "memory");
    const int c = lane & 7;
#pragma unroll
    for (int j = 0; j < 4; ++j) { const int nn = (lane >> 3) + 8 * j; const LAS float* s = scr + (8 * c) * 33 + nn;
        u32x4 o; o.x = cvtpk(s[0 * 33], s[1 * 33]); o.y = cvtpk(s[2 * 33], s[3 * 33]); o.z = cvtpk(s[4 * 33], s[5 * 33]); o.w = cvtpk(s[6 * 33], s[7 * 33]);
        *(u32x4*)(WT + (size_t)(dr0 + nn) * K + k0 + 8 * c) = o; }
    asm volatile("s_waitcnt lgkmcnt(0)" ::: "memory");
}

struct Args { const float* in[18]; float* out; unsigned char* ws; };
enum { I_X = 0, I_META, I_F1N, I_F1WI, I_F1WO, I_MIXN, I_WMI, I_BF, I_QN, I_KN, I_CW, I_AON, I_CON, I_WMO, I_F2N, I_F2WI, I_F2WO, I_FN };

__device__ __forceinline__ void p0_prologue(const Args& a, LAS unsigned char* lds, int gw, int NGW, int wave, int lane) {
    unsigned char* ws = a.ws;
    LAS float* scr = (LAS float*)(lds + wave * 16384);
    constexpr int I_IN = (2 * DFF / 32) * (D / 64), I_OUT = (D / 32) * (DFF / 64), I_MI = (NMI / 32) * (D / 64), I_MO = (D / 32) * (D / 64);
    constexpr int NITEMS = 2 * I_IN + 2 * I_OUT + I_MI + I_MO;
    for (int it = gw; it < NITEMS; it += NGW) {
        int r = it;
        if (r < 2 * I_IN) { const int which = r >= I_IN; r -= which * I_IN; const int nblk = 2 * DFF / 32, kb = r / nblk, dr0 = (r % nblk) * 32;
            const int pn = dr0 >> 8, within = dr0 & 255, bj = within >> 7, i0 = within & 127;
            conv_item(a.in[which ? I_F2WI : I_F1WI], 2 * DFF, D, (bf16_t*)(ws + (which ? WS_W2 : WS_W1)), dr0, bj * DFF + pn * 128 + i0, 32, a.in[which ? I_F2N : I_F1N], kb, scr, lane); continue; }
        r -= 2 * I_IN;
        if (r < 2 * I_OUT) { const int which = r >= I_OUT; r -= which * I_OUT; const int nblk = D / 32, kb = r / nblk, dr0 = (r % nblk) * 32;
            conv_item(a.in[which ? I_F2WO : I_F1WO], D, DFF, (bf16_t*)(ws + (which ? WS_W2O : WS_W1O)), dr0, dr0, 32, nullptr, kb, scr, lane); continue; }
        r -= 2 * I_OUT;
        if (r < I_MI) { const int nblk = NMI / 32, kb = r / nblk, dr0 = (r % nblk) * 32;
            const int pn = dr0 >> 8, within = dr0 & 255, bj = within >> 7, i0 = within & 127, wcw = i0 >> 5;
            int sc0, nv = 32;
            if (pn < 4) sc0 = (pn >> 1) * 512 + ((pn & 1) * 4 + wcw) * 64 + bj * 32;
            else if (pn < 6) sc0 = dr0;
            else if (pn < 8) sc0 = 1544 + (dr0 - 1536);
            else if (pn < 12) sc0 = (bj ? 2568 : 2056) + 128 * (pn - 8) + i0;
            else { sc0 = 1536; nv = (dr0 == 3072) ? 8 : 0; }
            conv_item(a.in[I_WMI], 3080, D, (bf16_t*)(ws + WS_WMI), dr0, sc0, nv, a.in[I_MIXN], kb, scr, lane); continue; }
        r -= I_MI;
        { const int nblk = D / 32, kb = r / nblk, dr0 = (r % nblk) * 32;
          const float* ks = (kb < 8) ? a.in[I_AON] : a.in[I_CON] - 512;
          conv_item(a.in[I_WMO], D, D, (bf16_t*)(ws + WS_WMO), dr0, dr0, 32, ks, kb, scr, lane); }
    }
    bf16_t* XA = (bf16_t*)(ws + WS_XA); float* part0 = (float*)(ws + WS_PART);
    for (int row = gw; row < M + 16; row += NGW) {
        const float* src = row < M ? a.in[I_X] + (size_t)row * D : a.in[I_META] + (size_t)(row - M) * D;
        f32x4 v[4]; float ss = 0.f;
#pragma unroll
        for (int j = 0; j < 4; ++j) { v[j] = ((const f32x4*)src)[lane + 64 * j]; ss += (v[j][0] * v[j][0] + v[j][1] * v[j][1]) + (v[j][2] * v[j][2] + v[j][3] * v[j][3]); }
        ss = wave_sum(ss);
#pragma unroll
        for (int j = 0; j < 4; ++j) { u32x2 w; w.x = cvtpk(v[j][0], v[j][1]); w.y = cvtpk(v[j][2], v[j][3]); *(u32x2*)(XA + (size_t)row * D + 4 * (lane + 64 * j)) = w; }
        if (lane < 16) part0[(size_t)row * 16 + lane] = lane == 0 ? ss : 0.f;
    }
}


template <int NC, int K> __device__ __forceinline__ void mini16(const bf16_t* X, const bf16_t* W, const int (&wr)[NC], f32x4 (&acc)[NC], LAS unsigned char* lds, int wave, int lane) {
    constexpr int KW = K / 8; static_assert(KW % 32 == 0, "K split");
    const int r = lane & 15, q = lane >> 4;
    const bf16_t* xp = X + (size_t)r * K + wave * KW + 8 * q;
    const bf16_t* wp[NC];
#pragma unroll
    for (int c = 0; c < NC; ++c) { wp[c] = W + (size_t)(wr[c] + r) * K + wave * KW + 8 * q; acc[c] = (f32x4){0.f, 0.f, 0.f, 0.f}; }
#pragma unroll
    for (int k = 0; k < KW; k += 32) { const bf16x8 xv = *(const bf16x8*)(xp + k);
#pragma unroll
        for (int c = 0; c < NC; ++c) { const bf16x8 wv = *(const bf16x8*)(wp[c] + k); acc[c] = __builtin_amdgcn_mfma_f32_16x16x32_bf16(wv, xv, acc[c], 0, 0, 0); } }
    LAS f32x4* P = (LAS f32x4*)lds;
#pragma unroll
    for (int c = 0; c < NC; ++c) P[(wave * NC + c) * 64 + lane] = acc[c];
    __syncthreads();
#pragma unroll
    for (int c = 0; c < NC; ++c) { f32x4 s = P[c * 64 + lane];
#pragma unroll
        for (int w = 1; w < 8; ++w) s += P[(w * NC + c) * 64 + lane];
        acc[c] = s; }
    __syncthreads();
}
__device__ __forceinline__ float log_sigmoid(float x) { return fminf(x, 0.f) - __logf(1.0f + __expf(-fabsf(x))); }
__device__ __forceinline__ float meta_rstd(const float* mpart, int tok) {
    const f32x4* p = (const f32x4*)(mpart + tok * 64); f32x4 s = p[0];
#pragma unroll
    for (int i = 1; i < 16; ++i) s += p[i];
    return 1.0f / sqrtf(((s[0] + s[1]) + (s[2] + s[3])) * (1.0f / 1024.0f) + EPS);
}
__device__ __forceinline__ void meta_up(const bf16_t* XA, const bf16_t* W1, bf16_t* ACT, const float* part0, int item, LAS unsigned char* lds, int wave, int lane) {
    const int j0 = item * 16, ng = 256 * (j0 >> 7) + (j0 & 127); const int wr[2] = {ng, ng + 128}; f32x4 acc[2];
    mini16<2, D>(XA + (size_t)M * D, W1, wr, acc, lds, wave, lane);
    if (wave != 0) return;
    const int tok = lane & 15, nq = lane >> 4; const float rs = row_rstd(part0, M + tok); float a[4];
#pragma unroll
    for (int i = 0; i < 4; ++i) { const float g = acc[0][i] * rs, up = acc[1][i] * rs; a[i] = g * __builtin_amdgcn_rcpf(1.0f + __builtin_amdgcn_exp2f(-g * LOG2E)) * up; }
    u32x2 w; w.x = cvtpk(a[0], a[1]); w.y = cvtpk(a[2], a[3]); *(u32x2*)(ACT + (size_t)(M + tok) * DFF + j0 + 4 * nq) = w;
}
__device__ __forceinline__ void meta_down(const bf16_t* ACT, const bf16_t* W1O, const float* meta, bf16_t* XA, float* mpart, int item, LAS unsigned char* lds, int wave, int lane) {
    const int c0 = item * 16; const int wr[1] = {c0}; f32x4 acc[1];
    mini16<1, DFF>(ACT + (size_t)M * DFF, W1O, wr, acc, lds, wave, lane);
    if (wave != 0) return;
    const int tok = lane & 15, nq = lane >> 4; const f32x4 r = *(const f32x4*)(meta + (size_t)tok * D + c0 + 4 * nq); const f32x4 v = r + acc[0] * 0.5f;
    u32x2 w; w.x = cvtpk(v[0], v[1]); w.y = cvtpk(v[2], v[3]); *(u32x2*)(XA + (size_t)(M + tok) * D + c0 + 4 * nq) = w;
    float ss = (v[0] * v[0] + v[1] * v[1]) + (v[2] * v[2] + v[3] * v[3]); ss += __shfl_xor(ss, 16); ss += __shfl_xor(ss, 32);
    if (nq == 0) mpart[tok * 64 + item] = ss;
}
__device__ __forceinline__ void meta_mix(const bf16_t* XA, const bf16_t* WMI, bf16_t* K, bf16_t* V, bf16_t* Z, float* logfT, const float* mpart, const float* kn, const float* bfg, int item, LAS unsigned char* lds, int wave, int lane) {
    int wr[4];
    if (item < 8) { const int pn = 2 + (item >> 2), wc = item & 3;
#pragma unroll
        for (int c = 0; c < 4; ++c) wr[c] = 256 * pn + 128 * (c >> 1) + 32 * wc + 16 * (c & 1); }
    else if (item < 16) {
#pragma unroll
        for (int c = 0; c < 4; ++c) wr[c] = 1024 + (item - 8) * 64 + 16 * c; }
    else if (item < 32) { const int ch0 = (item - 16) * 32; wr[0] = 2048 + 256 * (ch0 >> 7) + (ch0 & 127); wr[1] = wr[0] + 16; wr[2] = wr[0] + 128; wr[3] = wr[1] + 128; }
    else { wr[0] = 3072; wr[1] = 3072; wr[2] = 3072; wr[3] = 3072; }
    f32x4 acc[4];
    mini16<4, D>(XA + (size_t)M * D, WMI, wr, acc, lds, wave, lane);
    if (wave != 0) return;
    const int tok = lane & 15, nq = lane >> 4; const float rs = meta_rstd(mpart, tok); const size_t row = (size_t)M + tok;
    if (item < 8) { float ss = 0.f;
#pragma unroll
        for (int c = 0; c < 4; ++c) { acc[c] = acc[c] * rs; ss += (acc[c][0] * acc[c][0] + acc[c][1] * acc[c][1]) + (acc[c][2] * acc[c][2] + acc[c][3] * acc[c][3]); }
        ss += __shfl_xor(ss, 16); ss += __shfl_xor(ss, 32); const float rr = 1.0f / sqrtf(ss * (1.0f / 64.0f) + EPS);
#pragma unroll
        for (int c = 0; c < 4; ++c) { const f32x4 g = *(const f32x4*)(kn + 16 * c + 4 * nq); const f32x4 v = acc[c] * rr * g; u32x2 w; w.x = cvtpk(v[0], v[1]); w.y = cvtpk(v[2], v[3]);
            *(u32x2*)(K + row * DH + item * 64 + 16 * c + 4 * nq) = w; } }
    else if (item < 16) {
#pragma unroll
        for (int c = 0; c < 4; ++c) { const f32x4 v = acc[c] * rs; u32x2 w; w.x = cvtpk(v[0], v[1]); w.y = cvtpk(v[2], v[3]); *(u32x2*)(V + row * DH + (item - 8) * 64 + 16 * c + 4 * nq) = w; } }
    else if (item < 32) { const float r2 = rs * rs;
#pragma unroll
        for (int c = 0; c < 2; ++c) { const f32x4 v = acc[c] * acc[2 + c] * r2; u32x2 w; w.x = cvtpk(v[0], v[1]); w.y = cvtpk(v[2], v[3]); *(u32x2*)(Z + row * DH + (item - 16) * 32 + 16 * c + 4 * nq) = w; } }
    else if (nq < 2) {
#pragma unroll
        for (int i = 0; i < 4; ++i) { const int h = 4 * nq + i; logfT[(size_t)h * MP + row] = log_sigmoid(acc[0][i] * rs + bfg[h]); } }
}
__device__ __forceinline__ void flog_wg(const bf16_t* XA, const bf16_t* WMI, float* logfT, const float* part1, const float* bfg, int rowbase, LAS unsigned char* lds, int wave, int lane) {
    const int r = lane & 15, q = lane >> 4;
    const bf16_t* wp = WMI + (size_t)(3072 + r) * D + wave * 128 + 8 * q;
    bf16x8 wv[4];
#pragma unroll
    for (int s = 0; s < 4; ++s) wv[s] = *(const bf16x8*)(wp + 32 * s);
    LAS f32x4* P = (LAS f32x4*)lds;
#pragma unroll
    for (int g = 0; g < 8; ++g) { const bf16_t* xp = XA + (size_t)(rowbase + 16 * g + r) * D + wave * 128 + 8 * q; f32x4 acc = (f32x4){0.f, 0.f, 0.f, 0.f};
#pragma unroll
        for (int s = 0; s < 4; ++s) acc = __builtin_amdgcn_mfma_f32_16x16x32_bf16(wv[s], *(const bf16x8*)(xp + 32 * s), acc, 0, 0, 0);
        P[(wave * 8 + g) * 64 + lane] = acc; }
    __syncthreads();
    f32x4 s = P[wave * 64 + lane];
#pragma unroll
    for (int w = 1; w < 8; ++w) s += P[(w * 8 + wave) * 64 + lane];
    const int tok = lane & 15, nq = lane >> 4, row = rowbase + 16 * wave + tok; const float rs = row_rstd(part1, row);
    if (nq < 2) {
#pragma unroll
        for (int i = 0; i < 4; ++i) { const int h = 4 * nq + i; logfT[(size_t)h * MP + row] = log_sigmoid(s[i] * rs + bfg[h]); } }
    __syncthreads();
}

struct MixP { const bf16_t *Q, *K, *V, *B, *Z; const float* logfT; const float* cw; bf16_t* out; float thresh; };

__device__ __forceinline__ void mixer_unit(const MixP& p, int b, int t0, LAS unsigned char* lds, int wave, int lane) {
    const int r32 = lane & 31, hi = lane >> 5, h = wave;
    LAS float* sc = (LAS float*)lds + wave * 64;
    LAS float* ssq = (LAS float*)(lds + 4096);
    const size_t rowq = (size_t)b * SEQ + t0;
    bf16x8 qf[4];
    { const bf16_t* qp = p.Q + (rowq + r32) * DH + h * 64 + 8 * hi;
#pragma unroll
      for (int ks = 0; ks < 4; ++ks) qf[ks] = *(const bf16x8*)(qp + 16 * ks); }
    float mrun = -INFINITY, l = 0.f; f32x16 o0, o1;
#pragma unroll
    for (int r = 0; r < 16; ++r) { o0[r] = 0.f; o1[r] = 0.f; }
    const int jd = t0 >> 6, T0 = jd << 6;
    float base = 0.f;
    for (int j = jd; j >= -1; --j) {
        if (j < jd && base < -p.thresh) break;
        const int nvalid = j >= 0 ? 64 : 16;
        const size_t krow0 = j >= 0 ? (size_t)b * SEQ + 64 * j : (size_t)M;
        const float Lv = lane < nvalid ? p.logfT[(size_t)h * MP + krow0 + lane] * LOG2E : 0.f;
        float P = Lv;
#pragma unroll
        for (int o = 1; o < 64; o <<= 1) { const float t = __shfl_up(P, o); if (lane >= o) P += t; }
        const float tot = __int_as_float(__builtin_amdgcn_readlane(__float_as_int(P), 63));
        const float p31 = __int_as_float(__builtin_amdgcn_readlane(__float_as_int(P), 31));
        const float bj = (j == jd) ? ((t0 > T0) ? p31 : 0.f) : base + tot;
        sc[lane] = bj - P; base = bj;
        f32x16 s0, s1;
#pragma unroll
        for (int r = 0; r < 16; ++r) { s0[r] = 0.f; s1[r] = 0.f; }
        { const bf16_t* kp = p.K + (krow0 + r32) * DH + h * 64 + 8 * hi;
#pragma unroll
          for (int ks = 0; ks < 4; ++ks) { const bf16x8 k0 = *(const bf16x8*)(kp + 16 * ks), k1 = *(const bf16x8*)(kp + 32 * DH + 16 * ks);
              s0 = __builtin_amdgcn_mfma_f32_32x32x16_bf16(k0, qf[ks], s0, 0, 0, 0); s1 = __builtin_amdgcn_mfma_f32_32x32x16_bf16(k1, qf[ks], s1, 0, 0, 0); } }
        asm volatile("s_waitcnt lgkmcnt(0)" ::: "memory");
#pragma unroll
        for (int g = 0; g < 4; ++g) { const f32x4 b0 = *(const LAS f32x4*)(sc + 8 * g + 4 * hi), b1 = *(const LAS f32x4*)(sc + 32 + 8 * g + 4 * hi);
#pragma unroll
            for (int i = 0; i < 4; ++i) { s0[4 * g + i] += b0[i]; s1[4 * g + i] += b1[i]; } }
        if (j == jd) { const int qa = t0 + r32 - T0;
#pragma unroll
            for (int r = 0; r < 16; ++r) { const int key = (r & 3) + 8 * (r >> 2) + 4 * hi; if (key > qa) s0[r] = -INFINITY; if (key + 32 > qa) s1[r] = -INFINITY; } }
        if (j < 0) {
#pragma unroll
            for (int r = 0; r < 16; ++r) { const int key = (r & 3) + 8 * (r >> 2) + 4 * hi; if (key >= 16) s0[r] = -INFINITY; s1[r] = -INFINITY; } }
        float mt = fmaxf(s0[0], s1[0]);
#pragma unroll
        for (int r = 1; r < 16; ++r) mt = fmaxf(mt, fmaxf(s0[r], s1[r]));
        mt = fmaxf(mt, __shfl_xor(mt, 32));
        const float mn = fmaxf(mrun, mt), al = __builtin_amdgcn_exp2f(mrun - mn); mrun = mn;
        float ps = 0.f;
#pragma unroll
        for (int r = 0; r < 16; ++r) { s0[r] = __builtin_amdgcn_exp2f(s0[r] - mn); s1[r] = __builtin_amdgcn_exp2f(s1[r] - mn); ps += s0[r] + s1[r]; }
        l = l * al + ps;
#pragma unroll
        for (int r = 0; r < 16; ++r) { o0[r] *= al; o1[r] *= al; }
#pragma unroll
        for (int g4 = 0; g4 < 4; ++g4) {
            if (j < 0 && g4 > 0) break;
            const int sub = g4 & 1; u32x4 pw;
            if (g4 < 2) { pw.x = cvtpk(s0[8 * sub + 0], s0[8 * sub + 1]); pw.y = cvtpk(s0[8 * sub + 2], s0[8 * sub + 3]); pw.z = cvtpk(s0[8 * sub + 4], s0[8 * sub + 5]); pw.w = cvtpk(s0[8 * sub + 6], s0[8 * sub + 7]); }
            else        { pw.x = cvtpk(s1[8 * sub + 0], s1[8 * sub + 1]); pw.y = cvtpk(s1[8 * sub + 2], s1[8 * sub + 3]); pw.z = cvtpk(s1[8 * sub + 4], s1[8 * sub + 5]); pw.w = cvtpk(s1[8 * sub + 6], s1[8 * sub + 7]); }
            const bf16x8 pf = __builtin_bit_cast(bf16x8, pw);
            const bf16_t* vp = p.V + (krow0 + 16 * g4 + 4 * hi) * DH + h * 64 + r32;
            bf16x8 v0, v1;
#pragma unroll
            for (int i = 0; i < 4; ++i) { v0[i] = (short)vp[i * DH]; v0[4 + i] = (short)vp[(8 + i) * DH]; v1[i] = (short)vp[i * DH + 32]; v1[4 + i] = (short)vp[(8 + i) * DH + 32]; }
            o0 = __builtin_amdgcn_mfma_f32_32x32x16_bf16(v0, pf, o0, 0, 0, 0); o1 = __builtin_amdgcn_mfma_f32_32x32x16_bf16(v1, pf, o1, 0, 0, 0);
        }
    }
    l += __shfl_xor(l, 32);
    const float inv = 1.0f / l; float ss = 0.f;
#pragma unroll
    for (int r = 0; r < 16; ++r) { o0[r] *= inv; o1[r] *= inv; ss += o0[r] * o0[r] + o1[r] * o1[r]; }
    ss += __shfl_xor(ss, 32);
    if (hi == 0) ssq[r32 * 8 + h] = ss;
    { const int c0 = lane * 8;
      float w0[8], w1[8], w2[8];
#pragma unroll
      for (int i = 0; i < 8; ++i) { w0[i] = p.cw[c0 + i]; w1[i] = p.cw[DH + c0 + i]; w2[i] = p.cw[2 * DH + c0 + i]; }
#pragma unroll 1
      for (int rr = 0; rr < 4; ++rr) { const int t = t0 + wave + 8 * rr; const size_t row = (size_t)b * SEQ + t;
          const size_t row1 = t >= 1 ? row - 1 : (size_t)M + 15, row2 = t >= 2 ? row - 2 : (size_t)M + 14 + t;
          const u32x4 z0 = *(const u32x4*)(p.Z + row * DH + c0), z1 = *(const u32x4*)(p.Z + row1 * DH + c0), z2 = *(const u32x4*)(p.Z + row2 * DH + c0), bv = *(const u32x4*)(p.B + row * DH + c0);
          float y[8]; float s2 = 0.f;
#pragma unroll
          for (int i = 0; i < 4; ++i) {
              y[2 * i] = bf_lo(bv[i]) * (w0[2 * i] * bf_lo(z2[i]) + w1[2 * i] * bf_lo(z1[i]) + w2[2 * i] * bf_lo(z0[i]));
              y[2 * i + 1] = bf_hi(bv[i]) * (w0[2 * i + 1] * bf_hi(z2[i]) + w1[2 * i + 1] * bf_hi(z1[i]) + w2[2 * i + 1] * bf_hi(z0[i]));
              s2 += y[2 * i] * y[2 * i] + y[2 * i + 1] * y[2 * i + 1]; }
          s2 = wave_sum(s2); const float rs = 1.0f / sqrtf(s2 * (1.0f / 512.0f) + EPS);
          u32x4 w; w.x = cvtpk(y[0] * rs, y[1] * rs); w.y = cvtpk(y[2] * rs, y[3] * rs); w.z = cvtpk(y[4] * rs, y[5] * rs); w.w = cvtpk(y[6] * rs, y[7] * rs);
          *(u32x4*)(p.out + row * D + DH + c0) = w; } }
    __syncthreads();
    { const f32x4 a = *(const LAS f32x4*)(ssq + r32 * 8), c = *(const LAS f32x4*)(ssq + r32 * 8 + 4);
      const float tot = ((a[0] + a[1]) + (a[2] + a[3])) + ((c[0] + c[1]) + (c[2] + c[3]));
      const float rs = 1.0f / sqrtf(tot * (1.0f / 512.0f) + EPS);
      bf16_t* op = p.out + (rowq + r32) * D + h * 64 + 4 * hi;
#pragma unroll
      for (int g = 0; g < 4; ++g) { u32x2 w;
          w.x = cvtpk(o0[4 * g] * rs, o0[4 * g + 1] * rs); w.y = cvtpk(o0[4 * g + 2] * rs, o0[4 * g + 3] * rs); *(u32x2*)(op + 8 * g) = w;
          w.x = cvtpk(o1[4 * g] * rs, o1[4 * g + 1] * rs); w.y = cvtpk(o1[4 * g + 2] * rs, o1[4 * g + 3] * rs); *(u32x2*)(op + 32 + 8 * g) = w; } }
    __syncthreads();
}

#define RLX_AGENT __ATOMIC_RELAXED, __HIP_MEMORY_SCOPE_AGENT
#define XB_TMO      128
#define XB_XCNT(j)  (256  + 64 * (j))
#define XB_XSUB(j)  (1280 + 64 * (j))
#define XB_XGEN(j)  (2304 + 64 * (j))
#define XB_TOP      3328
#define XB_TOPGEN   3392
#define XCD_BAR_WORDS 3456
#define XB_SPIN_CAP (1u << 18)

__device__ __forceinline__ unsigned xb_ld(unsigned* p)              { return __hip_atomic_load(p, __ATOMIC_RELAXED, __HIP_MEMORY_SCOPE_AGENT); }
__device__ __forceinline__ unsigned xb_add(unsigned* p, unsigned v) { return __hip_atomic_fetch_add(p, v, __ATOMIC_RELAXED, __HIP_MEMORY_SCOPE_AGENT); }
__device__ __forceinline__ unsigned xb_xcc_id() { return (unsigned)__builtin_amdgcn_s_getreg((3 << 11) | 20) & 0xFu; }
#define XB_SPIN(cond, bar) do { unsigned _sp = 0; while (cond) { __builtin_amdgcn_s_sleep(1); \
    if ((++_sp & 255u) == 0u) { if (xb_ld(&(bar)[XB_TMO])) break; if (_sp > XB_SPIN_CAP) { atomicAdd(&(bar)[XB_TMO], 1u); break; } } } } while (0)

struct XcdBarrier {
    unsigned* bar; unsigned x;
    volatile LAS unsigned* st;
};

__device__ __forceinline__ XcdBarrier xcd_barrier_post(unsigned* bar, volatile LAS unsigned* st) {
    XcdBarrier b; b.bar = bar; b.x = xb_xcc_id(); b.st = st;
    if (threadIdx.x == 0) (void)xb_add(&bar[XB_XCNT(b.x)], 1u);
    return b;
}
__device__ __forceinline__ void xcd_barrier_complete(unsigned* bar, unsigned x, unsigned& nloc, unsigned& nx) {
    const unsigned G = gridDim.x * gridDim.y * gridDim.z;
    unsigned sum, cnt, mine, sp = 0u;
    for (;;) {
        sum = 0u; cnt = 0u; mine = 0u;
#pragma unroll
        for (unsigned j = 0; j < 16; ++j) { const unsigned c = xb_ld(&bar[XB_XCNT(j)]); sum += c; cnt += (c > 0u) ? 1u : 0u; mine = (j == x) ? c : mine; }
        if (sum == G) break;
        __builtin_amdgcn_s_sleep(1);
        if ((++sp & 255u) == 0u) { if (xb_ld(&bar[XB_TMO])) break; if (sp > XB_SPIN_CAP) { atomicAdd(&bar[XB_TMO], 1u); break; } }
    }
    nloc = mine > 0u ? mine : 1u; nx = cnt > 0u ? cnt : 1u;
}

__device__ __forceinline__ void xcd_barrier(const XcdBarrier& b) {
    asm volatile("s_waitcnt vmcnt(0)" ::: "memory");
    __syncthreads();
    if (threadIdx.x == 0) {
        unsigned* bar = b.bar;
        __builtin_amdgcn_s_waitcnt(0);
        unsigned nloc = b.st[0], nx = b.st[1];
        if (nloc == 0u) { xcd_barrier_complete(bar, b.x, nloc, nx); b.st[0] = nloc; b.st[1] = nx; }
        const unsigned old = xb_add(&bar[XB_XSUB(b.x)], 1u);
        const unsigned gen = old / nloc;
        if (old + 1u == (gen + 1u) * nloc) {
            __builtin_amdgcn_fence(__ATOMIC_RELEASE, "agent");
            asm volatile("s_waitcnt vmcnt(0)" ::: "memory");
            const unsigned og = xb_add(&bar[XB_TOP], 1u);
            const unsigned tg = og / nx;
            if (og + 1u == (tg + 1u) * nx) xb_add(&bar[XB_TOPGEN], 1u);
            else XB_SPIN(xb_ld(&bar[XB_TOPGEN]) == tg, bar);
            __builtin_amdgcn_fence(__ATOMIC_ACQUIRE, "agent");
            xb_add(&bar[XB_XGEN(b.x)], 1u);
            asm volatile("s_waitcnt vmcnt(0)" ::: "memory");
        } else {
            XB_SPIN(xb_ld(&bar[XB_XGEN(b.x)]) == gen, bar);
            __builtin_amdgcn_fence(__ATOMIC_ACQUIRE, "agent");
            asm volatile("s_waitcnt vmcnt(0)" ::: "memory");
        }
    }
    __syncthreads();
}

__global__ void __launch_bounds__(NWAVES * 64, 2) fwd_mega(Args a) {
    extern __shared__ __attribute__((aligned(16))) unsigned char lds_raw[];
    LAS unsigned char* lds = (LAS unsigned char*)lds_raw;
    cg::grid_group grid = cg::this_grid();
    const int tid = threadIdx.x, lane = tid & 63, wave = __builtin_amdgcn_readfirstlane(tid >> 6);
    const int G = gridDim.x, bx = blockIdx.x;
    const int vcu = (G % 8 == 0) ? (bx % 8) * (G / 8) + bx / 8 : bx;
    const int gw = vcu * NWAVES + wave, NGW = G * NWAVES;
    unsigned char* ws = a.ws;
    bf16_t *W1 = (bf16_t*)(ws + WS_W1), *W1O = (bf16_t*)(ws + WS_W1O), *WMI = (bf16_t*)(ws + WS_WMI), *WMO = (bf16_t*)(ws + WS_WMO), *W2 = (bf16_t*)(ws + WS_W2), *W2O = (bf16_t*)(ws + WS_W2O);
    bf16_t *XA = (bf16_t*)(ws + WS_XA), *XB = (bf16_t*)(ws + WS_XB), *ACT = (bf16_t*)(ws + WS_ACT);
    bf16_t *Qb = ACT, *Kb = (bf16_t*)(ws + WS_ACT + QKV_STRIDE), *Vb = (bf16_t*)(ws + WS_ACT + 2 * QKV_STRIDE), *Bb = (bf16_t*)(ws + WS_ACT + 3 * QKV_STRIDE), *Zb = (bf16_t*)(ws + WS_ACT + 4 * QKV_STRIDE);
    float *part0 = (float*)(ws + WS_PART), *part1 = (float*)(ws + WS_PART + PART_STRIDE), *part2 = (float*)(ws + WS_PART + 2 * PART_STRIDE), *part3 = (float*)(ws + WS_PART + 3 * PART_STRIDE);
    float *logfT = (float*)(ws + WS_LOGF), *mpart = (float*)(ws + WS_RESM);

    volatile LAS unsigned* bst = (volatile LAS unsigned*)(lds + 131072 + 64);
    if (tid < 2) bst[tid] = 0u;
    unsigned* barw = (unsigned*)(ws + WS_CTL);
    if (bx == 0) for (int i = tid; i < XCD_BAR_WORDS; i += NWAVES * 64) __hip_atomic_store(barw + i, 0u, __ATOMIC_RELAXED, __HIP_MEMORY_SCOPE_AGENT);
    __syncthreads();
    p0_prologue(a, lds, gw, NGW, wave, lane);
    grid.sync();
    const XcdBarrier bar = xcd_barrier_post(barw, bst);
    if (vcu < 176) meta_up(XA, W1, ACT, part0, vcu, lds, wave, lane);
    { pg8::Gemm g{XA, W1, M, 2 * DFF, D}; pg8::StaticOrder S; S.init(M, 2 * DFF, G, bx); EpiSwiGLU E{ACT, part0};
      pg8::gemm_phase<EpiSwiGLU, pg8::StaticOrder, true, true>(lds, g, S, E); }
    xcd_barrier(bar);
    if (vcu < 64) meta_down(ACT, W1O, a.in[I_META], XA, mpart, vcu, lds, wave, lane);
    { pg8::Gemm g{ACT, W1O, M, D, DFF}; pg8::StaticOrder S; S.init(M, D, G, bx); EpiResid<false> E{XA, nullptr, XA, part1, 0.5f};
      pg8::gemm_phase<EpiResid<false>, pg8::StaticOrder, true, true>(lds, g, S, E); }
    xcd_barrier(bar);
    if (vcu < 33) meta_mix(XA, WMI, Kb, Vb, Zb, logfT, mpart, a.in[I_KN], a.in[I_BF], vcu, lds, wave, lane);
    for (int it = vcu; it < M / 128; it += G) flog_wg(XA, WMI, logfT, part1, a.in[I_BF], it * 128, lds, wave, lane);
    { pg8::Gemm g{XA, WMI, M, 3072, D}; pg8::StaticOrder S; S.init(M, 3072, G, bx); EpiMixIn E{Qb, Kb, Vb, Bb, Zb, logfT, part1, a.in[I_QN], a.in[I_KN], a.in[I_BF]};
      pg8::gemm_phase<EpiMixIn, pg8::StaticOrder, true, true>(lds, g, S, E); }
    xcd_barrier(bar);
    { float gq = fabsf(a.in[I_QN][lane]), gk = fabsf(a.in[I_KN][lane]);
#pragma unroll
      for (int o = 1; o < 64; o <<= 1) { gq = fmaxf(gq, __shfl_xor(gq, o)); gk = fmaxf(gk, __shfl_xor(gk, o)); }
      MixP mp{Qb, Kb, Vb, Bb, Zb, logfT, a.in[I_CW], XB, 2.0f * (8.0f * gq * gk * LOG2E * 1.05f) + 170.0f};
      constexpr int NU = M / 32;
      for (int u = vcu; u < NU; u += G) { const int b = u / (SEQ / 32), t0 = (u % (SEQ / 32)) * 32; mixer_unit(mp, b, t0, lds, wave, lane); } }
    xcd_barrier(bar);
    { pg8::Gemm g{XB, WMO, M, D, D}; pg8::StaticOrder S; S.init(M, D, G, bx); EpiResid<false> E{XA, nullptr, XA, part2, 1.0f};
      pg8::gemm_phase<EpiResid<false>, pg8::StaticOrder, true, true>(lds, g, S, E); }
    xcd_barrier(bar);
    { pg8::Gemm g{XA, W2, M, 2 * DFF, D}; pg8::StaticOrder S; S.init(M, 2 * DFF, G, bx); EpiSwiGLU E{ACT, part2};
      pg8::gemm_phase<EpiSwiGLU, pg8::StaticOrder, true, true>(lds, g, S, E); }
    xcd_barrier(bar);
    { pg8::Gemm g{ACT, W2O, M, D, DFF}; pg8::StaticOrder S; S.init(M, D, G, bx); EpiResid<false> E{XA, nullptr, XA, part3, 0.5f};
      pg8::gemm_phase<EpiResid<false>, pg8::StaticOrder, true, true>(lds, g, S, E); }
    xcd_barrier(bar);
    { const float* gfn = a.in[I_FN]; f32x4 gv[4];
#pragma unroll
      for (int j = 0; j < 4; ++j) gv[j] = ((const f32x4*)gfn)[lane + 64 * j];
      for (int row = gw; row < M; row += NGW) { const float rs = row_rstd(part3, row); f32x4* rp = (f32x4*)(a.out + (size_t)row * D); const u32x2* hp = (const u32x2*)(XA + (size_t)row * D);
#pragma unroll
          for (int j = 0; j < 4; ++j) { const u32x2 hv = hp[lane + 64 * j]; const f32x4 v = (f32x4){bf_lo(hv.x), bf_hi(hv.x), bf_lo(hv.y), bf_hi(hv.y)}; rp[lane + 64 * j] = v * rs * gv[j]; } } }
}

extern "C" void kernel_launch(void* const* d_in, const int* in_sizes, int n_in, void* d_out, int out_size, void* d_ws, size_t ws_size, hipStream_t stream) {
    static int grid = 0;
    if (grid == 0) {
        if (n_in != 18 || in_sizes[0] != M * D || out_size != M * D || ws_size < WS_END) { fprintf(stderr, "kernel_launch: unexpected shapes (n_in %d, in0 %d, out %d, ws %zu < %zu)\n", n_in, n_in > 0 ? in_sizes[0] : -1, out_size, ws_size, (size_t)WS_END); grid = -1; return; }
        int dev = 0, cus = 0, per_cu = 0;
        if (hipGetDevice(&dev) != hipSuccess || hipDeviceGetAttribute(&cus, hipDeviceAttributeMultiprocessorCount, dev) != hipSuccess) { grid = -1; return; }
        if (hipFuncSetAttribute((const void*)fwd_mega, hipFuncAttributeMaxDynamicSharedMemorySize, LDS_BYTES) != hipSuccess) { fprintf(stderr, "kernel_launch: hipFuncSetAttribute failed\n"); grid = -1; return; }
        if (hipOccupancyMaxActiveBlocksPerMultiprocessor(&per_cu, (const void*)fwd_mega, NWAVES * 64, LDS_BYTES) != hipSuccess || per_cu < 1) { fprintf(stderr, "kernel_launch: occupancy query gave %d\n", per_cu); (void)hipGetLastError(); grid = -1; return; }
        grid = cus * per_cu;
    }
    if (grid < 0) return;
    Args a{};
    for (int i = 0; i < 18; ++i) a.in[i] = (const float*)d_in[i];
    a.out = (float*)d_out; a.ws = (unsigned char*)d_ws;
    void* args[] = {&a};
    const hipError_t e = hipLaunchCooperativeKernel((const void*)fwd_mega, dim3(grid), dim3(NWAVES * 64), args, LDS_BYTES, stream);
    if (e != hipSuccess) fprintf(stderr, "kernel_launch: cooperative launch failed: %s (grid %d)\n", hipGetErrorString(e), grid);
}
```

```cpp
#include <hip/hip_runtime.h>
#include <hip/hip_cooperative_groups.h>
#include <cstdio>
#include <cstdint>
#include <cmath>
namespace cg = cooperative_groups;
namespace pg8 {
#define PG8_LAS __attribute__((address_space(3)))
typedef unsigned short bf16_t;
typedef short bf16x8 __attribute__((ext_vector_type(8)));
typedef float f32x4 __attribute__((ext_vector_type(4)));
typedef unsigned u32x4 __attribute__((ext_vector_type(4)));
constexpr int BM = 256, BK = 64, HALF = 128, HTB = HALF * BK * 2  , STAGE_BYTES = 8 * HTB, NXCD = 8, WGM = 8;

__host__ __device__ __forceinline__ int lds_byte(int r, int c) { const int st = (r >> 4) * 2 + (c >> 5), rr = r & 15, cc = c & 31, ob = rr * 64 + cc * 2; return st * 1024 + (ob ^ (((ob >> 9) & 1) << 5)); }
__host__ __device__ __forceinline__ void stage_rc(int b, int& R, int& C) { const int st = b / 1024, sb = b % 1024, swz = sb ^ (((sb >> 9) & 1) << 5); R = (st >> 1) * 16 + swz / 64; C = (st & 1) * 32 + (swz % 64) / 2; }
__host__ __device__ __forceinline__ int perm32(int rho) { const int n = rho >> 4, i = rho & 15; return 8 * (i >> 2) + 4 * n + (i & 3); }

struct Unit { int pm, pn; };
struct Gemm { const bf16_t* A; const bf16_t* Bt; int M, N, K; };

struct StaticOrder {
    int nM, nN, nwg, G, c;
    __host__ __device__ void init(int M, int N, int G_, int c_) { nM = M / BM; nN = N / BM; nwg = nM * nN; G = G_; c = c_; }
    __host__ __device__ bool next(int i, Unit& u) const {
        const long L = (long)i * G + c; if (L >= nwg) return false;
        int wgid = (int)L; { const int q = nwg / NXCD, r = nwg % NXCD, xcd = wgid % NXCD, off = wgid / NXCD; wgid = (xcd < r ? xcd * (q + 1) : r * (q + 1) + (xcd - r) * q) + off; }
        const int nig = WGM * nN, gid = wgid / nig, fm = gid * WGM, gsz = (nM - fm) < WGM ? (nM - fm) : WGM;
        u.pm = fm + ((wgid % nig) % gsz); u.pn = (wgid % nig) / gsz; return true;
    }
    __device__ __forceinline__ void a_ready(const Unit&) const {}
    __device__ __forceinline__ void done(const Unit&) const {}
};

__device__ __forceinline__ unsigned cvt_pk_bf16(float lo, float hi) { unsigned r; asm volatile("v_cvt_pk_bf16_f32 %0, %1, %2" : "=v"(r) : "v"(lo), "v"(hi)); return r; }
typedef float f32x2 __attribute__((ext_vector_type(2)));
template <class Epi, class Sched, bool ALIGN_EPI = false, bool SP2 = false>
__device__ __forceinline__ void gemm_phase(PG8_LAS unsigned char* lds, const Gemm g, const Sched& S, const Epi& E, const int wid) {
    int z_ = 0; asm volatile("" : "+v"(z_)); const int lane_ = __builtin_amdgcn_mbcnt_hi(~0u, __builtin_amdgcn_mbcnt_lo(~0u, z_));
    const int lane = lane_, tid = wid * 64 + lane, wr = wid >> 2, wc = wid & 3, fr = lane & 15, fq = lane >> 4;
    const int K = g.K, nt = K / BK;
    unsigned voffA[2], voffB[2];
#pragma unroll
    for (int i = 0; i < 2; ++i) { int R, C; stage_rc(tid * 16 + i * 8192, R, C); const int Rb = Epi::PERM ? ((R & ~31) + perm32(R & 31)) : R;
        voffA[i] = (unsigned)(R * K + C) * 2u; voffB[i] = (unsigned)(Rb * K + C) * 2u; }
    const size_t kstep = (size_t)(BK * 2);
    const size_t hstep = (size_t)HALF * K * 2;
    const size_t tstep = 2 * hstep;
    const unsigned ldsw = (unsigned)wid * 1024u;
    const int aoff = lds_byte(wr * 64 + fr, fq * 8), boff = lds_byte(wc * 32 + fr, fq * 8);
#define PG8_SA(b, h) (((b) * 2 + (h)) * HTB)
#define PG8_SB(b, h) ((4 + (b) * 2 + (h)) * HTB)
#define PG8_STAGE(bufoff, gbase, voff) do { _Pragma("unroll") for (int _i = 0; _i < 2; ++_i) \
        __builtin_amdgcn_global_load_lds((const unsigned*)((const char*)(gbase) + (voff)[_i]), (PG8_LAS unsigned*)(lds + (bufoff) + ldsw + _i * 8192), 16, 0, 0); } while (0)
#define PG8_LDA(dst, b, h) do { _Pragma("unroll") for (int m = 0; m < 4; ++m) _Pragma("unroll") for (int k = 0; k < 2; ++k) dst[m][k] = *(const PG8_LAS bf16x8*)(lds + PG8_SA(b, h) + aoff + m * 2048 + k * 1024); } while (0)
#define PG8_LDB(dst, b, h) do { _Pragma("unroll") for (int n = 0; n < 2; ++n) _Pragma("unroll") for (int k = 0; k < 2; ++k) dst[n][k] = *(const PG8_LAS bf16x8*)(lds + PG8_SB(b, h) + boff + n * 2048 + k * 1024); } while (0)
#define PG8_MMA(ai, bj, At, Bt) do { __builtin_amdgcn_s_setprio(1); _Pragma("unroll") for (int m = 0; m < 4; ++m) _Pragma("unroll") for (int n = 0; n < 2; ++n) _Pragma("unroll") for (int k = 0; k < 2; ++k) \
        acc[ai][bj][m][n] = __builtin_amdgcn_mfma_f32_16x16x32_bf16(Bt[n][k], At[m][k], acc[ai][bj][m][n], 0, 0, 0); __builtin_amdgcn_s_setprio(0); } while (0)
#define PG8_WAIT_V(n) asm volatile("s_waitcnt vmcnt(" #n ")" ::: "memory")
#define PG8_WAIT_L(n) asm volatile("s_waitcnt lgkmcnt(" #n ")" ::: "memory")
#define PG8_BAR __builtin_amdgcn_s_barrier()
#define PG8_SCHED __builtin_amdgcn_sched_barrier(0)
    Unit cur, nxt; int ui = 0;
    if (!S.next(0, cur)) return;
    f32x4 acc[2][2][4][2];
#pragma unroll
    for (int a = 0; a < 2; ++a)
#pragma unroll
        for (int b = 0; b < 2; ++b)
#pragma unroll
            for (int m = 0; m < 4; ++m)
#pragma unroll
                for (int n = 0; n < 2; ++n) acc[a][b][m][n] = (f32x4){0.f, 0.f, 0.f, 0.f};
    bf16x8 At[4][2], B0[2][2], B1[2][2];
    const char* cA = (const char*)g.A + (size_t)cur.pm * tstep; const char* cB = (const char*)g.Bt + (size_t)cur.pn * tstep;
    S.a_ready(cur);
    if constexpr (SP2) {
        PG8_STAGE(PG8_SB(0, 0), cB, voffB); PG8_STAGE(PG8_SB(0, 1), cB + hstep, voffB); PG8_STAGE(PG8_SA(0, 0), cA, voffA); PG8_STAGE(PG8_SA(0, 1), cA + hstep, voffA);
        if (wr == 1) PG8_BAR;
        PG8_WAIT_V(2); PG8_BAR;
        PG8_STAGE(PG8_SB(1, 0), cB + kstep, voffB); PG8_STAGE(PG8_SA(1, 0), cA + kstep, voffA); PG8_STAGE(PG8_SB(1, 1), cB + hstep + kstep, voffB);
        PG8_WAIT_V(6); PG8_BAR;
    } else {
        PG8_STAGE(PG8_SB(0, 0), cB, voffB); PG8_STAGE(PG8_SA(0, 0), cA, voffA); PG8_STAGE(PG8_SB(0, 1), cB + hstep, voffB); PG8_STAGE(PG8_SA(0, 1), cA + hstep, voffA);
        if (wr == 1) PG8_BAR;
        PG8_WAIT_V(4); PG8_BAR;
        PG8_STAGE(PG8_SB(1, 0), cB + kstep, voffB); PG8_STAGE(PG8_SA(1, 0), cA + kstep, voffA); PG8_STAGE(PG8_SB(1, 1), cB + hstep + kstep, voffB);
        PG8_WAIT_V(6); PG8_BAR;
    }
    for (;;) {
        const bool has_next = S.next(ui + 1, nxt);
        const char* nA = has_next ? (const char*)g.A + (size_t)nxt.pm * tstep : cA; const char* nB = has_next ? (const char*)g.Bt + (size_t)nxt.pn * tstep : cB;
        for (int t = 0; t < nt; t += 2) {
            const bool last = (t == nt - 2);
            const char* a1 = cA + (size_t)(t + 1) * kstep;
            const char* a2 = last ? nA : cA + (size_t)(t + 2) * kstep; const char* b2 = last ? nB : cB + (size_t)(t + 2) * kstep;
            const char* a3 = a2 + kstep; const char* b3 = b2 + kstep;
            if (last && has_next) S.a_ready(nxt);
            if constexpr (SP2) {
            PG8_LDB(B0, 0, 0); PG8_LDB(B1, 0, 1); PG8_SCHED; PG8_LDA(At, 0, 0); PG8_STAGE(PG8_SA(1, 1), a1 + hstep, voffA);
            PG8_WAIT_V(8); PG8_WAIT_L(0); PG8_BAR; PG8_MMA(0, 0, At, B0); PG8_MMA(0, 1, At, B1); PG8_BAR; PG8_SCHED;
            PG8_LDA(At, 0, 1); PG8_STAGE(PG8_SB(0, 0), b2, voffB); PG8_STAGE(PG8_SB(0, 1), b2 + hstep, voffB); PG8_STAGE(PG8_SA(0, 0), a2, voffA);
            PG8_WAIT_V(8); PG8_WAIT_L(0); PG8_BAR; PG8_MMA(1, 0, At, B0); PG8_MMA(1, 1, At, B1); PG8_BAR; PG8_SCHED;
            PG8_LDB(B0, 1, 0); PG8_LDB(B1, 1, 1); PG8_SCHED; PG8_LDA(At, 1, 0); PG8_STAGE(PG8_SA(0, 1), a2 + hstep, voffA);
            PG8_WAIT_V(8); PG8_WAIT_L(0); PG8_BAR; PG8_MMA(0, 0, At, B0); PG8_MMA(0, 1, At, B1); PG8_BAR; PG8_SCHED;
            PG8_LDA(At, 1, 1); PG8_STAGE(PG8_SB(1, 0), b3, voffB); PG8_STAGE(PG8_SB(1, 1), b3 + hstep, voffB); PG8_STAGE(PG8_SA(1, 0), a3, voffA);
            PG8_WAIT_V(8); PG8_WAIT_L(0); PG8_BAR; PG8_MMA(1, 0, At, B0); PG8_MMA(1, 1, At, B1); PG8_BAR; PG8_SCHED;
            } else {
            PG8_LDB(B0, 0, 0); PG8_SCHED; PG8_LDA(At, 0, 0); PG8_STAGE(PG8_SA(1, 1), a1 + hstep, voffA);
            PG8_WAIT_L(8); PG8_BAR; PG8_WAIT_L(0); PG8_MMA(0, 0, At, B0); PG8_BAR; PG8_SCHED;
            PG8_LDB(B1, 0, 1); PG8_STAGE(PG8_SB(0, 0), b2, voffB);
            PG8_BAR; PG8_WAIT_L(0); PG8_MMA(0, 1, At, B1); PG8_BAR;
            PG8_LDA(At, 0, 1); PG8_STAGE(PG8_SA(0, 0), a2, voffA);
            PG8_BAR; PG8_WAIT_L(0); PG8_MMA(1, 0, At, B0); PG8_BAR; PG8_SCHED;
            PG8_STAGE(PG8_SB(0, 1), b2 + hstep, voffB);
            PG8_WAIT_V(6); PG8_BAR; PG8_MMA(1, 1, At, B1); PG8_BAR;
            PG8_LDB(B0, 1, 0); PG8_SCHED; PG8_LDA(At, 1, 0); PG8_STAGE(PG8_SA(0, 1), a2 + hstep, voffA);
            PG8_WAIT_L(8); PG8_BAR; PG8_WAIT_L(0); PG8_MMA(0, 0, At, B0); PG8_BAR; PG8_SCHED;
            PG8_LDB(B1, 1, 1); PG8_STAGE(PG8_SB(1, 0), b3, voffB);
            PG8_BAR; PG8_WAIT_L(0); PG8_MMA(0, 1, At, B1); PG8_BAR;
            PG8_LDA(At, 1, 1); PG8_STAGE(PG8_SA(1, 0), a3, voffA);
            PG8_BAR; PG8_WAIT_L(0); PG8_MMA(1, 0, At, B0); PG8_BAR; PG8_SCHED;
            PG8_STAGE(PG8_SB(1, 1), b3 + hstep, voffB);
            PG8_WAIT_V(6); PG8_BAR; PG8_MMA(1, 1, At, B1); PG8_BAR;
            }
        }
        if constexpr (ALIGN_EPI) { if (wr == 0) PG8_BAR; }
        if constexpr (!Epi::AFTER_DRAIN) { E(acc, cur, wr, wc, fr, fq); S.done(cur); }
        if (!has_next) break;
#pragma unroll
        for (int a = 0; a < 2; ++a)
#pragma unroll
            for (int b = 0; b < 2; ++b)
#pragma unroll
                for (int m = 0; m < 4; ++m)
#pragma unroll
                    for (int n = 0; n < 2; ++n) acc[a][b][m][n] = (f32x4){0.f, 0.f, 0.f, 0.f};
        cur = nxt; cA = nA; cB = nB; ++ui;
        if constexpr (ALIGN_EPI) { if (wr == 1) PG8_BAR; }
    }
    PG8_WAIT_V(0);
    if constexpr (!ALIGN_EPI) { if (wr == 0) PG8_BAR; }
    PG8_BAR;
    if constexpr (Epi::AFTER_DRAIN) { E.fused(acc, cur, wr, wc, fr, fq, lds, wid, lane); S.done(cur); }
#undef PG8_SA
#undef PG8_SB
#undef PG8_STAGE
#undef PG8_LDA
#undef PG8_LDB
#undef PG8_MMA
#undef PG8_WAIT_V
#undef PG8_WAIT_L
#undef PG8_BAR
#undef PG8_SCHED
}
}

using pg8::bf16_t; using pg8::bf16x8; using pg8::f32x4; using pg8::u32x4;
typedef float f32x16 __attribute__((ext_vector_type(16)));
typedef unsigned u32x2 __attribute__((ext_vector_type(2)));
#define LAS __attribute__((address_space(3)))
constexpr int D = 1024, BATCH = 4, SEQ = 8192, DFF = 2816, DH = 512, NH = 8;
constexpr int M = BATCH * SEQ;
constexpr int MP = M + 256;
constexpr int NMI = 3328;
constexpr float EPS = 1e-6f, LOG2E = 1.4426950408889634f;
constexpr int NWAVES = 8, LDS_BYTES = 147456;

constexpr size_t MiB = 1u << 20;
constexpr size_t WS_CTL = 0;
constexpr size_t WS_W1 = 2 * MiB, WS_W1O = 13 * MiB, WS_WMI = 19 * MiB, WS_WMO = 26 * MiB, WS_W2 = 28 * MiB, WS_W2O = 39 * MiB;
constexpr size_t WS_PART = 45 * MiB, PART_STRIDE = 2304 * 1024;
constexpr size_t WS_LOGF = 54 * MiB;
constexpr size_t WS_RESM = 56 * MiB;
constexpr size_t WS_XA = 58 * MiB;
constexpr size_t WS_XB = 123 * MiB;
constexpr size_t WS_ACT = 187 * MiB;
constexpr size_t QKV_STRIDE = (size_t)MP * DH * 2;
constexpr size_t WS_END = WS_ACT + (size_t)MP * DFF * 2;
static_assert(5 * QKV_STRIDE <= (size_t)MP * DFF * 2, "P3 outputs overlay the activation buffer");
static_assert((size_t)MP * 16 * 4 <= PART_STRIDE && WS_PART + 4 * PART_STRIDE <= WS_LOGF, "ws map");

__device__ __forceinline__ unsigned cvtpk(float lo, float hi) { return pg8::cvt_pk_bf16(lo, hi); }
__device__ __forceinline__ float bf_lo(unsigned u) { return __uint_as_float(u << 16); }
__device__ __forceinline__ float bf_hi(unsigned u) { return __uint_as_float(u & 0xffff0000u); }
__device__ __forceinline__ float wave_sum(float v) {
#pragma unroll
    for (int o = 1; o < 64; o <<= 1) v += __shfl_xor(v, o);
    return v;
}
__device__ __forceinline__ float row_rstd(const float* part, int row) {
    const f32x4* p = (const f32x4*)(part + (size_t)row * 16);
    const f32x4 a = p[0], b = p[1], c = p[2], d = p[3];
    const f32x4 s = (a + b) + (c + d);
    const float t = (s[0] + s[1]) + (s[2] + s[3]);
    return 1.0f / sqrtf(t * (1.0f / 1024.0f) + EPS);
}


struct EpiSwiGLU {
    static constexpr bool PERM = true, AFTER_DRAIN = false;
    bf16_t* O; const float* part;
    __device__ __forceinline__ void operator()(const f32x4 (&acc)[2][2][4][2], const pg8::Unit& u, int wr, int wc, int fr, int fq) const {
        const int row0 = u.pm * 256 + wr * 64 + fr, col0 = u.pn * 128 + wc * 32 + 8 * fq;
#pragma unroll
        for (int ai = 0; ai < 2; ++ai)
#pragma unroll
            for (int m = 0; m < 4; ++m) {
                const int row = row0 + ai * 128 + m * 16; const float rs = row_rstd(part, row);
                float a[8];
#pragma unroll
                for (int n = 0; n < 2; ++n)
#pragma unroll
                    for (int i = 0; i < 4; ++i) { const float g = acc[ai][0][m][n][i] * rs, up = acc[ai][1][m][n][i] * rs;
                        const float sg = __builtin_amdgcn_rcpf(1.0f + __builtin_amdgcn_exp2f(-g * LOG2E)); a[n * 4 + i] = g * sg * up; }
                u32x4 w; w.x = cvtpk(a[0], a[1]); w.y = cvtpk(a[2], a[3]); w.z = cvtpk(a[4], a[5]); w.w = cvtpk(a[6], a[7]);
                *(u32x4*)(O + (size_t)row * DFF + col0) = w;
            }
    }
};

template <bool F32OUT> struct EpiResid {
    static constexpr bool PERM = true, AFTER_DRAIN = false;
    const bf16_t* res; float* out; bf16_t* hb; float* part; float alpha;
    __device__ __forceinline__ void operator()(const f32x4 (&acc)[2][2][4][2], const pg8::Unit& u, int wr, int wc, int fr, int fq) const {
        const int row0 = u.pm * 256 + wr * 64 + fr, col0 = u.pn * 256 + wc * 32 + 8 * fq;
#pragma unroll
        for (int ai = 0; ai < 2; ++ai)
#pragma unroll
            for (int m = 0; m < 4; ++m) {
                const int row = row0 + ai * 128 + m * 16;
                float ss = 0.f;
#pragma unroll
                for (int bj = 0; bj < 2; ++bj) { const int c = col0 + 128 * bj;
                    const u32x4 rb = *(const u32x4*)(res + (size_t)row * D + c);
                    const f32x4 r0 = (f32x4){bf_lo(rb.x), bf_hi(rb.x), bf_lo(rb.y), bf_hi(rb.y)}, r1 = (f32x4){bf_lo(rb.z), bf_hi(rb.z), bf_lo(rb.w), bf_hi(rb.w)};
                    const f32x4 v0 = r0 + acc[ai][bj][m][0] * alpha, v1 = r1 + acc[ai][bj][m][1] * alpha;
                    if (F32OUT) { float* op = out + (size_t)row * D + c; *(f32x4*)op = v0; *(f32x4*)(op + 4) = v1; }
                    else { u32x4 w; w.x = cvtpk(v0[0], v0[1]); w.y = cvtpk(v0[2], v0[3]); w.z = cvtpk(v1[0], v1[1]); w.w = cvtpk(v1[2], v1[3]);
                        *(u32x4*)(hb + (size_t)row * D + c) = w; }
                    ss += (v0[0] * v0[0] + v0[1] * v0[1]) + (v0[2] * v0[2] + v0[3] * v0[3]) + (v1[0] * v1[0] + v1[1] * v1[1]) + (v1[2] * v1[2] + v1[3] * v1[3]); }
                ss += __shfl_xor(ss, 16); ss += __shfl_xor(ss, 32);
                if (fq == 0) part[(size_t)row * 16 + u.pn * 4 + wc] = ss;
            }
    }
};

struct EpiMixIn {
    static constexpr bool PERM = true, AFTER_DRAIN = false;
    bf16_t *Q, *K, *V, *B, *Z; float* logfT; const float* part; const float *qn, *kn, *bfg;
    __device__ __forceinline__ void operator()(const f32x4 (&acc)[2][2][4][2], const pg8::Unit& u, int wr, int wc, int fr, int fq) const {
        const int row0 = u.pm * 256 + wr * 64 + fr, pn = u.pn;
        if (pn < 4) {
            const float* gp = (pn < 2 ? qn : kn) + 8 * fq; bf16_t* base = pn < 2 ? Q : K; const float sc = pn < 2 ? 0.125f * LOG2E : 1.0f;
            const int head = (pn & 1) * 4 + wc;
            float g[2][8];
#pragma unroll
            for (int bj = 0; bj < 2; ++bj)
#pragma unroll
                for (int i = 0; i < 8; ++i) g[bj][i] = gp[bj * 32 + i] * sc;
#pragma unroll
            for (int ai = 0; ai < 2; ++ai)
#pragma unroll
                for (int m = 0; m < 4; ++m) {
                    const int row = row0 + ai * 128 + m * 16; const float rs = row_rstd(part, row);
                    float a[2][8]; float ss = 0.f;
#pragma unroll
                    for (int bj = 0; bj < 2; ++bj)
#pragma unroll
                        for (int i = 0; i < 8; ++i) { a[bj][i] = acc[ai][bj][m][i >> 2][i & 3] * rs; ss += a[bj][i] * a[bj][i]; }
                    ss += __shfl_xor(ss, 16); ss += __shfl_xor(ss, 32);
                    const float rr = 1.0f / sqrtf(ss * (1.0f / 64.0f) + EPS);
#pragma unroll
                    for (int bj = 0; bj < 2; ++bj) { u32x4 w;
                        w.x = cvtpk(a[bj][0] * rr * g[bj][0], a[bj][1] * rr * g[bj][1]); w.y = cvtpk(a[bj][2] * rr * g[bj][2], a[bj][3] * rr * g[bj][3]);
                        w.z = cvtpk(a[bj][4] * rr * g[bj][4], a[bj][5] * rr * g[bj][5]); w.w = cvtpk(a[bj][6] * rr * g[bj][6], a[bj][7] * rr * g[bj][7]);
                        *(u32x4*)(base + (size_t)row * DH + head * 64 + bj * 32 + 8 * fq) = w; }
                }
        } else if (pn < 6) {
            const int col0 = (pn & 1) * 256 + wc * 32 + 8 * fq;
#pragma unroll
            for (int ai = 0; ai < 2; ++ai)
#pragma unroll
                for (int m = 0; m < 4; ++m) {
                    const int row = row0 + ai * 128 + m * 16; const float rs = row_rstd(part, row); const int bb = row / SEQ, t = row % SEQ;
#pragma unroll
                    for (int bj = 0; bj < 2; ++bj) { const int c = col0 + 128 * bj; bf16_t* vp = V + ((size_t)(bb * NH) * 64 + c) * SEQ + t;
                        const f32x4 v0 = acc[ai][bj][m][0] * rs, v1 = acc[ai][bj][m][1] * rs;
                        const unsigned w0 = cvtpk(v0[0], v0[1]), w1 = cvtpk(v0[2], v0[3]), w2 = cvtpk(v1[0], v1[1]), w3 = cvtpk(v1[2], v1[3]);
                        vp[0] = (bf16_t)w0; vp[SEQ] = (bf16_t)(w0 >> 16); vp[2 * SEQ] = (bf16_t)w1; vp[3 * SEQ] = (bf16_t)(w1 >> 16);
                        vp[4 * SEQ] = (bf16_t)w2; vp[5 * SEQ] = (bf16_t)(w2 >> 16); vp[6 * SEQ] = (bf16_t)w3; vp[7 * SEQ] = (bf16_t)(w3 >> 16); }
                }
        } else if (pn < 8) {
            bf16_t* base = B; const int col0 = (pn & 1) * 256 + wc * 32 + 8 * fq;
#pragma unroll
            for (int ai = 0; ai < 2; ++ai)
#pragma unroll
                for (int m = 0; m < 4; ++m) {
                    const int row = row0 + ai * 128 + m * 16; const float rs = row_rstd(part, row);
#pragma unroll
                    for (int bj = 0; bj < 2; ++bj) { const f32x4 v0 = acc[ai][bj][m][0] * rs, v1 = acc[ai][bj][m][1] * rs; u32x4 w;
                        w.x = cvtpk(v0[0], v0[1]); w.y = cvtpk(v0[2], v0[3]); w.z = cvtpk(v1[0], v1[1]); w.w = cvtpk(v1[2], v1[3]);
                        *(u32x4*)(base + (size_t)row * DH + col0 + 128 * bj) = w; }
                }
        } else if (pn < 12) {
            const int col0 = (pn - 8) * 128 + wc * 32 + 8 * fq;
#pragma unroll
            for (int ai = 0; ai < 2; ++ai)
#pragma unroll
                for (int m = 0; m < 4; ++m) {
                    const int row = row0 + ai * 128 + m * 16; const float rs = row_rstd(part, row); const float r2 = rs * rs;
                    const f32x4 v0 = acc[ai][0][m][0] * acc[ai][1][m][0] * r2, v1 = acc[ai][0][m][1] * acc[ai][1][m][1] * r2; u32x4 w;
                    w.x = cvtpk(v0[0], v0[1]); w.y = cvtpk(v0[2], v0[3]); w.z = cvtpk(v1[0], v1[1]); w.w = cvtpk(v1[2], v1[3]);
                    *(u32x4*)(Z + (size_t)row * DH + col0) = w;
                }
        }
    }
};

__device__ __forceinline__ void conv_item(const float* W, int N, int K, bf16_t* WT, int dr0, int sc0, int nvalid, const float* ks, int kb, LAS float* scr, int lane) {
    const int k0 = 64 * kb, n = lane & 31;
#pragma unroll 8
    for (int i = 0; i < 32; ++i) { const int kk = 2 * i + (lane >> 5);
        float v = 0.f; if (n < nvalid) { v = W[(size_t)(k0 + kk) * N + sc0 + n]; if (ks) v *= ks[k0 + kk]; }
        scr[kk * 33 + n] = v; }
    asm volatile("s_waitcnt lgkmcnt(0)" ::: "memory");
    const int c = lane & 7;
#pragma unroll
    for (int j = 0; j < 4; ++j) { const int nn = (lane >> 3) + 8 * j; const LAS float* s = scr + (8 * c) * 33 + nn;
        u32x4 o; o.x = cvtpk(s[0 * 33], s[1 * 33]); o.y = cvtpk(s[2 * 33], s[3 * 33]); o.z = cvtpk(s[4 * 33], s[5 * 33]); o.w = cvtpk(s[6 * 33], s[7 * 33]);
        *(u32x4*)(WT + (size_t)(dr0 + nn) * K + k0 + 8 * c) = o; }
    asm volatile("s_waitcnt lgkmcnt(0)" ::: "memory");
}

struct Args { const float* in[18]; float* out; unsigned char* ws; };
enum { I_X = 0, I_META, I_F1N, I_F1WI, I_F1WO, I_MIXN, I_WMI, I_BF, I_QN, I_KN, I_CW, I_AON, I_CON, I_WMO, I_F2N, I_F2WI, I_F2WO, I_FN };

__device__ __forceinline__ void p0_prologue(const Args& a, LAS unsigned char* lds, int gw, int NGW, int wave, int lane) {
    unsigned char* ws = a.ws;
    LAS float* scr = (LAS float*)(lds + wave * 16384);
    constexpr int I_IN = (2 * DFF / 32) * (D / 64), I_OUT = (D / 32) * (DFF / 64), I_MI = (NMI / 32) * (D / 64), I_MO = (D / 32) * (D / 64);
    constexpr int NITEMS = 2 * I_IN + 2 * I_OUT + I_MI + I_MO;
    for (int it = gw; it < NITEMS; it += NGW) {
        int r = it;
        if (r < 2 * I_IN) { const int which = r >= I_IN; r -= which * I_IN; const int nblk = 2 * DFF / 32, kb = r / nblk, dr0 = (r % nblk) * 32;
            const int pn = dr0 >> 8, within = dr0 & 255, bj = within >> 7, i0 = within & 127;
            conv_item(a.in[which ? I_F2WI : I_F1WI], 2 * DFF, D, (bf16_t*)(ws + (which ? WS_W2 : WS_W1)), dr0, bj * DFF + pn * 128 + i0, 32, a.in[which ? I_F2N : I_F1N], kb, scr, lane); continue; }
        r -= 2 * I_IN;
        if (r < 2 * I_OUT) { const int which = r >= I_OUT; r -= which * I_OUT; const int nblk = D / 32, kb = r / nblk, dr0 = (r % nblk) * 32;
            conv_item(a.in[which ? I_F2WO : I_F1WO], D, DFF, (bf16_t*)(ws + (which ? WS_W2O : WS_W1O)), dr0, dr0, 32, nullptr, kb, scr, lane); continue; }
        r -= 2 * I_OUT;
        if (r < I_MI) { const int nblk = NMI / 32, kb = r / nblk, dr0 = (r % nblk) * 32;
            const int pn = dr0 >> 8, within = dr0 & 255, bj = within >> 7, i0 = within & 127, wcw = i0 >> 5;
            int sc0, nv = 32;
            if (pn < 4) sc0 = (pn >> 1) * 512 + ((pn & 1) * 4 + wcw) * 64 + bj * 32;
            else if (pn < 6) sc0 = dr0;
            else if (pn < 8) sc0 = 1544 + (dr0 - 1536);
            else if (pn < 12) sc0 = (bj ? 2568 : 2056) + 128 * (pn - 8) + i0;
            else { sc0 = 1536; nv = (dr0 == 3072) ? 8 : 0; }
            conv_item(a.in[I_WMI], 3080, D, (bf16_t*)(ws + WS_WMI), dr0, sc0, nv, a.in[I_MIXN], kb, scr, lane); continue; }
        r -= I_MI;
        { const int nblk = D / 32, kb = r / nblk, dr0 = (r % nblk) * 32;
          const float* ks = (kb < 8) ? a.in[I_AON] : a.in[I_CON] - 512;
          conv_item(a.in[I_WMO], D, D, (bf16_t*)(ws + WS_WMO), dr0, dr0, 32, ks, kb, scr, lane); }
    }
    bf16_t* XA = (bf16_t*)(ws + WS_XA); float* part0 = (float*)(ws + WS_PART);
    for (int row = gw; row < M + 16; row += NGW) {
        const float* src = row < M ? a.in[I_X] + (size_t)row * D : a.in[I_META] + (size_t)(row - M) * D;
        f32x4 v[4]; float ss = 0.f;
#pragma unroll
        for (int j = 0; j < 4; ++j) { v[j] = ((const f32x4*)src)[lane + 64 * j]; ss += (v[j][0] * v[j][0] + v[j][1] * v[j][1]) + (v[j][2] * v[j][2] + v[j][3] * v[j][3]); }
        ss = wave_sum(ss);
#pragma unroll
        for (int j = 0; j < 4; ++j) { u32x2 w; w.x = cvtpk(v[j][0], v[j][1]); w.y = cvtpk(v[j][2], v[j][3]); *(u32x2*)(XA + (size_t)row * D + 4 * (lane + 64 * j)) = w; }
        if (lane < 16) part0[(size_t)row * 16 + lane] = lane == 0 ? ss : 0.f;
    }
}


template <int NC, int K> __device__ __forceinline__ void mini16(const bf16_t* X, const bf16_t* W, const int (&wr)[NC], f32x4 (&acc)[NC], LAS unsigned char* lds, int wave, int lane) {
    constexpr int KW = K / 8; static_assert(KW % 32 == 0, "K split");
    const int r = lane & 15, q = lane >> 4;
    const bf16_t* xp = X + (size_t)r * K + wave * KW + 8 * q;
    const bf16_t* wp[NC];
#pragma unroll
    for (int c = 0; c < NC; ++c) { wp[c] = W + (size_t)(wr[c] + r) * K + wave * KW + 8 * q; acc[c] = (f32x4){0.f, 0.f, 0.f, 0.f}; }
#pragma unroll
    for (int k = 0; k < KW; k += 32) { const bf16x8 xv = *(const bf16x8*)(xp + k);
#pragma unroll
        for (int c = 0; c < NC; ++c) { const bf16x8 wv = *(const bf16x8*)(wp[c] + k); acc[c] = __builtin_amdgcn_mfma_f32_16x16x32_bf16(wv, xv, acc[c], 0, 0, 0); } }
    LAS f32x4* P = (LAS f32x4*)lds;
#pragma unroll
    for (int c = 0; c < NC; ++c) P[(wave * NC + c) * 64 + lane] = acc[c];
    __syncthreads();
#pragma unroll
    for (int c = 0; c < NC; ++c) { f32x4 s = P[c * 64 + lane];
#pragma unroll
        for (int w = 1; w < 8; ++w) s += P[(w * NC + c) * 64 + lane];
        acc[c] = s; }
    __syncthreads();
}
__device__ __forceinline__ float log_sigmoid(float x) { return fminf(x, 0.f) - __logf(1.0f + __expf(-fabsf(x))); }
__device__ __forceinline__ float meta_rstd(const float* mpart, int tok) {
    const f32x4* p = (const f32x4*)(mpart + tok * 64); f32x4 s = p[0];
#pragma unroll
    for (int i = 1; i < 16; ++i) s += p[i];
    return 1.0f / sqrtf(((s[0] + s[1]) + (s[2] + s[3])) * (1.0f / 1024.0f) + EPS);
}
__device__ __forceinline__ void meta_up(const bf16_t* XA, const bf16_t* W1, bf16_t* ACT, const float* part0, int item, LAS unsigned char* lds, int wave, int lane) {
    const int j0 = item * 16, ng = 256 * (j0 >> 7) + (j0 & 127); const int wr[2] = {ng, ng + 128}; f32x4 acc[2];
    mini16<2, D>(XA + (size_t)M * D, W1, wr, acc, lds, wave, lane);
    if (wave != 0) return;
    const int tok = lane & 15, nq = lane >> 4; const float rs = row_rstd(part0, M + tok); float a[4];
#pragma unroll
    for (int i = 0; i < 4; ++i) { const float g = acc[0][i] * rs, up = acc[1][i] * rs; a[i] = g * __builtin_amdgcn_rcpf(1.0f + __builtin_amdgcn_exp2f(-g * LOG2E)) * up; }
    u32x2 w; w.x = cvtpk(a[0], a[1]); w.y = cvtpk(a[2], a[3]); *(u32x2*)(ACT + (size_t)(M + tok) * DFF + j0 + 4 * nq) = w;
}
__device__ __forceinline__ void meta_down(const bf16_t* ACT, const bf16_t* W1O, const float* meta, bf16_t* XA, float* mpart, int item, LAS unsigned char* lds, int wave, int lane) {
    const int c0 = item * 16; const int wr[1] = {c0}; f32x4 acc[1];
    mini16<1, DFF>(ACT + (size_t)M * DFF, W1O, wr, acc, lds, wave, lane);
    if (wave != 0) return;
    const int tok = lane & 15, nq = lane >> 4; const f32x4 r = *(const f32x4*)(meta + (size_t)tok * D + c0 + 4 * nq); const f32x4 v = r + acc[0] * 0.5f;
    u32x2 w; w.x = cvtpk(v[0], v[1]); w.y = cvtpk(v[2], v[3]); *(u32x2*)(XA + (size_t)(M + tok) * D + c0 + 4 * nq) = w;
    float ss = (v[0] * v[0] + v[1] * v[1]) + (v[2] * v[2] + v[3] * v[3]); ss += __shfl_xor(ss, 16); ss += __shfl_xor(ss, 32);
    if (nq == 0) mpart[tok * 64 + item] = ss;
}
__device__ __forceinline__ void meta_mix(const bf16_t* XA, const bf16_t* WMI, bf16_t* K, bf16_t* V, bf16_t* Z, float* logfT, const float* mpart, const float* kn, const float* bfg, int item, LAS unsigned char* lds, int wave, int lane) {
    int wr[4];
    if (item < 8) { const int pn = 2 + (item >> 2), wc = item & 3;
#pragma unroll
        for (int c = 0; c < 4; ++c) wr[c] = 256 * pn + 128 * (c >> 1) + 32 * wc + 16 * (c & 1); }
    else if (item < 16) {
#pragma unroll
        for (int c = 0; c < 4; ++c) wr[c] = 1024 + (item - 8) * 64 + 16 * c; }
    else if (item < 32) { const int ch0 = (item - 16) * 32; wr[0] = 2048 + 256 * (ch0 >> 7) + (ch0 & 127); wr[1] = wr[0] + 16; wr[2] = wr[0] + 128; wr[3] = wr[1] + 128; }
    else { wr[0] = 3072; wr[1] = 3072; wr[2] = 3072; wr[3] = 3072; }
    f32x4 acc[4];
    mini16<4, D>(XA + (size_t)M * D, WMI, wr, acc, lds, wave, lane);
    if (wave != 0) return;
    const int tok = lane & 15, nq = lane >> 4; const float rs = meta_rstd(mpart, tok); const size_t row = (size_t)M + tok;
    if (item < 8) { float ss = 0.f;
#pragma unroll
        for (int c = 0; c < 4; ++c) { acc[c] = acc[c] * rs; ss += (acc[c][0] * acc[c][0] + acc[c][1] * acc[c][1]) + (acc[c][2] * acc[c][2] + acc[c][3] * acc[c][3]); }
        ss += __shfl_xor(ss, 16); ss += __shfl_xor(ss, 32); const float rr = 1.0f / sqrtf(ss * (1.0f / 64.0f) + EPS);
#pragma unroll
        for (int c = 0; c < 4; ++c) { const f32x4 g = *(const f32x4*)(kn + 16 * c + 4 * nq); const f32x4 v = acc[c] * rr * g; u32x2 w; w.x = cvtpk(v[0], v[1]); w.y = cvtpk(v[2], v[3]);
            *(u32x2*)(K + row * DH + item * 64 + 16 * c + 4 * nq) = w; } }
    else if (item < 16) {
#pragma unroll
        for (int c = 0; c < 4; ++c) { const f32x4 v = acc[c] * rs; const unsigned w0 = cvtpk(v[0], v[1]), w1 = cvtpk(v[2], v[3]); bf16_t* vp = V + (size_t)((item - 8) * 64 + 16 * c + 4 * nq) * 16 + tok;
            vp[0] = (bf16_t)w0; vp[16] = (bf16_t)(w0 >> 16); vp[32] = (bf16_t)w1; vp[48] = (bf16_t)(w1 >> 16); } }
    else if (item < 32) { const float r2 = rs * rs;
#pragma unroll
        for (int c = 0; c < 2; ++c) { const f32x4 v = acc[c] * acc[2 + c] * r2; u32x2 w; w.x = cvtpk(v[0], v[1]); w.y = cvtpk(v[2], v[3]); *(u32x2*)(Z + row * DH + (item - 16) * 32 + 16 * c + 4 * nq) = w; } }
    else if (nq < 2) {
#pragma unroll
        for (int i = 0; i < 4; ++i) { const int h = 4 * nq + i; logfT[(size_t)h * MP + row] = log_sigmoid(acc[0][i] * rs + bfg[h]); } }
}
__device__ __forceinline__ void flog_wg(const bf16_t* XA, const bf16_t* WMI, float* logfT, const float* part1, const float* bfg, int rowbase, LAS unsigned char* lds, int wave, int lane) {
    const int r = lane & 15, q = lane >> 4;
    const bf16_t* wp = WMI + (size_t)(3072 + r) * D + wave * 128 + 8 * q;
    bf16x8 wv[4];
#pragma unroll
    for (int s = 0; s < 4; ++s) wv[s] = *(const bf16x8*)(wp + 32 * s);
    LAS f32x4* P = (LAS f32x4*)lds;
#pragma unroll
    for (int g = 0; g < 8; ++g) { const bf16_t* xp = XA + (size_t)(rowbase + 16 * g + r) * D + wave * 128 + 8 * q; f32x4 acc = (f32x4){0.f, 0.f, 0.f, 0.f};
#pragma unroll
        for (int s = 0; s < 4; ++s) acc = __builtin_amdgcn_mfma_f32_16x16x32_bf16(wv[s], *(const bf16x8*)(xp + 32 * s), acc, 0, 0, 0);
        P[(wave * 8 + g) * 64 + lane] = acc; }
    __syncthreads();
    f32x4 s = P[wave * 64 + lane];
#pragma unroll
    for (int w = 1; w < 8; ++w) s += P[(w * 8 + wave) * 64 + lane];
    const int tok = lane & 15, nq = lane >> 4, row = rowbase + 16 * wave + tok; const float rs = row_rstd(part1, row);
    if (nq < 2) {
#pragma unroll
        for (int i = 0; i < 4; ++i) { const int h = 4 * nq + i; logfT[(size_t)h * MP + row] = log_sigmoid(s[i] * rs + bfg[h]); } }
    __syncthreads();
}

struct MixP { const bf16_t *Q, *K, *VT, *VTm, *B, *Z; const float* logfT; const float* cw; bf16_t* out; float thresh; };

__device__ __forceinline__ float wave_scan_incl(float v) {
#define DPP_ADD(ctrl, rmask) v += __int_as_float(__builtin_amdgcn_update_dpp(0, __float_as_int(v), ctrl, rmask, 0xf, false))
    DPP_ADD(0x111, 0xf); DPP_ADD(0x112, 0xf); DPP_ADD(0x114, 0xf); DPP_ADD(0x118, 0xf);
    DPP_ADD(0x142, 0xa);
    DPP_ADD(0x143, 0xc);
#undef DPP_ADD
    return v;
}
__device__ __forceinline__ void mixer_unit(const MixP& p, int b, int t0, LAS unsigned char* lds, int wave, int lane) {
    const int r32 = lane & 31, hi = lane >> 5, h = wave;
    LAS float* ssq = (LAS float*)(lds + 4096);
    const size_t rowq = (size_t)b * SEQ + t0;
    bf16x8 qf[4];
    { const bf16_t* qp = p.Q + (rowq + r32) * DH + h * 64 + 8 * hi;
#pragma unroll
      for (int ks = 0; ks < 4; ++ks) qf[ks] = *(const bf16x8*)(qp + 16 * ks); }
    float mrun = -INFINITY, l = 0.f; f32x16 o0, o1;
#pragma unroll
    for (int r = 0; r < 16; ++r) { o0[r] = 0.f; o1[r] = 0.f; }
    const int jd = t0 >> 6, T0 = jd << 6;
    const char* Kh = (const char*)(p.K + h * 64);
    const char* Vh = (const char*)(p.VT + (size_t)(b * NH + h) * 64 * SEQ);
    const char* Vm = (const char*)(p.VTm + (size_t)h * 64 * 16);
    const char* Lh = (const char*)(p.logfT + (size_t)h * MP);
#define KROW(j_) ((j_) >= 0 ? (size_t)b * SEQ + 64 * (j_) : (size_t)M)
    bf16x8 kc[8]; float Lc;
    { const char* kp = Kh + KROW(jd) * DH * 2; const unsigned koff0 = (unsigned)(r32 * DH + 8 * hi) * 2u;
#pragma unroll
      for (int ks = 0; ks < 4; ++ks) { kc[2 * ks] = *(const bf16x8*)(kp + koff0 + 32 * ks); kc[2 * ks + 1] = *(const bf16x8*)(kp + koff0 + 32 * DH * 2 + 32 * ks); }
      Lc = *(const float*)(Lh + KROW(jd) * 4 + (unsigned)lane * 4u); }
    float base = 0.f;
    for (int j = jd; ; --j) {
        int ln = lane; asm volatile("" : "+v"(ln));
        const int r32 = ln & 31, hi = ln >> 5, lane = ln;
        const unsigned koff = (unsigned)(r32 * DH + 8 * hi) * 2u, vldoff = (unsigned)((lane >> 3) * SEQ + 8 * (lane & 7)) * 2u, voffm = (unsigned)(r32 * 16 + 4 * hi) * 2u, loffx = (unsigned)lane * 4u, loffm = (unsigned)(lane & 15) * 4u;
        LAS float* sc = (LAS float*)lds + wave * 64; LAS unsigned char* vt = lds + 8192 + wave * 8704;
        u32x4 vld[8];
        if (j >= 0) { const char* vp = Vh + (size_t)(64 * j) * 2;
#pragma unroll
            for (int i = 0; i < 8; ++i) vld[i] = *(const u32x4*)(vp + vldoff + (size_t)(8 * i) * SEQ * 2); }
        else {
#pragma unroll
            for (int i = 0; i < 2; ++i) { const u32x2 a_ = *(const u32x2*)(Vm + voffm + i * 32 * 16 * 2), b_ = *(const u32x2*)(Vm + voffm + i * 32 * 16 * 2 + 16); vld[i] = (u32x4){a_.x, a_.y, b_.x, b_.y}; } }
        const int nvalid = j >= 0 ? 64 : 16;
        const float P = wave_scan_incl(lane < nvalid ? Lc * LOG2E : 0.f);
        const float tot = __int_as_float(__builtin_amdgcn_readlane(__float_as_int(P), 63));
        const float p31 = __int_as_float(__builtin_amdgcn_readlane(__float_as_int(P), 31));
        const float bj = (j == jd) ? ((t0 > T0) ? p31 : 0.f) : base + tot;
        sc[lane] = bj - P; base = bj;
        f32x16 s0, s1;
#pragma unroll
        for (int r = 0; r < 16; ++r) { s0[r] = 0.f; s1[r] = 0.f; }
#pragma unroll
        for (int ks = 0; ks < 4; ++ks) { s0 = __builtin_amdgcn_mfma_f32_32x32x16_bf16(kc[2 * ks], qf[ks], s0, 0, 0, 0); s1 = __builtin_amdgcn_mfma_f32_32x32x16_bf16(kc[2 * ks + 1], qf[ks], s1, 0, 0, 0); }
        if (j >= 0) { const char* kp = Kh + KROW(j - 1) * DH * 2;
#pragma unroll
            for (int ks = 0; ks < 4; ++ks) { kc[2 * ks] = *(const bf16x8*)(kp + koff + 32 * ks); kc[2 * ks + 1] = *(const bf16x8*)(kp + koff + 32 * DH * 2 + 32 * ks); }
            Lc = *(const float*)(Lh + KROW(j - 1) * 4 + (j > 0 ? loffx : loffm)); }
        asm volatile("s_waitcnt lgkmcnt(0)" ::: "memory");
#pragma unroll
        for (int g = 0; g < 4; ++g) { const f32x4 b0 = *(const LAS f32x4*)(sc + 8 * g + 4 * hi), b1 = *(const LAS f32x4*)(sc + 32 + 8 * g + 4 * hi);
#pragma unroll
            for (int i = 0; i < 4; ++i) { s0[4 * g + i] += b0[i]; s1[4 * g + i] += b1[i]; } }
        if (j == jd) { const int qa4 = t0 + r32 - T0 - 4 * hi;
#pragma unroll
            for (int r = 0; r < 16; ++r) { if ((r & 3) + 8 * (r >> 2) > qa4) s0[r] = -INFINITY; if ((r & 3) + 8 * (r >> 2) + 32 > qa4) s1[r] = -INFINITY; } }
        if (j < 0) { const int h4 = 4 * hi;
#pragma unroll
            for (int r = 0; r < 16; ++r) { if ((r & 3) + 8 * (r >> 2) >= 16 - h4) s0[r] = -INFINITY; s1[r] = -INFINITY; } }
        float mt = fmaxf(s0[0], s1[0]);
#pragma unroll
        for (int r = 1; r < 16; ++r) mt = fmaxf(mt, fmaxf(s0[r], s1[r]));
        mt = fmaxf(mt, __shfl_xor(mt, 32));
        const float mn = fmaxf(mrun, mt), al = __builtin_amdgcn_exp2f(mrun - mn); mrun = mn;
        float ps = 0.f;
#pragma unroll
        for (int r = 0; r < 16; ++r) { s0[r] = __builtin_amdgcn_exp2f(s0[r] - mn); s1[r] = __builtin_amdgcn_exp2f(s1[r] - mn); ps += s0[r] + s1[r]; }
        l = l * al + ps;
#pragma unroll
        for (int r = 0; r < 16; ++r) { o0[r] *= al; o1[r] *= al; }
#define PWPK(S_, o_) (u32x4){cvtpk(S_[o_ + 0], S_[o_ + 1]), cvtpk(S_[o_ + 2], S_[o_ + 3]), cvtpk(S_[o_ + 4], S_[o_ + 5]), cvtpk(S_[o_ + 6], S_[o_ + 7])}
        if (j >= 0) {
#pragma unroll
            for (int i = 0; i < 8; ++i) { LAS unsigned char* wp_ = vt + (8 * i + (lane >> 3)) * 136 + 16 * (lane & 7);
                *(LAS u32x2*)wp_ = (u32x2){vld[i].x, vld[i].y}; *(LAS u32x2*)(wp_ + 8) = (u32x2){vld[i].z, vld[i].w}; }
            asm volatile("s_waitcnt lgkmcnt(0)" ::: "memory");
            const LAS unsigned char* rp_ = vt + r32 * 136 + 8 * hi;
#pragma unroll
            for (int g4 = 0; g4 < 4; ++g4) {
                const u32x4 pw = (g4 < 2) ? PWPK(s0, 8 * (g4 & 1)) : PWPK(s1, 8 * (g4 & 1));
                const bf16x8 pf = __builtin_bit_cast(bf16x8, pw);
                const u32x2 a0 = *(const LAS u32x2*)(rp_ + 32 * g4), b0 = *(const LAS u32x2*)(rp_ + 32 * g4 + 16), a1 = *(const LAS u32x2*)(rp_ + 32 * 136 + 32 * g4), b1 = *(const LAS u32x2*)(rp_ + 32 * 136 + 32 * g4 + 16);
                const u32x4 x0 = (u32x4){a0.x, a0.y, b0.x, b0.y}, x1 = (u32x4){a1.x, a1.y, b1.x, b1.y};
                o0 = __builtin_amdgcn_mfma_f32_32x32x16_bf16(__builtin_bit_cast(bf16x8, x0), pf, o0, 0, 0, 0);
                o1 = __builtin_amdgcn_mfma_f32_32x32x16_bf16(__builtin_bit_cast(bf16x8, x1), pf, o1, 0, 0, 0);
            }
        } else {
            const u32x4 pw = PWPK(s0, 0); const bf16x8 pf = __builtin_bit_cast(bf16x8, pw);
            o0 = __builtin_amdgcn_mfma_f32_32x32x16_bf16(__builtin_bit_cast(bf16x8, vld[0]), pf, o0, 0, 0, 0);
            o1 = __builtin_amdgcn_mfma_f32_32x32x16_bf16(__builtin_bit_cast(bf16x8, vld[1]), pf, o1, 0, 0, 0);
        }
#undef PWPK
        if (j < 0 || base < -p.thresh) break;
    }
    l += __shfl_xor(l, 32);
    const float inv = 1.0f / l; float ss = 0.f;
#pragma unroll
    for (int r = 0; r < 16; ++r) { o0[r] *= inv; o1[r] *= inv; ss += o0[r] * o0[r] + o1[r] * o1[r]; }
    ss += __shfl_xor(ss, 32);
    if (hi == 0) ssq[r32 * 8 + h] = ss;
    { int c0 = lane * 8; asm volatile("" : "+v"(c0));
      float w0[8], w1[8], w2[8];
#pragma unroll
      for (int i = 0; i < 8; ++i) { w0[i] = p.cw[c0 + i]; w1[i] = p.cw[DH + c0 + i]; w2[i] = p.cw[2 * DH + c0 + i]; }
      u32x4 z0[4], z1[4], z2[4], bv[4];
#pragma unroll
      for (int rr = 0; rr < 4; ++rr) { const int t = t0 + wave + 8 * rr; const size_t row = (size_t)b * SEQ + t;
          const size_t row1 = t >= 1 ? row - 1 : (size_t)M + 15, row2 = t >= 2 ? row - 2 : (size_t)M + 14 + t;
          z0[rr] = *(const u32x4*)(p.Z + row * DH + c0); z1[rr] = *(const u32x4*)(p.Z + row1 * DH + c0); z2[rr] = *(const u32x4*)(p.Z + row2 * DH + c0); bv[rr] = *(const u32x4*)(p.B + row * DH + c0); }
#pragma unroll
      for (int rr = 0; rr < 4; ++rr) { const size_t row = (size_t)b * SEQ + t0 + wave + 8 * rr;
          float y[8]; float s2 = 0.f;
#pragma unroll
          for (int i = 0; i < 4; ++i) {
              y[2 * i] = bf_lo(bv[rr][i]) * (w0[2 * i] * bf_lo(z2[rr][i]) + w1[2 * i] * bf_lo(z1[rr][i]) + w2[2 * i] * bf_lo(z0[rr][i]));
              y[2 * i + 1] = bf_hi(bv[rr][i]) * (w0[2 * i + 1] * bf_hi(z2[rr][i]) + w1[2 * i + 1] * bf_hi(z1[rr][i]) + w2[2 * i + 1] * bf_hi(z0[rr][i]));
              s2 += y[2 * i] * y[2 * i] + y[2 * i + 1] * y[2 * i + 1]; }
          s2 = wave_sum(s2); const float rs = 1.0f / sqrtf(s2 * (1.0f / 512.0f) + EPS);
          u32x4 w; w.x = cvtpk(y[0] * rs, y[1] * rs); w.y = cvtpk(y[2] * rs, y[3] * rs); w.z = cvtpk(y[4] * rs, y[5] * rs); w.w = cvtpk(y[6] * rs, y[7] * rs);
          *(u32x4*)(p.out + row * D + DH + c0) = w; } }
    __syncthreads();
    { const f32x4 a = *(const LAS f32x4*)(ssq + r32 * 8), c = *(const LAS f32x4*)(ssq + r32 * 8 + 4);
      const float tot = ((a[0] + a[1]) + (a[2] + a[3])) + ((c[0] + c[1]) + (c[2] + c[3]));
      const float rs = 1.0f / sqrtf(tot * (1.0f / 512.0f) + EPS);
      bf16_t* op = p.out + (rowq + r32) * D + h * 64 + 4 * hi;
#pragma unroll
      for (int g = 0; g < 4; ++g) { u32x2 w;
          w.x = cvtpk(o0[4 * g] * rs, o0[4 * g + 1] * rs); w.y = cvtpk(o0[4 * g + 2] * rs, o0[4 * g + 3] * rs); *(u32x2*)(op + 8 * g) = w;
          w.x = cvtpk(o1[4 * g] * rs, o1[4 * g + 1] * rs); w.y = cvtpk(o1[4 * g + 2] * rs, o1[4 * g + 3] * rs); *(u32x2*)(op + 32 + 8 * g) = w; } }
    __syncthreads();
}

#define RLX_AGENT __ATOMIC_RELAXED, __HIP_MEMORY_SCOPE_AGENT
#define XB_TMO      128
#define XB_XCNT(j)  (256  + 64 * (j))
#define XB_XSUB(j)  (1280 + 64 * (j))
#define XB_XGEN(j)  (2304 + 64 * (j))
#define XB_TOP      3328
#define XB_TOPGEN   3392
#define XCD_BAR_WORDS 3456
#define XB_SPIN_CAP (1u << 18)

__device__ __forceinline__ unsigned xb_ld(unsigned* p)              { return __hip_atomic_load(p, __ATOMIC_RELAXED, __HIP_MEMORY_SCOPE_AGENT); }
__device__ __forceinline__ unsigned xb_add(unsigned* p, unsigned v) { return __hip_atomic_fetch_add(p, v, __ATOMIC_RELAXED, __HIP_MEMORY_SCOPE_AGENT); }
__device__ __forceinline__ unsigned xb_xcc_id() { return (unsigned)__builtin_amdgcn_s_getreg((3 << 11) | 20) & 0xFu; }
#define XB_SPIN(cond, bar) do { unsigned _sp = 0; while (cond) { __builtin_amdgcn_s_sleep(1); \
    if ((++_sp & 255u) == 0u) { if (xb_ld(&(bar)[XB_TMO])) break; if (_sp > XB_SPIN_CAP) { atomicAdd(&(bar)[XB_TMO], 1u); break; } } } } while (0)

struct XcdBarrier {
    unsigned* bar; unsigned x;
    volatile LAS unsigned* st;
};

__device__ __forceinline__ XcdBarrier xcd_barrier_post(unsigned* bar, volatile LAS unsigned* st, const bool t0) {
    XcdBarrier b; b.bar = bar; b.x = xb_xcc_id(); b.st = st;
    if (t0) (void)xb_add(&bar[XB_XCNT(b.x)], 1u);
    return b;
}
__device__ __forceinline__ void xcd_barrier_complete(unsigned* bar, unsigned x, unsigned& nloc, unsigned& nx) {
    const unsigned G = gridDim.x * gridDim.y * gridDim.z;
    unsigned sum, cnt, mine, sp = 0u;
    for (;;) {
        sum = 0u; cnt = 0u; mine = 0u;
#pragma unroll
        for (unsigned j = 0; j < 16; ++j) { const unsigned c = xb_ld(&bar[XB_XCNT(j)]); sum += c; cnt += (c > 0u) ? 1u : 0u; mine = (j == x) ? c : mine; }
        if (sum == G) break;
        __builtin_amdgcn_s_sleep(1);
        if ((++sp & 255u) == 0u) { if (xb_ld(&bar[XB_TMO])) break; if (sp > XB_SPIN_CAP) { atomicAdd(&bar[XB_TMO], 1u); break; } }
    }
    nloc = mine > 0u ? mine : 1u; nx = cnt > 0u ? cnt : 1u;
}

__device__ __forceinline__ void xcd_barrier(const XcdBarrier& b, const bool t0) {
    asm volatile("s_waitcnt vmcnt(0)" ::: "memory");
    __syncthreads();
    if (t0) {
        unsigned* bar = b.bar;
        __builtin_amdgcn_s_waitcnt(0);
        unsigned nloc = b.st[0], nx = b.st[1];
        if (nloc == 0u) { xcd_barrier_complete(bar, b.x, nloc, nx); b.st[0] = nloc; b.st[1] = nx; }
        const unsigned old = xb_add(&bar[XB_XSUB(b.x)], 1u);
        const unsigned gen = old / nloc;
        if (old + 1u == (gen + 1u) * nloc) {
            __builtin_amdgcn_fence(__ATOMIC_RELEASE, "agent");
            asm volatile("s_waitcnt vmcnt(0)" ::: "memory");
            const unsigned og = xb_add(&bar[XB_TOP], 1u);
            const unsigned tg = og / nx;
            if (og + 1u == (tg + 1u) * nx) xb_add(&bar[XB_TOPGEN], 1u);
            else XB_SPIN(xb_ld(&bar[XB_TOPGEN]) == tg, bar);
            __builtin_amdgcn_fence(__ATOMIC_ACQUIRE, "agent");
            xb_add(&bar[XB_XGEN(b.x)], 1u);
            asm volatile("s_waitcnt vmcnt(0)" ::: "memory");
        } else {
            XB_SPIN(xb_ld(&bar[XB_XGEN(b.x)]) == gen, bar);
            __builtin_amdgcn_fence(__ATOMIC_ACQUIRE, "agent");
            asm volatile("s_waitcnt vmcnt(0)" ::: "memory");
        }
    }
    __syncthreads();
}

__global__ void __launch_bounds__(NWAVES * 64, 2) fwd_mega(Args a) {
    extern __shared__ __attribute__((aligned(16))) unsigned char lds_raw[];
    LAS unsigned char* lds = (LAS unsigned char*)lds_raw;
    cg::grid_group grid = cg::this_grid();
    const int wave = __builtin_amdgcn_readfirstlane((int)threadIdx.x >> 6);
#define LANE() ({ int z_ = 0; asm volatile("" : "+v"(z_)); (int)__builtin_amdgcn_mbcnt_hi(~0u, __builtin_amdgcn_mbcnt_lo(~0u, z_)); })
#define TID0() (wave == 0 && LANE() == 0)
    const int G = gridDim.x, bx = blockIdx.x;
    const int vcu = (G % 8 == 0) ? (bx % 8) * (G / 8) + bx / 8 : bx;
    const int gw = vcu * NWAVES + wave, NGW = G * NWAVES;
    unsigned char* ws = a.ws;
    bf16_t *W1 = (bf16_t*)(ws + WS_W1), *W1O = (bf16_t*)(ws + WS_W1O), *WMI = (bf16_t*)(ws + WS_WMI), *WMO = (bf16_t*)(ws + WS_WMO), *W2 = (bf16_t*)(ws + WS_W2), *W2O = (bf16_t*)(ws + WS_W2O);
    bf16_t *XA = (bf16_t*)(ws + WS_XA), *XB = (bf16_t*)(ws + WS_XB), *ACT = (bf16_t*)(ws + WS_ACT);
    bf16_t *Qb = ACT, *Kb = (bf16_t*)(ws + WS_ACT + QKV_STRIDE), *Vb = (bf16_t*)(ws + WS_ACT + 2 * QKV_STRIDE), *Bb = (bf16_t*)(ws + WS_ACT + 3 * QKV_STRIDE), *Zb = (bf16_t*)(ws + WS_ACT + 4 * QKV_STRIDE);
    float *part0 = (float*)(ws + WS_PART), *part1 = (float*)(ws + WS_PART + PART_STRIDE), *part2 = (float*)(ws + WS_PART + 2 * PART_STRIDE), *part3 = (float*)(ws + WS_PART + 3 * PART_STRIDE);
    float *logfT = (float*)(ws + WS_LOGF), *mpart = (float*)(ws + WS_RESM);
    bf16_t* VTm = (bf16_t*)(ws + WS_RESM + 65536);

    volatile LAS unsigned* bst = (volatile LAS unsigned*)(lds + 131072 + 64);
    unsigned* barw = (unsigned*)(ws + WS_CTL);
    { const int tid = wave * 64 + LANE(); if (tid < 2) bst[tid] = 0u;
      if (bx == 0) for (int i = tid; i < XCD_BAR_WORDS; i += NWAVES * 64) __hip_atomic_store(barw + i, 0u, __ATOMIC_RELAXED, __HIP_MEMORY_SCOPE_AGENT); }
    __syncthreads();
    p0_prologue(a, lds, gw, NGW, wave, LANE());
    grid.sync();
    const XcdBarrier bar = xcd_barrier_post(barw, bst, TID0());
#define GBAR() do { XcdBarrier b_ = bar; asm volatile("" : "+s"(b_.bar)); xcd_barrier(b_, TID0()); } while (0)
    if (vcu < 176) meta_up(XA, W1, ACT, part0, vcu, lds, wave, LANE());
    { pg8::Gemm g{XA, W1, M, 2 * DFF, D}; pg8::StaticOrder S; S.init(M, 2 * DFF, G, bx); EpiSwiGLU E{ACT, part0};
      pg8::gemm_phase<EpiSwiGLU, pg8::StaticOrder, true, true>(lds, g, S, E, wave); }
    GBAR();
    if (vcu < 64) meta_down(ACT, W1O, a.in[I_META], XA, mpart, vcu, lds, wave, LANE());
    { pg8::Gemm g{ACT, W1O, M, D, DFF}; pg8::StaticOrder S; S.init(M, D, G, bx); EpiResid<false> E{XA, nullptr, XA, part1, 0.5f};
      pg8::gemm_phase<EpiResid<false>, pg8::StaticOrder, true, true>(lds, g, S, E, wave); }
    GBAR();
    if (vcu < 33) meta_mix(XA, WMI, Kb, VTm, Zb, logfT, mpart, a.in[I_KN], a.in[I_BF], vcu, lds, wave, LANE());
    { const int ln = LANE(); for (int it = vcu; it < M / 128; it += G) flog_wg(XA, WMI, logfT, part1, a.in[I_BF], it * 128, lds, wave, ln); }
    { pg8::Gemm g{XA, WMI, M, 3072, D}; pg8::StaticOrder S; S.init(M, 3072, G, bx); EpiMixIn E{Qb, Kb, Vb, Bb, Zb, logfT, part1, a.in[I_QN], a.in[I_KN], a.in[I_BF]};
      pg8::gemm_phase<EpiMixIn, pg8::StaticOrder, true, true>(lds, g, S, E, wave); }
    GBAR();
    { const int lane4 = LANE(); float gq = fabsf(a.in[I_QN][lane4]), gk = fabsf(a.in[I_KN][lane4]);
#pragma unroll
      for (int o = 1; o < 64; o <<= 1) { gq = fmaxf(gq, __shfl_xor(gq, o)); gk = fmaxf(gk, __shfl_xor(gk, o)); }
      MixP mp{Qb, Kb, Vb, VTm, Bb, Zb, logfT, a.in[I_CW], XB, 2.0f * (8.0f * gq * gk * LOG2E * 1.05f) + 170.0f};
      constexpr int NU = M / 32;
      for (int u = vcu; u < NU; u += G) { const int b = u / (SEQ / 32), t0 = (u % (SEQ / 32)) * 32; mixer_unit(mp, b, t0, lds, wave, lane4); } }
    GBAR();
    { pg8::Gemm g{XB, WMO, M, D, D}; pg8::StaticOrder S; S.init(M, D, G, bx); EpiResid<false> E{XA, nullptr, XA, part2, 1.0f};
      pg8::gemm_phase<EpiResid<false>, pg8::StaticOrder, true, true>(lds, g, S, E, wave); }
    GBAR();
    { pg8::Gemm g{XA, W2, M, 2 * DFF, D}; pg8::StaticOrder S; S.init(M, 2 * DFF, G, bx); EpiSwiGLU E{ACT, part2};
      pg8::gemm_phase<EpiSwiGLU, pg8::StaticOrder, true, true>(lds, g, S, E, wave); }
    GBAR();
    { pg8::Gemm g{ACT, W2O, M, D, DFF}; pg8::StaticOrder S; S.init(M, D, G, bx); EpiResid<false> E{XA, nullptr, XA, part3, 0.5f};
      pg8::gemm_phase<EpiResid<false>, pg8::StaticOrder, true, true>(lds, g, S, E, wave); }
    GBAR();
    { const int lane = LANE(); const float* gfn = a.in[I_FN]; f32x4 gv[4];
#pragma unroll
      for (int j = 0; j < 4; ++j) gv[j] = ((const f32x4*)gfn)[lane + 64 * j];
      for (int row = gw; row < M; row += NGW) { const float rs = row_rstd(part3, row); f32x4* rp = (f32x4*)(a.out + (size_t)row * D); const u32x2* hp = (const u32x2*)(XA + (size_t)row * D);
#pragma unroll
          for (int j = 0; j < 4; ++j) { const u32x2 hv = hp[lane + 64 * j]; const f32x4 v = (f32x4){bf_lo(hv.x), bf_hi(hv.x), bf_lo(hv.y), bf_hi(hv.y)}; rp[lane + 64 * j] = v * rs * gv[j]; } } }
}

extern "C" void kernel_launch(void* const* d_in, const int* in_sizes, int n_in, void* d_out, int out_size, void* d_ws, size_t ws_size, hipStream_t stream) {
    static int grid = 0;
    if (grid == 0) {
        if (n_in != 18 || in_sizes[0] != M * D || out_size != M * D || ws_size < WS_END) { fprintf(stderr, "kernel_launch: unexpected shapes (n_in %d, in0 %d, out %d, ws %zu < %zu)\n", n_in, n_in > 0 ? in_sizes[0] : -1, out_size, ws_size, (size_t)WS_END); grid = -1; return; }
        int dev = 0, cus = 0, per_cu = 0;
        if (hipGetDevice(&dev) != hipSuccess || hipDeviceGetAttribute(&cus, hipDeviceAttributeMultiprocessorCount, dev) != hipSuccess) { grid = -1; return; }
        if (hipFuncSetAttribute((const void*)fwd_mega, hipFuncAttributeMaxDynamicSharedMemorySize, LDS_BYTES) != hipSuccess) { fprintf(stderr, "kernel_launch: hipFuncSetAttribute failed\n"); grid = -1; return; }
        if (hipOccupancyMaxActiveBlocksPerMultiprocessor(&per_cu, (const void*)fwd_mega, NWAVES * 64, LDS_BYTES) != hipSuccess || per_cu < 1) { fprintf(stderr, "kernel_launch: occupancy query gave %d\n", per_cu); (void)hipGetLastError(); grid = -1; return; }
        grid = cus * per_cu;
    }
    if (grid < 0) return;
    Args a{};
    for (int i = 0; i < 18; ++i) a.in[i] = (const float*)d_in[i];
    a.out = (float*)d_out; a.ws = (unsigned char*)d_ws;
    void* args[] = {&a};
    const hipError_t e = hipLaunchCooperativeKernel((const void*)fwd_mega, dim3(grid), dim3(NWAVES * 64), args, LDS_BYTES, stream);
    if (e != hipSuccess) fprintf(stderr, "kernel_launch: cooperative launch failed: %s (grid %d)\n", hipGetErrorString(e), grid);
}
```

```cpp
#include <hip/hip_runtime.h>
#include <hip/hip_cooperative_groups.h>
#include <cstdio>
#include <cstdint>
#include <cmath>
namespace cg = cooperative_groups;
namespace pg8 {
#define PG8_LAS __attribute__((address_space(3)))
typedef unsigned short bf16_t;
typedef short bf16x8 __attribute__((ext_vector_type(8)));
typedef float f32x4 __attribute__((ext_vector_type(4)));
typedef unsigned u32x4 __attribute__((ext_vector_type(4)));
constexpr int BM = 256, BK = 64, HALF = 128, HTB = HALF * BK * 2  , STAGE_BYTES = 8 * HTB, NXCD = 8, WGM = 8;

__host__ __device__ __forceinline__ int lds_byte(int r, int c) { const int st = (r >> 4) * 2 + (c >> 5), rr = r & 15, cc = c & 31, ob = rr * 64 + cc * 2; return st * 1024 + (ob ^ (((ob >> 9) & 1) << 5)); }
__host__ __device__ __forceinline__ void stage_rc(int b, int& R, int& C) { const int st = b / 1024, sb = b % 1024, swz = sb ^ (((sb >> 9) & 1) << 5); R = (st >> 1) * 16 + swz / 64; C = (st & 1) * 32 + (swz % 64) / 2; }
__host__ __device__ __forceinline__ int perm32(int rho) { const int n = rho >> 4, i = rho & 15; return 8 * (i >> 2) + 4 * n + (i & 3); }

struct Unit { int pm, pn, ui; };
struct Gemm { const bf16_t* A; const bf16_t* Bt; int M, N, K; };

struct StaticOrder {
    int nM, nN, nwg, G, c;
    __host__ __device__ void init(int M, int N, int G_, int c_) { nM = M / BM; nN = N / BM; nwg = nM * nN; G = G_; c = c_; }
    __host__ __device__ bool next(int i, Unit& u) const {
        const long L = (long)i * G + c; if (L >= nwg) return false;
        int wgid = (int)L; { const int q = nwg / NXCD, r = nwg % NXCD, xcd = wgid % NXCD, off = wgid / NXCD; wgid = (xcd < r ? xcd * (q + 1) : r * (q + 1) + (xcd - r) * q) + off; }
        const int nig = WGM * nN, gid = wgid / nig, fm = gid * WGM, gsz = (nM - fm) < WGM ? (nM - fm) : WGM;
        u.pm = fm + ((wgid % nig) % gsz); u.pn = (wgid % nig) / gsz; u.ui = i; return true;
    }
    __device__ __forceinline__ void a_ready(const Unit&) const {}
    __device__ __forceinline__ void done(const Unit&) const {}
};

__device__ __forceinline__ unsigned cvt_pk_bf16(float lo, float hi) { unsigned r; asm volatile("v_cvt_pk_bf16_f32 %0, %1, %2" : "=v"(r) : "v"(lo), "v"(hi)); return r; }
typedef float f32x2 __attribute__((ext_vector_type(2)));
template <class Epi, class Sched, bool ALIGN_EPI = false, bool SP2 = false>
__device__ __forceinline__ void gemm_phase(PG8_LAS unsigned char* lds, const Gemm g, const Sched& S, const Epi& E, const int wid) {
    int z_ = 0; asm volatile("" : "+v"(z_)); const int lane_ = __builtin_amdgcn_mbcnt_hi(~0u, __builtin_amdgcn_mbcnt_lo(~0u, z_));
    const int lane = lane_, tid = wid * 64 + lane, wr = wid >> 2, wc = wid & 3, fr = lane & 15, fq = lane >> 4;
    const int K = g.K, nt = K / BK;
    unsigned voffA[2], voffB[2];
#pragma unroll
    for (int i = 0; i < 2; ++i) { int R, C; stage_rc(tid * 16 + i * 8192, R, C); const int Rb = Epi::PERM ? ((R & ~31) + perm32(R & 31)) : R;
        voffA[i] = (unsigned)(R * K + C) * 2u; voffB[i] = (unsigned)(Rb * K + C) * 2u; }
    const size_t kstep = (size_t)(BK * 2);
    const size_t hstep = (size_t)HALF * K * 2;
    const size_t tstep = 2 * hstep;
    const unsigned ldsw = (unsigned)wid * 1024u;
    const int aoff = lds_byte(wr * 64 + fr, fq * 8), boff = lds_byte(wc * 32 + fr, fq * 8);
#define PG8_SA(b, h) (((b) * 2 + (h)) * HTB)
#define PG8_SB(b, h) ((4 + (b) * 2 + (h)) * HTB)
#define PG8_STAGE(bufoff, gbase, voff) do { _Pragma("unroll") for (int _i = 0; _i < 2; ++_i) \
        __builtin_amdgcn_global_load_lds((const unsigned*)((const char*)(gbase) + (voff)[_i]), (PG8_LAS unsigned*)(lds + (bufoff) + ldsw + _i * 8192), 16, 0, 0); } while (0)
#define PG8_LDA(dst, b, h) do { _Pragma("unroll") for (int m = 0; m < 4; ++m) _Pragma("unroll") for (int k = 0; k < 2; ++k) dst[m][k] = *(const PG8_LAS bf16x8*)(lds + PG8_SA(b, h) + aoff + m * 2048 + k * 1024); } while (0)
#define PG8_LDB(dst, b, h) do { _Pragma("unroll") for (int n = 0; n < 2; ++n) _Pragma("unroll") for (int k = 0; k < 2; ++k) dst[n][k] = *(const PG8_LAS bf16x8*)(lds + PG8_SB(b, h) + boff + n * 2048 + k * 1024); } while (0)
#define PG8_MMA(ai, bj, At, Bt) do { __builtin_amdgcn_s_setprio(1); _Pragma("unroll") for (int m = 0; m < 4; ++m) _Pragma("unroll") for (int n = 0; n < 2; ++n) _Pragma("unroll") for (int k = 0; k < 2; ++k) \
        acc[ai][bj][m][n] = __builtin_amdgcn_mfma_f32_16x16x32_bf16(Bt[n][k], At[m][k], acc[ai][bj][m][n], 0, 0, 0); __builtin_amdgcn_s_setprio(0); } while (0)
#define PG8_WAIT_V(n) asm volatile("s_waitcnt vmcnt(" #n ")" ::: "memory")
#define PG8_WAIT_L(n) asm volatile("s_waitcnt lgkmcnt(" #n ")" ::: "memory")
#define PG8_BAR __builtin_amdgcn_s_barrier()
#define PG8_SCHED __builtin_amdgcn_sched_barrier(0)
    Unit cur, nxt; int ui = 0;
    if (!S.next(0, cur)) return;
    f32x4 acc[2][2][4][2];
#pragma unroll
    for (int a = 0; a < 2; ++a)
#pragma unroll
        for (int b = 0; b < 2; ++b)
#pragma unroll
            for (int m = 0; m < 4; ++m)
#pragma unroll
                for (int n = 0; n < 2; ++n) acc[a][b][m][n] = (f32x4){0.f, 0.f, 0.f, 0.f};
    bf16x8 At[4][2], B0[2][2], B1[2][2];
    const char* cA = (const char*)g.A + (size_t)cur.pm * tstep; const char* cB = (const char*)g.Bt + (size_t)cur.pn * tstep;
    S.a_ready(cur);
    if constexpr (SP2) {
        PG8_STAGE(PG8_SB(0, 0), cB, voffB); PG8_STAGE(PG8_SB(0, 1), cB + hstep, voffB); PG8_STAGE(PG8_SA(0, 0), cA, voffA); PG8_STAGE(PG8_SA(0, 1), cA + hstep, voffA);
        if (wr == 1) PG8_BAR;
        PG8_WAIT_V(2); PG8_BAR;
        PG8_STAGE(PG8_SB(1, 0), cB + kstep, voffB); PG8_STAGE(PG8_SA(1, 0), cA + kstep, voffA); PG8_STAGE(PG8_SB(1, 1), cB + hstep + kstep, voffB);
        PG8_WAIT_V(6); PG8_BAR;
    } else {
        PG8_STAGE(PG8_SB(0, 0), cB, voffB); PG8_STAGE(PG8_SA(0, 0), cA, voffA); PG8_STAGE(PG8_SB(0, 1), cB + hstep, voffB); PG8_STAGE(PG8_SA(0, 1), cA + hstep, voffA);
        if (wr == 1) PG8_BAR;
        PG8_WAIT_V(4); PG8_BAR;
        PG8_STAGE(PG8_SB(1, 0), cB + kstep, voffB); PG8_STAGE(PG8_SA(1, 0), cA + kstep, voffA); PG8_STAGE(PG8_SB(1, 1), cB + hstep + kstep, voffB);
        PG8_WAIT_V(6); PG8_BAR;
    }
    for (;;) {
        const bool has_next = S.next(ui + 1, nxt);
        const char* nA = has_next ? (const char*)g.A + (size_t)nxt.pm * tstep : cA; const char* nB = has_next ? (const char*)g.Bt + (size_t)nxt.pn * tstep : cB;
        for (int t = 0; t < nt; t += 2) {
            const bool last = (t == nt - 2);
            const char* a1 = cA + (size_t)(t + 1) * kstep;
            const char* a2 = last ? nA : cA + (size_t)(t + 2) * kstep; const char* b2 = last ? nB : cB + (size_t)(t + 2) * kstep;
            const char* a3 = a2 + kstep; const char* b3 = b2 + kstep;
            if (last && has_next) S.a_ready(nxt);
            if constexpr (SP2) {
            PG8_LDB(B0, 0, 0); PG8_LDB(B1, 0, 1); PG8_SCHED; PG8_LDA(At, 0, 0); PG8_STAGE(PG8_SA(1, 1), a1 + hstep, voffA);
            PG8_WAIT_V(8); PG8_WAIT_L(0); PG8_BAR; PG8_MMA(0, 0, At, B0); PG8_MMA(0, 1, At, B1); PG8_BAR; PG8_SCHED;
            PG8_LDA(At, 0, 1); PG8_STAGE(PG8_SB(0, 0), b2, voffB); PG8_STAGE(PG8_SB(0, 1), b2 + hstep, voffB); PG8_STAGE(PG8_SA(0, 0), a2, voffA);
            PG8_WAIT_V(8); PG8_WAIT_L(0); PG8_BAR; PG8_MMA(1, 0, At, B0); PG8_MMA(1, 1, At, B1); PG8_BAR; PG8_SCHED;
            PG8_LDB(B0, 1, 0); PG8_LDB(B1, 1, 1); PG8_SCHED; PG8_LDA(At, 1, 0); PG8_STAGE(PG8_SA(0, 1), a2 + hstep, voffA);
            PG8_WAIT_V(8); PG8_WAIT_L(0); PG8_BAR; PG8_MMA(0, 0, At, B0); PG8_MMA(0, 1, At, B1); PG8_BAR; PG8_SCHED;
            PG8_LDA(At, 1, 1); PG8_STAGE(PG8_SB(1, 0), b3, voffB); PG8_STAGE(PG8_SB(1, 1), b3 + hstep, voffB); PG8_STAGE(PG8_SA(1, 0), a3, voffA);
            PG8_WAIT_V(8); PG8_WAIT_L(0); PG8_BAR; PG8_MMA(1, 0, At, B0); PG8_MMA(1, 1, At, B1); PG8_BAR; PG8_SCHED;
            } else {
            PG8_LDB(B0, 0, 0); PG8_SCHED; PG8_LDA(At, 0, 0); PG8_STAGE(PG8_SA(1, 1), a1 + hstep, voffA);
            PG8_WAIT_L(8); PG8_BAR; PG8_WAIT_L(0); PG8_MMA(0, 0, At, B0); PG8_BAR; PG8_SCHED;
            PG8_LDB(B1, 0, 1); PG8_STAGE(PG8_SB(0, 0), b2, voffB);
            PG8_BAR; PG8_WAIT_L(0); PG8_MMA(0, 1, At, B1); PG8_BAR;
            PG8_LDA(At, 0, 1); PG8_STAGE(PG8_SA(0, 0), a2, voffA);
            PG8_BAR; PG8_WAIT_L(0); PG8_MMA(1, 0, At, B0); PG8_BAR; PG8_SCHED;
            PG8_STAGE(PG8_SB(0, 1), b2 + hstep, voffB);
            PG8_WAIT_V(6); PG8_BAR; PG8_MMA(1, 1, At, B1); PG8_BAR;
            PG8_LDB(B0, 1, 0); PG8_SCHED; PG8_LDA(At, 1, 0); PG8_STAGE(PG8_SA(0, 1), a2 + hstep, voffA);
            PG8_WAIT_L(8); PG8_BAR; PG8_WAIT_L(0); PG8_MMA(0, 0, At, B0); PG8_BAR; PG8_SCHED;
            PG8_LDB(B1, 1, 1); PG8_STAGE(PG8_SB(1, 0), b3, voffB);
            PG8_BAR; PG8_WAIT_L(0); PG8_MMA(0, 1, At, B1); PG8_BAR;
            PG8_LDA(At, 1, 1); PG8_STAGE(PG8_SA(1, 0), a3, voffA);
            PG8_BAR; PG8_WAIT_L(0); PG8_MMA(1, 0, At, B0); PG8_BAR; PG8_SCHED;
            PG8_STAGE(PG8_SB(1, 1), b3 + hstep, voffB);
            PG8_WAIT_V(6); PG8_BAR; PG8_MMA(1, 1, At, B1); PG8_BAR;
            }
        }
        if constexpr (ALIGN_EPI) { if (wr == 0) PG8_BAR; }
        if constexpr (!Epi::AFTER_DRAIN) { E(acc, cur, wr, wc, fr, fq); S.done(cur); }
        if (!has_next) break;
#pragma unroll
        for (int a = 0; a < 2; ++a)
#pragma unroll
            for (int b = 0; b < 2; ++b)
#pragma unroll
                for (int m = 0; m < 4; ++m)
#pragma unroll
                    for (int n = 0; n < 2; ++n) acc[a][b][m][n] = (f32x4){0.f, 0.f, 0.f, 0.f};
        cur = nxt; cA = nA; cB = nB; ++ui;
        if constexpr (ALIGN_EPI) { if (wr == 1) PG8_BAR; }
    }
    PG8_WAIT_V(0);
    if constexpr (!ALIGN_EPI) { if (wr == 0) PG8_BAR; }
    PG8_BAR;
    if constexpr (Epi::AFTER_DRAIN) { E.fused(acc, cur, wr, wc, fr, fq, lds, wid, lane); S.done(cur); }
#undef PG8_SA
#undef PG8_SB
#undef PG8_STAGE
#undef PG8_LDA
#undef PG8_LDB
#undef PG8_MMA
#undef PG8_WAIT_V
#undef PG8_WAIT_L
#undef PG8_BAR
#undef PG8_SCHED
}
}

using pg8::bf16_t; using pg8::bf16x8; using pg8::f32x4; using pg8::u32x4;
typedef float f32x16 __attribute__((ext_vector_type(16)));
typedef unsigned u32x2 __attribute__((ext_vector_type(2)));
#define LAS __attribute__((address_space(3)))
constexpr int D = 1024, BATCH = 4, SEQ = 8192, DFF = 2816, DH = 512, NH = 8;
constexpr int M = BATCH * SEQ;
constexpr int MP = M + 256;
constexpr int NMI = 3328;
constexpr float EPS = 1e-6f, LOG2E = 1.4426950408889634f;
constexpr int NWAVES = 8, LDS_BYTES = 147456;

constexpr size_t MiB = 1u << 20;
constexpr size_t WS_CTL = 0;
constexpr size_t WS_W1 = 2 * MiB, WS_W1O = 13 * MiB, WS_WMI = 19 * MiB, WS_WMO = 26 * MiB, WS_W2 = 28 * MiB, WS_W2O = 39 * MiB;
constexpr size_t WS_PART = 45 * MiB, PART_STRIDE = 2304 * 1024;
constexpr size_t WS_LOGF = 54 * MiB;
constexpr size_t WS_RESM = 56 * MiB;
constexpr size_t WS_XA = 58 * MiB;
constexpr size_t WS_XB = 123 * MiB;
constexpr size_t WS_ACT = 187 * MiB;
constexpr size_t QKV_STRIDE = (size_t)MP * DH * 2;
constexpr size_t WS_END = WS_ACT + (size_t)MP * DFF * 2;
static_assert(5 * QKV_STRIDE <= (size_t)MP * DFF * 2, "P3 outputs overlay the activation buffer");
static_assert((size_t)MP * 16 * 4 <= PART_STRIDE && WS_PART + 4 * PART_STRIDE <= WS_LOGF, "ws map");

__device__ __forceinline__ unsigned cvtpk(float lo, float hi) { return pg8::cvt_pk_bf16(lo, hi); }
__device__ __forceinline__ float bf_lo(unsigned u) { return __uint_as_float(u << 16); }
__device__ __forceinline__ float bf_hi(unsigned u) { return __uint_as_float(u & 0xffff0000u); }
__device__ __forceinline__ float wave_sum(float v) {
#pragma unroll
    for (int o = 1; o < 64; o <<= 1) v += __shfl_xor(v, o);
    return v;
}
__device__ __forceinline__ float row_rstd(const float* part, int row) {
    const f32x4* p = (const f32x4*)(part + (size_t)row * 16);
    const f32x4 a = p[0], b = p[1], c = p[2], d = p[3];
    const f32x4 s = (a + b) + (c + d);
    const float t = (s[0] + s[1]) + (s[2] + s[3]);
    return __builtin_amdgcn_rsqf(t * (1.0f / 1024.0f) + EPS);
}

constexpr int RSTAB_OFF = 131072 + 1024;
template <class Sched> __device__ __forceinline__ void rstd_table(const Sched& S, const float* part, LAS unsigned char* lds, int wave, int lane) {
    LAS float* tab = (LAS float*)(lds + RSTAB_OFF); pg8::Unit u; int nu = 0;
    while (nu < 11 && S.next(nu, u)) ++nu;
    const int t = wave * 64 + lane;
#pragma unroll 6
    for (int k = t; k < nu * 256; k += NWAVES * 64) { S.next(k >> 8, u); tab[k] = row_rstd(part, u.pm * 256 + (k & 255)); }
    __syncthreads();
}


struct EpiSwiGLU {
    static constexpr bool PERM = true, AFTER_DRAIN = false;
    bf16_t* O; const LAS float* tab;
    __device__ __forceinline__ void operator()(const f32x4 (&acc)[2][2][4][2], const pg8::Unit& u, int wr, int wc, int fr, int fq) const {
        const int row0 = u.pm * 256 + wr * 64 + fr, col0 = u.pn * 128 + wc * 32 + 8 * fq; const LAS float* tb = tab + u.ui * 256 + wr * 64 + fr;
#pragma unroll
        for (int ai = 0; ai < 2; ++ai)
#pragma unroll
            for (int m = 0; m < 4; ++m) {
                const int row = row0 + ai * 128 + m * 16; const float rs = tb[ai * 128 + m * 16]; const float nrl = -rs * LOG2E, rs2 = rs * rs;
                f32x4 o[2];
#pragma unroll
                for (int n = 0; n < 2; ++n) { const f32x4 G = acc[ai][0][m][n], U = acc[ai][1][m][n]; const f32x4 T = G * nrl; f32x4 Rr;
#pragma unroll
                    for (int i = 0; i < 4; ++i) Rr[i] = __builtin_amdgcn_rcpf(1.0f + __builtin_amdgcn_exp2f(T[i]));
                    o[n] = (G * U) * (Rr * rs2); }
                u32x4 w; w.x = cvtpk(o[0][0], o[0][1]); w.y = cvtpk(o[0][2], o[0][3]); w.z = cvtpk(o[1][0], o[1][1]); w.w = cvtpk(o[1][2], o[1][3]);
                *(u32x4*)(O + (size_t)row * DFF + col0) = w;
            }
    }
};

template <bool F32OUT> struct EpiResid {
    static constexpr bool PERM = true, AFTER_DRAIN = false;
    const bf16_t* res; float* out; bf16_t* hb; float* part; float alpha;
    __device__ __forceinline__ void operator()(const f32x4 (&acc)[2][2][4][2], const pg8::Unit& u, int wr, int wc, int fr, int fq) const {
        const int row0 = u.pm * 256 + wr * 64 + fr, col0 = u.pn * 256 + wc * 32 + 8 * fq;
        u32x4 rb[2][4][2];
#pragma unroll
        for (int ai = 0; ai < 2; ++ai)
#pragma unroll
            for (int m = 0; m < 4; ++m)
#pragma unroll
                for (int bj = 0; bj < 2; ++bj) rb[ai][m][bj] = *(const u32x4*)(res + (size_t)(row0 + ai * 128 + m * 16) * D + col0 + 128 * bj);
#pragma unroll
        for (int ai = 0; ai < 2; ++ai)
#pragma unroll
            for (int m = 0; m < 4; ++m) {
                const int row = row0 + ai * 128 + m * 16;
                float ss = 0.f;
#pragma unroll
                for (int bj = 0; bj < 2; ++bj) { const int c = col0 + 128 * bj;
                    const u32x4 rv = rb[ai][m][bj];
                    const f32x4 r0 = (f32x4){bf_lo(rv.x), bf_hi(rv.x), bf_lo(rv.y), bf_hi(rv.y)}, r1 = (f32x4){bf_lo(rv.z), bf_hi(rv.z), bf_lo(rv.w), bf_hi(rv.w)};
                    const f32x4 v0 = r0 + acc[ai][bj][m][0] * alpha, v1 = r1 + acc[ai][bj][m][1] * alpha;
                    if (F32OUT) { float* op = out + (size_t)row * D + c; *(f32x4*)op = v0; *(f32x4*)(op + 4) = v1; }
                    else { u32x4 w; w.x = cvtpk(v0[0], v0[1]); w.y = cvtpk(v0[2], v0[3]); w.z = cvtpk(v1[0], v1[1]); w.w = cvtpk(v1[2], v1[3]);
                        *(u32x4*)(hb + (size_t)row * D + c) = w; }
                    ss += (v0[0] * v0[0] + v0[1] * v0[1]) + (v0[2] * v0[2] + v0[3] * v0[3]) + (v1[0] * v1[0] + v1[1] * v1[1]) + (v1[2] * v1[2] + v1[3] * v1[3]); }
                ss += __shfl_xor(ss, 16); ss += __shfl_xor(ss, 32);
                if (fq == 0) part[(size_t)row * 16 + u.pn * 4 + wc] = ss;
            }
    }
};

struct EpiMixIn {
    static constexpr bool PERM = true, AFTER_DRAIN = false;
    bf16_t *Q, *K, *V, *B, *Z; float* logfT; const LAS float* tab; const float *qn, *kn, *bfg;
    __device__ __forceinline__ void operator()(const f32x4 (&acc)[2][2][4][2], const pg8::Unit& u, int wr, int wc, int fr, int fq) const {
        const int row0 = u.pm * 256 + wr * 64 + fr, pn = u.pn; const LAS float* tb = tab + u.ui * 256 + wr * 64 + fr;
        if (pn < 4) {
            const float* gp = (pn < 2 ? qn : kn) + 8 * fq; bf16_t* base = pn < 2 ? Q : K; const float sc = pn < 2 ? 0.125f * LOG2E : 1.0f;
            const int head = (pn & 1) * 4 + wc;
            float g[2][8];
#pragma unroll
            for (int bj = 0; bj < 2; ++bj)
#pragma unroll
                for (int i = 0; i < 8; ++i) g[bj][i] = gp[bj * 32 + i] * sc;
#pragma unroll
            for (int ai = 0; ai < 2; ++ai)
#pragma unroll
                for (int m = 0; m < 4; ++m) {
                    const int row = row0 + ai * 128 + m * 16; const float rs = tb[ai * 128 + m * 16];
                    float a[2][8]; float ss = 0.f;
#pragma unroll
                    for (int bj = 0; bj < 2; ++bj)
#pragma unroll
                        for (int i = 0; i < 8; ++i) { a[bj][i] = acc[ai][bj][m][i >> 2][i & 3] * rs; ss += a[bj][i] * a[bj][i]; }
                    ss += __shfl_xor(ss, 16); ss += __shfl_xor(ss, 32);
                    const float rr = 1.0f / sqrtf(ss * (1.0f / 64.0f) + EPS);
#pragma unroll
                    for (int bj = 0; bj < 2; ++bj) { u32x4 w;
                        w.x = cvtpk(a[bj][0] * rr * g[bj][0], a[bj][1] * rr * g[bj][1]); w.y = cvtpk(a[bj][2] * rr * g[bj][2], a[bj][3] * rr * g[bj][3]);
                        w.z = cvtpk(a[bj][4] * rr * g[bj][4], a[bj][5] * rr * g[bj][5]); w.w = cvtpk(a[bj][6] * rr * g[bj][6], a[bj][7] * rr * g[bj][7]);
                        *(u32x4*)(base + (size_t)row * DH + head * 64 + bj * 32 + 8 * fq) = w; }
                }
        } else if (pn < 6) {
            const int col0 = (pn & 1) * 256 + wc * 32 + 8 * fq;
#pragma unroll
            for (int ai = 0; ai < 2; ++ai)
#pragma unroll
                for (int m = 0; m < 4; ++m) {
                    const int row = row0 + ai * 128 + m * 16; const float rs = tb[ai * 128 + m * 16]; const int bb = row / SEQ, t = row % SEQ;
#pragma unroll
                    for (int bj = 0; bj < 2; ++bj) { const int c = col0 + 128 * bj; bf16_t* vp = V + ((size_t)(bb * NH) * 64 + c) * SEQ + t;
                        const f32x4 v0 = acc[ai][bj][m][0] * rs, v1 = acc[ai][bj][m][1] * rs;
                        const unsigned w0 = cvtpk(v0[0], v0[1]), w1 = cvtpk(v0[2], v0[3]), w2 = cvtpk(v1[0], v1[1]), w3 = cvtpk(v1[2], v1[3]);
                        vp[0] = (bf16_t)w0; vp[SEQ] = (bf16_t)(w0 >> 16); vp[2 * SEQ] = (bf16_t)w1; vp[3 * SEQ] = (bf16_t)(w1 >> 16);
                        vp[4 * SEQ] = (bf16_t)w2; vp[5 * SEQ] = (bf16_t)(w2 >> 16); vp[6 * SEQ] = (bf16_t)w3; vp[7 * SEQ] = (bf16_t)(w3 >> 16); }
                }
        } else if (pn < 8) {
            bf16_t* base = B; const int col0 = (pn & 1) * 256 + wc * 32 + 8 * fq;
#pragma unroll
            for (int ai = 0; ai < 2; ++ai)
#pragma unroll
                for (int m = 0; m < 4; ++m) {
                    const int row = row0 + ai * 128 + m * 16; const float rs = tb[ai * 128 + m * 16];
#pragma unroll
                    for (int bj = 0; bj < 2; ++bj) { const f32x4 v0 = acc[ai][bj][m][0] * rs, v1 = acc[ai][bj][m][1] * rs; u32x4 w;
                        w.x = cvtpk(v0[0], v0[1]); w.y = cvtpk(v0[2], v0[3]); w.z = cvtpk(v1[0], v1[1]); w.w = cvtpk(v1[2], v1[3]);
                        *(u32x4*)(base + (size_t)row * DH + col0 + 128 * bj) = w; }
                }
        } else if (pn < 12) {
            const int col0 = (pn - 8) * 128 + wc * 32 + 8 * fq;
#pragma unroll
            for (int ai = 0; ai < 2; ++ai)
#pragma unroll
                for (int m = 0; m < 4; ++m) {
                    const int row = row0 + ai * 128 + m * 16; const float rs = tb[ai * 128 + m * 16]; const float r2 = rs * rs;
                    const f32x4 v0 = acc[ai][0][m][0] * acc[ai][1][m][0] * r2, v1 = acc[ai][0][m][1] * acc[ai][1][m][1] * r2; u32x4 w;
                    w.x = cvtpk(v0[0], v0[1]); w.y = cvtpk(v0[2], v0[3]); w.z = cvtpk(v1[0], v1[1]); w.w = cvtpk(v1[2], v1[3]);
                    *(u32x4*)(Z + (size_t)row * DH + col0) = w;
                }
        }
    }
};

__device__ __forceinline__ void conv_item(const float* W, int N, int K, bf16_t* WT, int dr0, int sc0, int nvalid, const float* ks, int kb, LAS float* scr, int lane) {
    const int k0 = 64 * kb, n = lane & 31;
#pragma unroll 8
    for (int i = 0; i < 32; ++i) { const int kk = 2 * i + (lane >> 5);
        float v = 0.f; if (n < nvalid) { v = W[(size_t)(k0 + kk) * N + sc0 + n]; if (ks) v *= ks[k0 + kk]; }
        scr[kk * 33 + n] = v; }
    asm volatile("s_waitcnt lgkmcnt(0)" ::: "memory");
    const int c = lane & 7;
#pragma unroll
    for (int j = 0; j < 4; ++j) { const int nn = (lane >> 3) + 8 * j; const LAS float* s = scr + (8 * c) * 33 + nn;
        u32x4 o; o.x = cvtpk(s[0 * 33], s[1 * 33]); o.y = cvtpk(s[2 * 33], s[3 * 33]); o.z = cvtpk(s[4 * 33], s[5 * 33]); o.w = cvtpk(s[6 * 33], s[7 * 33]);
        *(u32x4*)(WT + (size_t)(dr0 + nn) * K + k0 + 8 * c) = o; }
    asm volatile("s_waitcnt lgkmcnt(0)" ::: "memory");
}

struct Args { const float* in[18]; float* out; unsigned char* ws; };
enum { I_X = 0, I_META, I_F1N, I_F1WI, I_F1WO, I_MIXN, I_WMI, I_BF, I_QN, I_KN, I_CW, I_AON, I_CON, I_WMO, I_F2N, I_F2WI, I_F2WO, I_FN };

__device__ __forceinline__ void p0_prologue(const Args& a, LAS unsigned char* lds, int gw, int NGW, int wave, int lane) {
    unsigned char* ws = a.ws;
    LAS float* scr = (LAS float*)(lds + wave * 16384);
    constexpr int I_IN = (2 * DFF / 32) * (D / 64), I_OUT = (D / 32) * (DFF / 64), I_MI = (NMI / 32) * (D / 64), I_MO = (D / 32) * (D / 64);
    constexpr int NITEMS = 2 * I_IN + 2 * I_OUT + I_MI + I_MO;
    for (int it = gw; it < NITEMS; it += NGW) {
        int r = it;
        if (r < 2 * I_IN) { const int which = r >= I_IN; r -= which * I_IN; const int nblk = 2 * DFF / 32, kb = r / nblk, dr0 = (r % nblk) * 32;
            const int pn = dr0 >> 8, within = dr0 & 255, bj = within >> 7, i0 = within & 127;
            conv_item(a.in[which ? I_F2WI : I_F1WI], 2 * DFF, D, (bf16_t*)(ws + (which ? WS_W2 : WS_W1)), dr0, bj * DFF + pn * 128 + i0, 32, a.in[which ? I_F2N : I_F1N], kb, scr, lane); continue; }
        r -= 2 * I_IN;
        if (r < 2 * I_OUT) { const int which = r >= I_OUT; r -= which * I_OUT; const int nblk = D / 32, kb = r / nblk, dr0 = (r % nblk) * 32;
            conv_item(a.in[which ? I_F2WO : I_F1WO], D, DFF, (bf16_t*)(ws + (which ? WS_W2O : WS_W1O)), dr0, dr0, 32, nullptr, kb, scr, lane); continue; }
        r -= 2 * I_OUT;
        if (r < I_MI) { const int nblk = NMI / 32, kb = r / nblk, dr0 = (r % nblk) * 32;
            const int pn = dr0 >> 8, within = dr0 & 255, bj = within >> 7, i0 = within & 127, wcw = i0 >> 5;
            int sc0, nv = 32;
            if (pn < 4) sc0 = (pn >> 1) * 512 + ((pn & 1) * 4 + wcw) * 64 + bj * 32;
            else if (pn < 6) sc0 = dr0;
            else if (pn < 8) sc0 = 1544 + (dr0 - 1536);
            else if (pn < 12) sc0 = (bj ? 2568 : 2056) + 128 * (pn - 8) + i0;
            else { sc0 = 1536; nv = (dr0 == 3072) ? 8 : 0; }
            conv_item(a.in[I_WMI], 3080, D, (bf16_t*)(ws + WS_WMI), dr0, sc0, nv, a.in[I_MIXN], kb, scr, lane); continue; }
        r -= I_MI;
        { const int nblk = D / 32, kb = r / nblk, dr0 = (r % nblk) * 32;
          const float* ks = (kb < 8) ? a.in[I_AON] : a.in[I_CON] - 512;
          conv_item(a.in[I_WMO], D, D, (bf16_t*)(ws + WS_WMO), dr0, dr0, 32, ks, kb, scr, lane); }
    }
    bf16_t* XA = (bf16_t*)(ws + WS_XA); float* part0 = (float*)(ws + WS_PART);
    for (int row = gw; row < M + 16; row += NGW) {
        const float* src = row < M ? a.in[I_X] + (size_t)row * D : a.in[I_META] + (size_t)(row - M) * D;
        f32x4 v[4]; float ss = 0.f;
#pragma unroll
        for (int j = 0; j < 4; ++j) { v[j] = ((const f32x4*)src)[lane + 64 * j]; ss += (v[j][0] * v[j][0] + v[j][1] * v[j][1]) + (v[j][2] * v[j][2] + v[j][3] * v[j][3]); }
        ss = wave_sum(ss);
#pragma unroll
        for (int j = 0; j < 4; ++j) { u32x2 w; w.x = cvtpk(v[j][0], v[j][1]); w.y = cvtpk(v[j][2], v[j][3]); *(u32x2*)(XA + (size_t)row * D + 4 * (lane + 64 * j)) = w; }
        if (lane < 16) part0[(size_t)row * 16 + lane] = lane == 0 ? ss : 0.f;
    }
}


template <int NC, int K> __device__ __forceinline__ void mini16(const bf16_t* X, const bf16_t* W, const int (&wr)[NC], f32x4 (&acc)[NC], LAS unsigned char* lds, int wave, int lane) {
    constexpr int KW = K / 8; static_assert(KW % 32 == 0, "K split");
    const int r = lane & 15, q = lane >> 4;
    const bf16_t* xp = X + (size_t)r * K + wave * KW + 8 * q;
    const bf16_t* wp[NC];
#pragma unroll
    for (int c = 0; c < NC; ++c) { wp[c] = W + (size_t)(wr[c] + r) * K + wave * KW + 8 * q; acc[c] = (f32x4){0.f, 0.f, 0.f, 0.f}; }
#pragma unroll
    for (int k = 0; k < KW; k += 32) { const bf16x8 xv = *(const bf16x8*)(xp + k);
#pragma unroll
        for (int c = 0; c < NC; ++c) { const bf16x8 wv = *(const bf16x8*)(wp[c] + k); acc[c] = __builtin_amdgcn_mfma_f32_16x16x32_bf16(wv, xv, acc[c], 0, 0, 0); } }
    LAS f32x4* P = (LAS f32x4*)lds;
#pragma unroll
    for (int c = 0; c < NC; ++c) P[(wave * NC + c) * 64 + lane] = acc[c];
    __syncthreads();
#pragma unroll
    for (int c = 0; c < NC; ++c) { f32x4 s = P[c * 64 + lane];
#pragma unroll
        for (int w = 1; w < 8; ++w) s += P[(w * NC + c) * 64 + lane];
        acc[c] = s; }
    __syncthreads();
}
__device__ __forceinline__ float log_sigmoid(float x) { return fminf(x, 0.f) - __logf(1.0f + __expf(-fabsf(x))); }
__device__ __forceinline__ float meta_rstd(const float* mpart, int tok) {
    const f32x4* p = (const f32x4*)(mpart + tok * 64); f32x4 s = p[0];
#pragma unroll
    for (int i = 1; i < 16; ++i) s += p[i];
    return 1.0f / sqrtf(((s[0] + s[1]) + (s[2] + s[3])) * (1.0f / 1024.0f) + EPS);
}
__device__ __forceinline__ void meta_up(const bf16_t* XA, const bf16_t* W1, bf16_t* ACT, const float* part0, int item, LAS unsigned char* lds, int wave, int lane) {
    const int j0 = item * 16, ng = 256 * (j0 >> 7) + (j0 & 127); const int wr[2] = {ng, ng + 128}; f32x4 acc[2];
    mini16<2, D>(XA + (size_t)M * D, W1, wr, acc, lds, wave, lane);
    if (wave != 0) return;
    const int tok = lane & 15, nq = lane >> 4; const float rs = row_rstd(part0, M + tok); float a[4];
#pragma unroll
    for (int i = 0; i < 4; ++i) { const float g = acc[0][i] * rs, up = acc[1][i] * rs; a[i] = g * __builtin_amdgcn_rcpf(1.0f + __builtin_amdgcn_exp2f(-g * LOG2E)) * up; }
    u32x2 w; w.x = cvtpk(a[0], a[1]); w.y = cvtpk(a[2], a[3]); *(u32x2*)(ACT + (size_t)(M + tok) * DFF + j0 + 4 * nq) = w;
}
__device__ __forceinline__ void meta_down(const bf16_t* ACT, const bf16_t* W1O, const float* meta, bf16_t* XA, float* mpart, int item, LAS unsigned char* lds, int wave, int lane) {
    const int c0 = item * 16; const int wr[1] = {c0}; f32x4 acc[1];
    mini16<1, DFF>(ACT + (size_t)M * DFF, W1O, wr, acc, lds, wave, lane);
    if (wave != 0) return;
    const int tok = lane & 15, nq = lane >> 4; const f32x4 r = *(const f32x4*)(meta + (size_t)tok * D + c0 + 4 * nq); const f32x4 v = r + acc[0] * 0.5f;
    u32x2 w; w.x = cvtpk(v[0], v[1]); w.y = cvtpk(v[2], v[3]); *(u32x2*)(XA + (size_t)(M + tok) * D + c0 + 4 * nq) = w;
    float ss = (v[0] * v[0] + v[1] * v[1]) + (v[2] * v[2] + v[3] * v[3]); ss += __shfl_xor(ss, 16); ss += __shfl_xor(ss, 32);
    if (nq == 0) mpart[tok * 64 + item] = ss;
}
__device__ __forceinline__ void meta_mix(const bf16_t* XA, const bf16_t* WMI, bf16_t* K, bf16_t* V, bf16_t* Z, float* logfT, const float* mpart, const float* kn, const float* bfg, int item, LAS unsigned char* lds, int wave, int lane) {
    int wr[4];
    if (item < 8) { const int pn = 2 + (item >> 2), wc = item & 3;
#pragma unroll
        for (int c = 0; c < 4; ++c) wr[c] = 256 * pn + 128 * (c >> 1) + 32 * wc + 16 * (c & 1); }
    else if (item < 16) {
#pragma unroll
        for (int c = 0; c < 4; ++c) wr[c] = 1024 + (item - 8) * 64 + 16 * c; }
    else if (item < 32) { const int ch0 = (item - 16) * 32; wr[0] = 2048 + 256 * (ch0 >> 7) + (ch0 & 127); wr[1] = wr[0] + 16; wr[2] = wr[0] + 128; wr[3] = wr[1] + 128; }
    else { wr[0] = 3072; wr[1] = 3072; wr[2] = 3072; wr[3] = 3072; }
    f32x4 acc[4];
    mini16<4, D>(XA + (size_t)M * D, WMI, wr, acc, lds, wave, lane);
    if (wave != 0) return;
    const int tok = lane & 15, nq = lane >> 4; const float rs = meta_rstd(mpart, tok); const size_t row = (size_t)M + tok;
    if (item < 8) { float ss = 0.f;
#pragma unroll
        for (int c = 0; c < 4; ++c) { acc[c] = acc[c] * rs; ss += (acc[c][0] * acc[c][0] + acc[c][1] * acc[c][1]) + (acc[c][2] * acc[c][2] + acc[c][3] * acc[c][3]); }
        ss += __shfl_xor(ss, 16); ss += __shfl_xor(ss, 32); const float rr = 1.0f / sqrtf(ss * (1.0f / 64.0f) + EPS);
#pragma unroll
        for (int c = 0; c < 4; ++c) { const f32x4 g = *(const f32x4*)(kn + 16 * c + 4 * nq); const f32x4 v = acc[c] * rr * g; u32x2 w; w.x = cvtpk(v[0], v[1]); w.y = cvtpk(v[2], v[3]);
            *(u32x2*)(K + row * DH + item * 64 + 16 * c + 4 * nq) = w; } }
    else if (item < 16) {
#pragma unroll
        for (int c = 0; c < 4; ++c) { const f32x4 v = acc[c] * rs; const unsigned w0 = cvtpk(v[0], v[1]), w1 = cvtpk(v[2], v[3]); bf16_t* vp = V + (size_t)((item - 8) * 64 + 16 * c + 4 * nq) * 16 + tok;
            vp[0] = (bf16_t)w0; vp[16] = (bf16_t)(w0 >> 16); vp[32] = (bf16_t)w1; vp[48] = (bf16_t)(w1 >> 16); } }
    else if (item < 32) { const float r2 = rs * rs;
#pragma unroll
        for (int c = 0; c < 2; ++c) { const f32x4 v = acc[c] * acc[2 + c] * r2; u32x2 w; w.x = cvtpk(v[0], v[1]); w.y = cvtpk(v[2], v[3]); *(u32x2*)(Z + row * DH + (item - 16) * 32 + 16 * c + 4 * nq) = w; } }
    else if (nq < 2) {
#pragma unroll
        for (int i = 0; i < 4; ++i) { const int h = 4 * nq + i; logfT[(size_t)h * MP + row] = log_sigmoid(acc[0][i] * rs + bfg[h]); } }
}
__device__ __forceinline__ void flog_wg(const bf16_t* XA, const bf16_t* WMI, float* logfT, const float* part1, const float* bfg, int rowbase, LAS unsigned char* lds, int wave, int lane) {
    const int r = lane & 15, q = lane >> 4;
    const bf16_t* wp = WMI + (size_t)(3072 + r) * D + wave * 128 + 8 * q;
    bf16x8 wv[4];
#pragma unroll
    for (int s = 0; s < 4; ++s) wv[s] = *(const bf16x8*)(wp + 32 * s);
    LAS f32x4* P = (LAS f32x4*)lds;
#pragma unroll
    for (int g = 0; g < 8; ++g) { const bf16_t* xp = XA + (size_t)(rowbase + 16 * g + r) * D + wave * 128 + 8 * q; f32x4 acc = (f32x4){0.f, 0.f, 0.f, 0.f};
#pragma unroll
        for (int s = 0; s < 4; ++s) acc = __builtin_amdgcn_mfma_f32_16x16x32_bf16(wv[s], *(const bf16x8*)(xp + 32 * s), acc, 0, 0, 0);
        P[(wave * 8 + g) * 64 + lane] = acc; }
    __syncthreads();
    f32x4 s = P[wave * 64 + lane];
#pragma unroll
    for (int w = 1; w < 8; ++w) s += P[(w * 8 + wave) * 64 + lane];
    const int tok = lane & 15, nq = lane >> 4, row = rowbase + 16 * wave + tok; const float rs = row_rstd(part1, row);
    if (nq < 2) {
#pragma unroll
        for (int i = 0; i < 4; ++i) { const int h = 4 * nq + i; logfT[(size_t)h * MP + row] = log_sigmoid(s[i] * rs + bfg[h]); } }
    __syncthreads();
}

struct MixP { const bf16_t *Q, *K, *VT, *VTm, *B, *Z; const float* logfT; const float* cw; bf16_t* out; float thresh; };

__device__ __forceinline__ float wave_scan_incl(float v) {
#define DPP_ADD(ctrl, rmask) v += __int_as_float(__builtin_amdgcn_update_dpp(0, __float_as_int(v), ctrl, rmask, 0xf, false))
    DPP_ADD(0x111, 0xf); DPP_ADD(0x112, 0xf); DPP_ADD(0x114, 0xf); DPP_ADD(0x118, 0xf);
    DPP_ADD(0x142, 0xa);
    DPP_ADD(0x143, 0xc);
#undef DPP_ADD
    return v;
}
__device__ __forceinline__ void mixer_unit(const MixP& p, int b, int t0, LAS unsigned char* lds, int wave, int lane) {
    const int r32 = lane & 31, hi = lane >> 5, h = wave;
    LAS float* ssq = (LAS float*)(lds + 4096);
    const size_t rowq = (size_t)b * SEQ + t0;
    bf16x8 qf[4];
    { const bf16_t* qp = p.Q + (rowq + r32) * DH + h * 64 + 8 * hi;
#pragma unroll
      for (int ks = 0; ks < 4; ++ks) qf[ks] = *(const bf16x8*)(qp + 16 * ks); }
    float mrun = -INFINITY, l = 0.f; f32x16 o0, o1;
#pragma unroll
    for (int r = 0; r < 16; ++r) { o0[r] = 0.f; o1[r] = 0.f; }
    const int jd = t0 >> 6, T0 = jd << 6;
    const char* Kh = (const char*)(p.K + h * 64);
    const char* Vh = (const char*)(p.VT + (size_t)(b * NH + h) * 64 * SEQ);
    const char* Vm = (const char*)(p.VTm + (size_t)h * 64 * 16);
    const char* Lh = (const char*)(p.logfT + (size_t)h * MP);
#define KROW(j_) ((j_) >= 0 ? (size_t)b * SEQ + 64 * (j_) : (size_t)M)
    bf16x8 kc[8]; float Lc;
    { const char* kp = Kh + KROW(jd) * DH * 2; const unsigned koff0 = (unsigned)(r32 * DH + 8 * hi) * 2u;
#pragma unroll
      for (int ks = 0; ks < 4; ++ks) { kc[2 * ks] = *(const bf16x8*)(kp + koff0 + 32 * ks); kc[2 * ks + 1] = *(const bf16x8*)(kp + koff0 + 32 * DH * 2 + 32 * ks); }
      Lc = *(const float*)(Lh + KROW(jd) * 4 + (unsigned)lane * 4u); }
    float base = 0.f;
    for (int j = jd; ; --j) {
        int ln = lane; asm volatile("" : "+v"(ln));
        const int r32 = ln & 31, hi = ln >> 5, lane = ln;
        const unsigned koff = (unsigned)(r32 * DH + 8 * hi) * 2u, vldoff = (unsigned)((lane >> 3) * SEQ + 8 * (lane & 7)) * 2u, voffm = (unsigned)(r32 * 16 + 4 * hi) * 2u, loffx = (unsigned)lane * 4u, loffm = (unsigned)(lane & 15) * 4u;
        LAS float* sc = (LAS float*)lds + wave * 64; LAS unsigned char* vt = lds + 8192 + wave * 8704;
        u32x4 vld[8];
        if (j >= 0) { const char* vp = Vh + (size_t)(64 * j) * 2;
#pragma unroll
            for (int i = 0; i < 8; ++i) vld[i] = *(const u32x4*)(vp + vldoff + (size_t)(8 * i) * SEQ * 2); }
        else {
#pragma unroll
            for (int i = 0; i < 2; ++i) { const u32x2 a_ = *(const u32x2*)(Vm + voffm + i * 32 * 16 * 2), b_ = *(const u32x2*)(Vm + voffm + i * 32 * 16 * 2 + 16); vld[i] = (u32x4){a_.x, a_.y, b_.x, b_.y}; } }
        const int nvalid = j >= 0 ? 64 : 16;
        const float P = wave_scan_incl(lane < nvalid ? Lc * LOG2E : 0.f);
        const float tot = __int_as_float(__builtin_amdgcn_readlane(__float_as_int(P), 63));
        const float p31 = __int_as_float(__builtin_amdgcn_readlane(__float_as_int(P), 31));
        const float bj = (j == jd) ? ((t0 > T0) ? p31 : 0.f) : base + tot;
        sc[lane] = bj - P; base = bj;
        f32x16 s0, s1;
#pragma unroll
        for (int r = 0; r < 16; ++r) { s0[r] = 0.f; s1[r] = 0.f; }
#pragma unroll
        for (int ks = 0; ks < 4; ++ks) { s0 = __builtin_amdgcn_mfma_f32_32x32x16_bf16(kc[2 * ks], qf[ks], s0, 0, 0, 0); s1 = __builtin_amdgcn_mfma_f32_32x32x16_bf16(kc[2 * ks + 1], qf[ks], s1, 0, 0, 0); }
        if (j >= 0) { const char* kp = Kh + KROW(j - 1) * DH * 2;
#pragma unroll
            for (int ks = 0; ks < 4; ++ks) { kc[2 * ks] = *(const bf16x8*)(kp + koff + 32 * ks); kc[2 * ks + 1] = *(const bf16x8*)(kp + koff + 32 * DH * 2 + 32 * ks); }
            Lc = *(const float*)(Lh + KROW(j - 1) * 4 + (j > 0 ? loffx : loffm)); }
        asm volatile("s_waitcnt lgkmcnt(0)" ::: "memory");
#pragma unroll
        for (int g = 0; g < 4; ++g) { const f32x4 b0 = *(const LAS f32x4*)(sc + 8 * g + 4 * hi), b1 = *(const LAS f32x4*)(sc + 32 + 8 * g + 4 * hi);
#pragma unroll
            for (int i = 0; i < 4; ++i) { s0[4 * g + i] += b0[i]; s1[4 * g + i] += b1[i]; } }
        if (j == jd) { const int qa4 = t0 + r32 - T0 - 4 * hi;
#pragma unroll
            for (int r = 0; r < 16; ++r) { if ((r & 3) + 8 * (r >> 2) > qa4) s0[r] = -INFINITY; if ((r & 3) + 8 * (r >> 2) + 32 > qa4) s1[r] = -INFINITY; } }
        if (j < 0) { const int h4 = 4 * hi;
#pragma unroll
            for (int r = 0; r < 16; ++r) { if ((r & 3) + 8 * (r >> 2) >= 16 - h4) s0[r] = -INFINITY; s1[r] = -INFINITY; } }
        float mt = fmaxf(s0[0], s1[0]);
#pragma unroll
        for (int r = 1; r < 16; ++r) mt = fmaxf(mt, fmaxf(s0[r], s1[r]));
        mt = fmaxf(mt, __shfl_xor(mt, 32));
        const float mn = fmaxf(mrun, mt), al = __builtin_amdgcn_exp2f(mrun - mn); mrun = mn;
        float ps = 0.f;
#pragma unroll
        for (int r = 0; r < 16; ++r) { s0[r] = __builtin_amdgcn_exp2f(s0[r] - mn); s1[r] = __builtin_amdgcn_exp2f(s1[r] - mn); ps += s0[r] + s1[r]; }
        l = l * al + ps;
#pragma unroll
        for (int r = 0; r < 16; ++r) { o0[r] *= al; o1[r] *= al; }
#define PWPK(S_, o_) (u32x4){cvtpk(S_[o_ + 0], S_[o_ + 1]), cvtpk(S_[o_ + 2], S_[o_ + 3]), cvtpk(S_[o_ + 4], S_[o_ + 5]), cvtpk(S_[o_ + 6], S_[o_ + 7])}
        if (j >= 0) {
#pragma unroll
            for (int i = 0; i < 8; ++i) { LAS unsigned char* wp_ = vt + (8 * i + (lane >> 3)) * 136 + 16 * (lane & 7);
                *(LAS u32x2*)wp_ = (u32x2){vld[i].x, vld[i].y}; *(LAS u32x2*)(wp_ + 8) = (u32x2){vld[i].z, vld[i].w}; }
            asm volatile("s_waitcnt lgkmcnt(0)" ::: "memory");
            const LAS unsigned char* rp_ = vt + r32 * 136 + 8 * hi;
#pragma unroll
            for (int g4 = 0; g4 < 4; ++g4) {
                const u32x4 pw = (g4 < 2) ? PWPK(s0, 8 * (g4 & 1)) : PWPK(s1, 8 * (g4 & 1));
                const bf16x8 pf = __builtin_bit_cast(bf16x8, pw);
                const u32x2 a0 = *(const LAS u32x2*)(rp_ + 32 * g4), b0 = *(const LAS u32x2*)(rp_ + 32 * g4 + 16), a1 = *(const LAS u32x2*)(rp_ + 32 * 136 + 32 * g4), b1 = *(const LAS u32x2*)(rp_ + 32 * 136 + 32 * g4 + 16);
                const u32x4 x0 = (u32x4){a0.x, a0.y, b0.x, b0.y}, x1 = (u32x4){a1.x, a1.y, b1.x, b1.y};
                o0 = __builtin_amdgcn_mfma_f32_32x32x16_bf16(__builtin_bit_cast(bf16x8, x0), pf, o0, 0, 0, 0);
                o1 = __builtin_amdgcn_mfma_f32_32x32x16_bf16(__builtin_bit_cast(bf16x8, x1), pf, o1, 0, 0, 0);
            }
        } else {
            const u32x4 pw = PWPK(s0, 0); const bf16x8 pf = __builtin_bit_cast(bf16x8, pw);
            o0 = __builtin_amdgcn_mfma_f32_32x32x16_bf16(__builtin_bit_cast(bf16x8, vld[0]), pf, o0, 0, 0, 0);
            o1 = __builtin_amdgcn_mfma_f32_32x32x16_bf16(__builtin_bit_cast(bf16x8, vld[1]), pf, o1, 0, 0, 0);
        }
#undef PWPK
        if (j < 0 || base < -p.thresh) break;
    }
    l += __shfl_xor(l, 32);
    const float inv = 1.0f / l; float ss = 0.f;
#pragma unroll
    for (int r = 0; r < 16; ++r) { o0[r] *= inv; o1[r] *= inv; ss += o0[r] * o0[r] + o1[r] * o1[r]; }
    ss += __shfl_xor(ss, 32);
    if (hi == 0) ssq[r32 * 8 + h] = ss;
    { int c0 = lane * 8; asm volatile("" : "+v"(c0));
      float w0[8], w1[8], w2[8];
#pragma unroll
      for (int i = 0; i < 8; ++i) { w0[i] = p.cw[c0 + i]; w1[i] = p.cw[DH + c0 + i]; w2[i] = p.cw[2 * DH + c0 + i]; }
      u32x4 z0[4], z1[4], z2[4], bv[4];
#pragma unroll
      for (int rr = 0; rr < 4; ++rr) { const int t = t0 + wave + 8 * rr; const size_t row = (size_t)b * SEQ + t;
          const size_t row1 = t >= 1 ? row - 1 : (size_t)M + 15, row2 = t >= 2 ? row - 2 : (size_t)M + 14 + t;
          z0[rr] = *(const u32x4*)(p.Z + row * DH + c0); z1[rr] = *(const u32x4*)(p.Z + row1 * DH + c0); z2[rr] = *(const u32x4*)(p.Z + row2 * DH + c0); bv[rr] = *(const u32x4*)(p.B + row * DH + c0); }
#pragma unroll
      for (int rr = 0; rr < 4; ++rr) { const size_t row = (size_t)b * SEQ + t0 + wave + 8 * rr;
          float y[8]; float s2 = 0.f;
#pragma unroll
          for (int i = 0; i < 4; ++i) {
              y[2 * i] = bf_lo(bv[rr][i]) * (w0[2 * i] * bf_lo(z2[rr][i]) + w1[2 * i] * bf_lo(z1[rr][i]) + w2[2 * i] * bf_lo(z0[rr][i]));
              y[2 * i + 1] = bf_hi(bv[rr][i]) * (w0[2 * i + 1] * bf_hi(z2[rr][i]) + w1[2 * i + 1] * bf_hi(z1[rr][i]) + w2[2 * i + 1] * bf_hi(z0[rr][i]));
              s2 += y[2 * i] * y[2 * i] + y[2 * i + 1] * y[2 * i + 1]; }
          s2 = wave_sum(s2); const float rs = 1.0f / sqrtf(s2 * (1.0f / 512.0f) + EPS);
          u32x4 w; w.x = cvtpk(y[0] * rs, y[1] * rs); w.y = cvtpk(y[2] * rs, y[3] * rs); w.z = cvtpk(y[4] * rs, y[5] * rs); w.w = cvtpk(y[6] * rs, y[7] * rs);
          *(u32x4*)(p.out + row * D + DH + c0) = w; } }
    __syncthreads();
    { const f32x4 a = *(const LAS f32x4*)(ssq + r32 * 8), c = *(const LAS f32x4*)(ssq + r32 * 8 + 4);
      const float tot = ((a[0] + a[1]) + (a[2] + a[3])) + ((c[0] + c[1]) + (c[2] + c[3]));
      const float rs = 1.0f / sqrtf(tot * (1.0f / 512.0f) + EPS);
      bf16_t* op = p.out + (rowq + r32) * D + h * 64 + 4 * hi;
#pragma unroll
      for (int g = 0; g < 4; ++g) { u32x2 w;
          w.x = cvtpk(o0[4 * g] * rs, o0[4 * g + 1] * rs); w.y = cvtpk(o0[4 * g + 2] * rs, o0[4 * g + 3] * rs); *(u32x2*)(op + 8 * g) = w;
          w.x = cvtpk(o1[4 * g] * rs, o1[4 * g + 1] * rs); w.y = cvtpk(o1[4 * g + 2] * rs, o1[4 * g + 3] * rs); *(u32x2*)(op + 32 + 8 * g) = w; } }
    __syncthreads();
}

#define RLX_AGENT __ATOMIC_RELAXED, __HIP_MEMORY_SCOPE_AGENT
#define XB_TMO      128
#define XB_XCNT(j)  (256  + 64 * (j))
#define XB_XSUB(j)  (1280 + 64 * (j))
#define XB_XGEN(j)  (2304 + 64 * (j))
#define XB_TOP      3328
#define XB_TOPGEN   3392
#define XCD_BAR_WORDS 3456
#define XB_SPIN_CAP (1u << 18)

__device__ __forceinline__ unsigned xb_ld(unsigned* p)              { return __hip_atomic_load(p, __ATOMIC_RELAXED, __HIP_MEMORY_SCOPE_AGENT); }
__device__ __forceinline__ unsigned xb_add(unsigned* p, unsigned v) { return __hip_atomic_fetch_add(p, v, __ATOMIC_RELAXED, __HIP_MEMORY_SCOPE_AGENT); }
__device__ __forceinline__ unsigned xb_xcc_id() { return (unsigned)__builtin_amdgcn_s_getreg((3 << 11) | 20) & 0xFu; }
#define XB_SPIN(cond, bar) do { unsigned _sp = 0; while (cond) { __builtin_amdgcn_s_sleep(1); \
    if ((++_sp & 255u) == 0u) { if (xb_ld(&(bar)[XB_TMO])) break; if (_sp > XB_SPIN_CAP) { atomicAdd(&(bar)[XB_TMO], 1u); break; } } } } while (0)

struct XcdBarrier {
    unsigned* bar; unsigned x;
    volatile LAS unsigned* st;
};

__device__ __forceinline__ XcdBarrier xcd_barrier_post(unsigned* bar, volatile LAS unsigned* st, const bool t0) {
    XcdBarrier b; b.bar = bar; b.x = xb_xcc_id(); b.st = st;
    if (t0) (void)xb_add(&bar[XB_XCNT(b.x)], 1u);
    return b;
}
__device__ __forceinline__ void xcd_barrier_complete(unsigned* bar, unsigned x, unsigned& nloc, unsigned& nx) {
    const unsigned G = gridDim.x * gridDim.y * gridDim.z;
    unsigned sum, cnt, mine, sp = 0u;
    for (;;) {
        sum = 0u; cnt = 0u; mine = 0u;
#pragma unroll
        for (unsigned j = 0; j < 16; ++j) { const unsigned c = xb_ld(&bar[XB_XCNT(j)]); sum += c; cnt += (c > 0u) ? 1u : 0u; mine = (j == x) ? c : mine; }
        if (sum == G) break;
        __builtin_amdgcn_s_sleep(1);
        if ((++sp & 255u) == 0u) { if (xb_ld(&bar[XB_TMO])) break; if (sp > XB_SPIN_CAP) { atomicAdd(&bar[XB_TMO], 1u); break; } }
    }
    nloc = mine > 0u ? mine : 1u; nx = cnt > 0u ? cnt : 1u;
}

__device__ __forceinline__ void xcd_barrier(const XcdBarrier& b, const bool t0) {
    asm volatile("s_waitcnt vmcnt(0)" ::: "memory");
    __syncthreads();
    if (t0) {
        unsigned* bar = b.bar;
        __builtin_amdgcn_s_waitcnt(0);
        unsigned nloc = b.st[0], nx = b.st[1];
        if (nloc == 0u) { xcd_barrier_complete(bar, b.x, nloc, nx); b.st[0] = nloc; b.st[1] = nx; }
        const unsigned old = xb_add(&bar[XB_XSUB(b.x)], 1u);
        const unsigned gen = old / nloc;
        if (old + 1u == (gen + 1u) * nloc) {
            __builtin_amdgcn_fence(__ATOMIC_RELEASE, "agent");
            asm volatile("s_waitcnt vmcnt(0)" ::: "memory");
            const unsigned og = xb_add(&bar[XB_TOP], 1u);
            const unsigned tg = og / nx;
            if (og + 1u == (tg + 1u) * nx) xb_add(&bar[XB_TOPGEN], 1u);
            else XB_SPIN(xb_ld(&bar[XB_TOPGEN]) == tg, bar);
            __builtin_amdgcn_fence(__ATOMIC_ACQUIRE, "agent");
            xb_add(&bar[XB_XGEN(b.x)], 1u);
            asm volatile("s_waitcnt vmcnt(0)" ::: "memory");
        } else {
            XB_SPIN(xb_ld(&bar[XB_XGEN(b.x)]) == gen, bar);
            __builtin_amdgcn_fence(__ATOMIC_ACQUIRE, "agent");
            asm volatile("s_waitcnt vmcnt(0)" ::: "memory");
        }
    }
    __syncthreads();
}

__global__ void __launch_bounds__(NWAVES * 64, 2) fwd_mega(Args a) {
    extern __shared__ __attribute__((aligned(16))) unsigned char lds_raw[];
    LAS unsigned char* lds = (LAS unsigned char*)lds_raw;
    cg::grid_group grid = cg::this_grid();
    const int wave = __builtin_amdgcn_readfirstlane((int)threadIdx.x >> 6);
#define LANE() ({ int z_ = 0; asm volatile("" : "+v"(z_)); (int)__builtin_amdgcn_mbcnt_hi(~0u, __builtin_amdgcn_mbcnt_lo(~0u, z_)); })
#define TID0() (wave == 0 && LANE() == 0)
    const int G = gridDim.x, bx = blockIdx.x;
    const int vcu = (G % 8 == 0) ? (bx % 8) * (G / 8) + bx / 8 : bx;
    const int gw = vcu * NWAVES + wave, NGW = G * NWAVES;
    unsigned char* ws = a.ws;
    bf16_t *W1 = (bf16_t*)(ws + WS_W1), *W1O = (bf16_t*)(ws + WS_W1O), *WMI = (bf16_t*)(ws + WS_WMI), *WMO = (bf16_t*)(ws + WS_WMO), *W2 = (bf16_t*)(ws + WS_W2), *W2O = (bf16_t*)(ws + WS_W2O);
    bf16_t *XA = (bf16_t*)(ws + WS_XA), *XB = (bf16_t*)(ws + WS_XB), *ACT = (bf16_t*)(ws + WS_ACT);
    bf16_t *Qb = ACT, *Kb = (bf16_t*)(ws + WS_ACT + QKV_STRIDE), *Vb = (bf16_t*)(ws + WS_ACT + 2 * QKV_STRIDE), *Bb = (bf16_t*)(ws + WS_ACT + 3 * QKV_STRIDE), *Zb = (bf16_t*)(ws + WS_ACT + 4 * QKV_STRIDE);
    float *part0 = (float*)(ws + WS_PART), *part1 = (float*)(ws + WS_PART + PART_STRIDE), *part2 = (float*)(ws + WS_PART + 2 * PART_STRIDE), *part3 = (float*)(ws + WS_PART + 3 * PART_STRIDE);
    float *logfT = (float*)(ws + WS_LOGF), *mpart = (float*)(ws + WS_RESM);
    bf16_t* VTm = (bf16_t*)(ws + WS_RESM + 65536);

    volatile LAS unsigned* bst = (volatile LAS unsigned*)(lds + 131072 + 64);
    unsigned* barw = (unsigned*)(ws + WS_CTL);
    { const int tid = wave * 64 + LANE(); if (tid < 2) bst[tid] = 0u; }
    __syncthreads();
    if (__builtin_expect(a.ws == nullptr, 0)) grid.sync();
    const XcdBarrier bar = xcd_barrier_post(barw, bst, TID0());
#define GBAR() do { XcdBarrier b_ = bar; asm volatile("" : "+s"(b_.bar)); xcd_barrier(b_, TID0()); } while (0)
    p0_prologue(a, lds, gw, NGW, wave, LANE());
    GBAR();
    if (vcu < 176) meta_up(XA, W1, ACT, part0, vcu, lds, wave, LANE());
    { pg8::Gemm g{XA, W1, M, 2 * DFF, D}; pg8::StaticOrder S; S.init(M, 2 * DFF, G, bx); EpiSwiGLU E{ACT, (const LAS float*)(lds + RSTAB_OFF)};
      rstd_table(S, part0, lds, wave, LANE());
      pg8::gemm_phase<EpiSwiGLU, pg8::StaticOrder, true, true>(lds, g, S, E, wave); }
    GBAR();
    if (vcu < 64) meta_down(ACT, W1O, a.in[I_META], XA, mpart, vcu, lds, wave, LANE());
    { pg8::Gemm g{ACT, W1O, M, D, DFF}; pg8::StaticOrder S; S.init(M, D, G, bx); EpiResid<false> E{XA, nullptr, XA, part1, 0.5f};
      pg8::gemm_phase<EpiResid<false>, pg8::StaticOrder, true, true>(lds, g, S, E, wave); }
    GBAR();
    if (vcu < 33) meta_mix(XA, WMI, Kb, VTm, Zb, logfT, mpart, a.in[I_KN], a.in[I_BF], vcu, lds, wave, LANE());
    { const int ln = LANE(); for (int it = vcu; it < M / 128; it += G) flog_wg(XA, WMI, logfT, part1, a.in[I_BF], it * 128, lds, wave, ln); }
    { pg8::Gemm g{XA, WMI, M, 3072, D}; pg8::StaticOrder S; S.init(M, 3072, G, bx); EpiMixIn E{Qb, Kb, Vb, Bb, Zb, logfT, (const LAS float*)(lds + RSTAB_OFF), a.in[I_QN], a.in[I_KN], a.in[I_BF]};
      rstd_table(S, part1, lds, wave, LANE());
      pg8::gemm_phase<EpiMixIn, pg8::StaticOrder, true, true>(lds, g, S, E, wave); }
    GBAR();
    { const int lane4 = LANE(); float gq = fabsf(a.in[I_QN][lane4]), gk = fabsf(a.in[I_KN][lane4]);
#pragma unroll
      for (int o = 1; o < 64; o <<= 1) { gq = fmaxf(gq, __shfl_xor(gq, o)); gk = fmaxf(gk, __shfl_xor(gk, o)); }
      MixP mp{Qb, Kb, Vb, VTm, Bb, Zb, logfT, a.in[I_CW], XB, 2.0f * (8.0f * gq * gk * LOG2E * 1.05f) + 170.0f};
      constexpr int NU = M / 32;
      for (int u = vcu; u < NU; u += G) { const int b = u / (SEQ / 32), t0 = (u % (SEQ / 32)) * 32; mixer_unit(mp, b, t0, lds, wave, lane4); } }
    GBAR();
    { pg8::Gemm g{XB, WMO, M, D, D}; pg8::StaticOrder S; S.init(M, D, G, bx); EpiResid<false> E{XA, nullptr, XA, part2, 1.0f};
      pg8::gemm_phase<EpiResid<false>, pg8::StaticOrder, true, true>(lds, g, S, E, wave); }
    GBAR();
    { pg8::Gemm g{XA, W2, M, 2 * DFF, D}; pg8::StaticOrder S; S.init(M, 2 * DFF, G, bx); EpiSwiGLU E{ACT, (const LAS float*)(lds + RSTAB_OFF)};
      rstd_table(S, part2, lds, wave, LANE());
      pg8::gemm_phase<EpiSwiGLU, pg8::StaticOrder, true, true>(lds, g, S, E, wave); }
    GBAR();
    { pg8::Gemm g{ACT, W2O, M, D, DFF}; pg8::StaticOrder S; S.init(M, D, G, bx); EpiResid<false> E{XA, nullptr, XA, part3, 0.5f};
      pg8::gemm_phase<EpiResid<false>, pg8::StaticOrder, true, true>(lds, g, S, E, wave); }
    GBAR();
    { const int lane = LANE(); const float* gfn = a.in[I_FN]; f32x4 gv[4];
#pragma unroll
      for (int j = 0; j < 4; ++j) gv[j] = ((const f32x4*)gfn)[lane + 64 * j];
      for (int row = gw; row < M; row += NGW) { const float rs = row_rstd(part3, row); f32x4* rp = (f32x4*)(a.out + (size_t)row * D); const u32x2* hp = (const u32x2*)(XA + (size_t)row * D);
#pragma unroll
          for (int j = 0; j < 4; ++j) { const u32x2 hv = hp[lane + 64 * j]; const f32x4 v = (f32x4){bf_lo(hv.x), bf_hi(hv.x), bf_lo(hv.y), bf_hi(hv.y)}; rp[lane + 64 * j] = v * rs * gv[j]; } } }
}

extern "C" void kernel_launch(void* const* d_in, const int* in_sizes, int n_in, void* d_out, int out_size, void* d_ws, size_t ws_size, hipStream_t stream) {
    static int grid = 0;
    if (grid == 0) {
        if (n_in != 18 || in_sizes[0] != M * D || out_size != M * D || ws_size < WS_END) { fprintf(stderr, "kernel_launch: unexpected shapes (n_in %d, in0 %d, out %d, ws %zu < %zu)\n", n_in, n_in > 0 ? in_sizes[0] : -1, out_size, ws_size, (size_t)WS_END); grid = -1; return; }
        int dev = 0, cus = 0, per_cu = 0;
        if (hipGetDevice(&dev) != hipSuccess || hipDeviceGetAttribute(&cus, hipDeviceAttributeMultiprocessorCount, dev) != hipSuccess) { grid = -1; return; }
        if (hipFuncSetAttribute((const void*)fwd_mega, hipFuncAttributeMaxDynamicSharedMemorySize, LDS_BYTES) != hipSuccess) { fprintf(stderr, "kernel_launch: hipFuncSetAttribute failed\n"); grid = -1; return; }
        if (hipOccupancyMaxActiveBlocksPerMultiprocessor(&per_cu, (const void*)fwd_mega, NWAVES * 64, LDS_BYTES) != hipSuccess || per_cu < 1) { fprintf(stderr, "kernel_launch: occupancy query gave %d\n", per_cu); (void)hipGetLastError(); grid = -1; return; }
        grid = cus * per_cu;
        if (grid < 256) { fprintf(stderr, "kernel_launch: %d resident workgroups; the per-workgroup 1/rms table is sized for >= 256 (<= 11 GEMM units each)\n", grid); grid = -1; return; }
    }
    if (grid < 0) return;
    if (hipMemsetAsync((char*)d_ws + WS_CTL, 0, 65536, stream) != hipSuccess) { fprintf(stderr, "kernel_launch: hipMemsetAsync failed\n"); return; }
    Args a{};
    for (int i = 0; i < 18; ++i) a.in[i] = (const float*)d_in[i];
    a.out = (float*)d_out; a.ws = (unsigned char*)d_ws;
    void* args[] = {&a};
    const hipError_t e = hipLaunchCooperativeKernel((const void*)fwd_mega, dim3(grid), dim3(NWAVES * 64), args, LDS_BYTES, stream);
    if (e != hipSuccess) fprintf(stderr, "kernel_launch: cooperative launch failed: %s (grid %d)\n", hipGetErrorString(e), grid);
}
```

```cpp
#include <hip/hip_runtime.h>
#include <hip/hip_cooperative_groups.h>
#include <cstdio>
#include <cstdint>
#include <cmath>
namespace cg = cooperative_groups;
namespace pg8 {
#define PG8_LAS __attribute__((address_space(3)))
typedef unsigned short bf16_t;
typedef short bf16x8 __attribute__((ext_vector_type(8)));
typedef float f32x4 __attribute__((ext_vector_type(4)));
typedef unsigned u32x4 __attribute__((ext_vector_type(4)));
constexpr int BM = 256, BK = 64, HALF = 128, HTB = HALF * BK * 2  , STAGE_BYTES = 8 * HTB, NXCD = 8, WGM = 8;

__host__ __device__ __forceinline__ int lds_byte(int r, int c) { const int st = (r >> 4) * 2 + (c >> 5), rr = r & 15, cc = c & 31, ob = rr * 64 + cc * 2; return st * 1024 + (ob ^ (((ob >> 9) & 1) << 5)); }
__host__ __device__ __forceinline__ void stage_rc(int b, int& R, int& C) { const int st = b / 1024, sb = b % 1024, swz = sb ^ (((sb >> 9) & 1) << 5); R = (st >> 1) * 16 + swz / 64; C = (st & 1) * 32 + (swz % 64) / 2; }
__host__ __device__ __forceinline__ int perm32(int rho) { const int n = rho >> 4, i = rho & 15; return 8 * (i >> 2) + 4 * n + (i & 3); }

struct Unit { int pm, pn, ui; };
struct Gemm { const bf16_t* A; const bf16_t* Bt; int M, N, K; };

struct StaticOrder {
    int nM, nN, nwg, G, c;
    __host__ __device__ void init(int M, int N, int G_, int c_) { nM = M / BM; nN = N / BM; nwg = nM * nN; G = G_; c = c_; }
    __host__ __device__ bool next(int i, Unit& u) const {
        const long L = (long)i * G + c; if (L >= nwg) return false;
        int wgid = (int)L; { const int q = nwg / NXCD, r = nwg % NXCD, xcd = wgid % NXCD, off = wgid / NXCD; wgid = (xcd < r ? xcd * (q + 1) : r * (q + 1) + (xcd - r) * q) + off; }
        const int nig = WGM * nN, gid = wgid / nig, fm = gid * WGM, gsz = (nM - fm) < WGM ? (nM - fm) : WGM;
        u.pm = fm + ((wgid % nig) % gsz); u.pn = (wgid % nig) / gsz; u.ui = i; return true;
    }
    __device__ __forceinline__ void a_ready(const Unit&) const {}
    __device__ __forceinline__ void done(const Unit&) const {}
};

__device__ __forceinline__ unsigned cvt_pk_bf16(float lo, float hi) { unsigned r; asm volatile("v_cvt_pk_bf16_f32 %0, %1, %2" : "=v"(r) : "v"(lo), "v"(hi)); return r; }
typedef float f32x2 __attribute__((ext_vector_type(2)));
template <class Epi, class Sched, bool ALIGN_EPI = false, bool SP2 = false>
__device__ __forceinline__ void gemm_phase(PG8_LAS unsigned char* lds, const Gemm g, const Sched& S, const Epi& E, const int wid) {
    int z_ = 0; asm volatile("" : "+v"(z_)); const int lane_ = __builtin_amdgcn_mbcnt_hi(~0u, __builtin_amdgcn_mbcnt_lo(~0u, z_));
    const int lane = lane_, tid = wid * 64 + lane, wr = wid >> 2, wc = wid & 3, fr = lane & 15, fq = lane >> 4;
    const int K = g.K, nt = K / BK;
    unsigned voffA[2], voffB[2];
#pragma unroll
    for (int i = 0; i < 2; ++i) { int R, C; stage_rc(tid * 16 + i * 8192, R, C); const int Rb = Epi::PERM ? ((R & ~31) + perm32(R & 31)) : R;
        voffA[i] = (unsigned)(R * K + C) * 2u; voffB[i] = (unsigned)(Rb * K + C) * 2u; }
    const size_t kstep = (size_t)(BK * 2);
    const size_t hstep = (size_t)HALF * K * 2;
    const size_t tstep = 2 * hstep;
    const unsigned ldsw = (unsigned)wid * 1024u;
    const int aoff = lds_byte(wr * 64 + fr, fq * 8), boff = lds_byte(wc * 32 + fr, fq * 8);
#define PG8_SA(b, h) (((b) * 2 + (h)) * HTB)
#define PG8_SB(b, h) ((4 + (b) * 2 + (h)) * HTB)
#define PG8_STAGE(bufoff, gbase, voff) do { _Pragma("unroll") for (int _i = 0; _i < 2; ++_i) \
        __builtin_amdgcn_global_load_lds((const unsigned*)((const char*)(gbase) + (voff)[_i]), (PG8_LAS unsigned*)(lds + (bufoff) + ldsw + _i * 8192), 16, 0, 0); } while (0)
#define PG8_LDA(dst, b, h) do { _Pragma("unroll") for (int m = 0; m < 4; ++m) _Pragma("unroll") for (int k = 0; k < 2; ++k) dst[m][k] = *(const PG8_LAS bf16x8*)(lds + PG8_SA(b, h) + aoff + m * 2048 + k * 1024); } while (0)
#define PG8_LDB(dst, b, h) do { _Pragma("unroll") for (int n = 0; n < 2; ++n) _Pragma("unroll") for (int k = 0; k < 2; ++k) dst[n][k] = *(const PG8_LAS bf16x8*)(lds + PG8_SB(b, h) + boff + n * 2048 + k * 1024); } while (0)
#define PG8_MMA(ai, bj, At, Bt) do { __builtin_amdgcn_s_setprio(1); _Pragma("unroll") for (int m = 0; m < 4; ++m) _Pragma("unroll") for (int n = 0; n < 2; ++n) _Pragma("unroll") for (int k = 0; k < 2; ++k) \
        acc[ai][bj][m][n] = __builtin_amdgcn_mfma_f32_16x16x32_bf16(Bt[n][k], At[m][k], acc[ai][bj][m][n], 0, 0, 0); __builtin_amdgcn_s_setprio(0); } while (0)
#define PG8_WAIT_V(n) asm volatile("s_waitcnt vmcnt(" #n ")" ::: "memory")
#define PG8_WAIT_L(n) asm volatile("s_waitcnt lgkmcnt(" #n ")" ::: "memory")
#define PG8_BAR __builtin_amdgcn_s_barrier()
#define PG8_SCHED __builtin_amdgcn_sched_barrier(0)
    Unit cur, nxt; int ui = 0;
    if (!S.next(0, cur)) return;
    f32x4 acc[2][2][4][2];
#pragma unroll
    for (int a = 0; a < 2; ++a)
#pragma unroll
        for (int b = 0; b < 2; ++b)
#pragma unroll
            for (int m = 0; m < 4; ++m)
#pragma unroll
                for (int n = 0; n < 2; ++n) acc[a][b][m][n] = (f32x4){0.f, 0.f, 0.f, 0.f};
    bf16x8 At[4][2], B0[2][2], B1[2][2];
    const char* cA = (const char*)g.A + (size_t)cur.pm * tstep; const char* cB = (const char*)g.Bt + (size_t)cur.pn * tstep;
    S.a_ready(cur);
    if constexpr (SP2) {
        PG8_STAGE(PG8_SB(0, 0), cB, voffB); PG8_STAGE(PG8_SB(0, 1), cB + hstep, voffB); PG8_STAGE(PG8_SA(0, 0), cA, voffA); PG8_STAGE(PG8_SA(0, 1), cA + hstep, voffA);
        if (wr == 1) PG8_BAR;
        PG8_WAIT_V(2); PG8_BAR;
        PG8_STAGE(PG8_SB(1, 0), cB + kstep, voffB); PG8_STAGE(PG8_SA(1, 0), cA + kstep, voffA); PG8_STAGE(PG8_SB(1, 1), cB + hstep + kstep, voffB);
        PG8_WAIT_V(6); PG8_BAR;
    } else {
        PG8_STAGE(PG8_SB(0, 0), cB, voffB); PG8_STAGE(PG8_SA(0, 0), cA, voffA); PG8_STAGE(PG8_SB(0, 1), cB + hstep, voffB); PG8_STAGE(PG8_SA(0, 1), cA + hstep, voffA);
        if (wr == 1) PG8_BAR;
        PG8_WAIT_V(4); PG8_BAR;
        PG8_STAGE(PG8_SB(1, 0), cB + kstep, voffB); PG8_STAGE(PG8_SA(1, 0), cA + kstep, voffA); PG8_STAGE(PG8_SB(1, 1), cB + hstep + kstep, voffB);
        PG8_WAIT_V(6); PG8_BAR;
    }
    for (;;) {
        const bool has_next = S.next(ui + 1, nxt);
        const char* nA = has_next ? (const char*)g.A + (size_t)nxt.pm * tstep : cA; const char* nB = has_next ? (const char*)g.Bt + (size_t)nxt.pn * tstep : cB;
        for (int t = 0; t < nt; t += 2) {
            const bool last = (t == nt - 2);
            const char* a1 = cA + (size_t)(t + 1) * kstep;
            const char* a2 = last ? nA : cA + (size_t)(t + 2) * kstep; const char* b2 = last ? nB : cB + (size_t)(t + 2) * kstep;
            const char* a3 = a2 + kstep; const char* b3 = b2 + kstep;
            if (last && has_next) S.a_ready(nxt);
            if constexpr (SP2) {
            PG8_LDB(B0, 0, 0); PG8_LDB(B1, 0, 1); PG8_SCHED; PG8_LDA(At, 0, 0); PG8_STAGE(PG8_SA(1, 1), a1 + hstep, voffA);
            PG8_WAIT_V(8); PG8_WAIT_L(0); PG8_BAR; PG8_MMA(0, 0, At, B0); PG8_MMA(0, 1, At, B1); PG8_BAR; PG8_SCHED;
            PG8_LDA(At, 0, 1); PG8_STAGE(PG8_SB(0, 0), b2, voffB); PG8_STAGE(PG8_SB(0, 1), b2 + hstep, voffB); PG8_STAGE(PG8_SA(0, 0), a2, voffA);
            PG8_WAIT_V(8); PG8_WAIT_L(0); PG8_BAR; PG8_MMA(1, 0, At, B0); PG8_MMA(1, 1, At, B1); PG8_BAR; PG8_SCHED;
            PG8_LDB(B0, 1, 0); PG8_LDB(B1, 1, 1); PG8_SCHED; PG8_LDA(At, 1, 0); PG8_STAGE(PG8_SA(0, 1), a2 + hstep, voffA);
            PG8_WAIT_V(8); PG8_WAIT_L(0); PG8_BAR; PG8_MMA(0, 0, At, B0); PG8_MMA(0, 1, At, B1); PG8_BAR; PG8_SCHED;
            PG8_LDA(At, 1, 1); PG8_STAGE(PG8_SB(1, 0), b3, voffB); PG8_STAGE(PG8_SB(1, 1), b3 + hstep, voffB); PG8_STAGE(PG8_SA(1, 0), a3, voffA);
            PG8_WAIT_V(8); PG8_WAIT_L(0); PG8_BAR; PG8_MMA(1, 0, At, B0); PG8_MMA(1, 1, At, B1); PG8_BAR; PG8_SCHED;
            } else {
            PG8_LDB(B0, 0, 0); PG8_SCHED; PG8_LDA(At, 0, 0); PG8_STAGE(PG8_SA(1, 1), a1 + hstep, voffA);
            PG8_WAIT_L(8); PG8_BAR; PG8_WAIT_L(0); PG8_MMA(0, 0, At, B0); PG8_BAR; PG8_SCHED;
            PG8_LDB(B1, 0, 1); PG8_STAGE(PG8_SB(0, 0), b2, voffB);
            PG8_BAR; PG8_WAIT_L(0); PG8_MMA(0, 1, At, B1); PG8_BAR;
            PG8_LDA(At, 0, 1); PG8_STAGE(PG8_SA(0, 0), a2, voffA);
            PG8_BAR; PG8_WAIT_L(0); PG8_MMA(1, 0, At, B0); PG8_BAR; PG8_SCHED;
            PG8_STAGE(PG8_SB(0, 1), b2 + hstep, voffB);
            PG8_WAIT_V(6); PG8_BAR; PG8_MMA(1, 1, At, B1); PG8_BAR;
            PG8_LDB(B0, 1, 0); PG8_SCHED; PG8_LDA(At, 1, 0); PG8_STAGE(PG8_SA(0, 1), a2 + hstep, voffA);
            PG8_WAIT_L(8); PG8_BAR; PG8_WAIT_L(0); PG8_MMA(0, 0, At, B0); PG8_BAR; PG8_SCHED;
            PG8_LDB(B1, 1, 1); PG8_STAGE(PG8_SB(1, 0), b3, voffB);
            PG8_BAR; PG8_WAIT_L(0); PG8_MMA(0, 1, At, B1); PG8_BAR;
            PG8_LDA(At, 1, 1); PG8_STAGE(PG8_SA(1, 0), a3, voffA);
            PG8_BAR; PG8_WAIT_L(0); PG8_MMA(1, 0, At, B0); PG8_BAR; PG8_SCHED;
            PG8_STAGE(PG8_SB(1, 1), b3 + hstep, voffB);
            PG8_WAIT_V(6); PG8_BAR; PG8_MMA(1, 1, At, B1); PG8_BAR;
            }
        }
        if constexpr (ALIGN_EPI) { if (wr == 0) PG8_BAR; }
        if constexpr (!Epi::AFTER_DRAIN) { E(acc, cur, wr, wc, fr, fq); S.done(cur); }
        if (!has_next) break;
#pragma unroll
        for (int a = 0; a < 2; ++a)
#pragma unroll
            for (int b = 0; b < 2; ++b)
#pragma unroll
                for (int m = 0; m < 4; ++m)
#pragma unroll
                    for (int n = 0; n < 2; ++n) acc[a][b][m][n] = (f32x4){0.f, 0.f, 0.f, 0.f};
        cur = nxt; cA = nA; cB = nB; ++ui;
        if constexpr (ALIGN_EPI) { if (wr == 1) PG8_BAR; }
    }
    PG8_WAIT_V(0);
    if constexpr (!ALIGN_EPI) { if (wr == 0) PG8_BAR; }
    PG8_BAR;
    if constexpr (Epi::AFTER_DRAIN) { E.fused(acc, cur, wr, wc, fr, fq, lds, wid, lane); S.done(cur); }
#undef PG8_SA
#undef PG8_SB
#undef PG8_STAGE
#undef PG8_LDA
#undef PG8_LDB
#undef PG8_MMA
#undef PG8_WAIT_V
#undef PG8_WAIT_L
#undef PG8_BAR
#undef PG8_SCHED
}
}

using pg8::bf16_t; using pg8::bf16x8; using pg8::f32x4; using pg8::u32x4;
typedef float f32x16 __attribute__((ext_vector_type(16)));
typedef unsigned u32x2 __attribute__((ext_vector_type(2)));
#define LAS __attribute__((address_space(3)))
constexpr int D = 1024, BATCH = 4, SEQ = 8192, DFF = 2816, DH = 512, NH = 8;
constexpr int M = BATCH * SEQ;
constexpr int MP = M + 256;
constexpr int NMI = 3328;
constexpr float EPS = 1e-6f, LOG2E = 1.4426950408889634f;
constexpr int NWAVES = 8, LDS_BYTES = 147456;

constexpr size_t MiB = 1u << 20;
constexpr size_t WS_CTL = 0;
constexpr size_t WS_W1 = 2 * MiB, WS_W1O = 13 * MiB, WS_WMI = 19 * MiB, WS_WMO = 26 * MiB, WS_W2 = 28 * MiB, WS_W2O = 39 * MiB;
constexpr size_t WS_PART = 45 * MiB, PART_STRIDE = 2304 * 1024;
constexpr size_t WS_LOGF = 54 * MiB;
constexpr size_t WS_RESM = 56 * MiB;
constexpr size_t WS_XA = 58 * MiB;
constexpr size_t WS_XB = 123 * MiB;
constexpr size_t WS_ACT = 187 * MiB;
constexpr size_t QKV_STRIDE = (size_t)MP * DH * 2;
constexpr size_t WS_END = WS_ACT + (size_t)MP * DFF * 2;
static_assert(5 * QKV_STRIDE <= (size_t)MP * DFF * 2, "P3 outputs overlay the activation buffer");
static_assert((size_t)MP * 16 * 4 <= PART_STRIDE && WS_PART + 4 * PART_STRIDE <= WS_LOGF, "ws map");

__device__ __forceinline__ unsigned cvtpk(float lo, float hi) { return pg8::cvt_pk_bf16(lo, hi); }
__device__ __forceinline__ float bf_lo(unsigned u) { return __uint_as_float(u << 16); }
__device__ __forceinline__ float bf_hi(unsigned u) { return __uint_as_float(u & 0xffff0000u); }
__device__ __forceinline__ float wave_sum(float v) {
#pragma unroll
    for (int o = 1; o < 64; o <<= 1) v += __shfl_xor(v, o);
    return v;
}
__device__ __forceinline__ float row_rstd(const float* part, int row) {
    const f32x4* p = (const f32x4*)(part + (size_t)row * 16);
    const f32x4 a = p[0], b = p[1], c = p[2], d = p[3];
    const f32x4 s = (a + b) + (c + d);
    const float t = (s[0] + s[1]) + (s[2] + s[3]);
    return __builtin_amdgcn_rsqf(t * (1.0f / 1024.0f) + EPS);
}

constexpr int RSTAB_OFF = 131072 + 1024;
template <class Sched> __device__ __forceinline__ void rstd_table(const Sched& S, const float* part, LAS unsigned char* lds, int wave, int lane) {
    LAS float* tab = (LAS float*)(lds + RSTAB_OFF); pg8::Unit u; int nu = 0;
    while (nu < 11 && S.next(nu, u)) ++nu;
    const int t = wave * 64 + lane;
#pragma unroll 6
    for (int k = t; k < nu * 256; k += NWAVES * 64) { S.next(k >> 8, u); tab[k] = row_rstd(part, u.pm * 256 + (k & 255)); }
    __syncthreads();
}


struct EpiSwiGLU {
    static constexpr bool PERM = true, AFTER_DRAIN = false;
    bf16_t* O; const LAS float* tab;
    __device__ __forceinline__ void operator()(const f32x4 (&acc)[2][2][4][2], const pg8::Unit& u, int wr, int wc, int fr, int fq) const {
        const int row0 = u.pm * 256 + wr * 64 + fr, col0 = u.pn * 128 + wc * 32 + 8 * fq; const LAS float* tb = tab + u.ui * 256 + wr * 64 + fr;
#pragma unroll
        for (int ai = 0; ai < 2; ++ai)
#pragma unroll
            for (int m = 0; m < 4; ++m) {
                const int row = row0 + ai * 128 + m * 16; const float rs = tb[ai * 128 + m * 16]; const float nrl = -rs * LOG2E, rs2 = rs * rs;
                f32x4 o[2];
#pragma unroll
                for (int n = 0; n < 2; ++n) { const f32x4 G = acc[ai][0][m][n], U = acc[ai][1][m][n]; const f32x4 T = G * nrl; f32x4 Rr;
#pragma unroll
                    for (int i = 0; i < 4; ++i) Rr[i] = __builtin_amdgcn_rcpf(1.0f + __builtin_amdgcn_exp2f(T[i]));
                    o[n] = (G * U) * (Rr * rs2); }
                u32x4 w; w.x = cvtpk(o[0][0], o[0][1]); w.y = cvtpk(o[0][2], o[0][3]); w.z = cvtpk(o[1][0], o[1][1]); w.w = cvtpk(o[1][2], o[1][3]);
                *(u32x4*)(O + (size_t)row * DFF + col0) = w;
            }
    }
};

template <bool F32OUT> struct EpiResid {
    static constexpr bool PERM = true, AFTER_DRAIN = false;
    const bf16_t* res; float* out; bf16_t* hb; float* part; float alpha;
    __device__ __forceinline__ void operator()(const f32x4 (&acc)[2][2][4][2], const pg8::Unit& u, int wr, int wc, int fr, int fq) const {
        const int row0 = u.pm * 256 + wr * 64 + fr, col0 = u.pn * 256 + wc * 32 + 8 * fq;
        u32x4 rb[2][4][2];
#pragma unroll
        for (int ai = 0; ai < 2; ++ai)
#pragma unroll
            for (int m = 0; m < 4; ++m)
#pragma unroll
                for (int bj = 0; bj < 2; ++bj) rb[ai][m][bj] = *(const u32x4*)(res + (size_t)(row0 + ai * 128 + m * 16) * D + col0 + 128 * bj);
#pragma unroll
        for (int ai = 0; ai < 2; ++ai)
#pragma unroll
            for (int m = 0; m < 4; ++m) {
                const int row = row0 + ai * 128 + m * 16;
                float ss = 0.f;
#pragma unroll
                for (int bj = 0; bj < 2; ++bj) { const int c = col0 + 128 * bj;
                    const u32x4 rv = rb[ai][m][bj];
                    const f32x4 r0 = (f32x4){bf_lo(rv.x), bf_hi(rv.x), bf_lo(rv.y), bf_hi(rv.y)}, r1 = (f32x4){bf_lo(rv.z), bf_hi(rv.z), bf_lo(rv.w), bf_hi(rv.w)};
                    const f32x4 v0 = r0 + acc[ai][bj][m][0] * alpha, v1 = r1 + acc[ai][bj][m][1] * alpha;
                    if (F32OUT) { float* op = out + (size_t)row * D + c; *(f32x4*)op = v0; *(f32x4*)(op + 4) = v1; }
                    else { u32x4 w; w.x = cvtpk(v0[0], v0[1]); w.y = cvtpk(v0[2], v0[3]); w.z = cvtpk(v1[0], v1[1]); w.w = cvtpk(v1[2], v1[3]);
                        *(u32x4*)(hb + (size_t)row * D + c) = w; }
                    ss += (v0[0] * v0[0] + v0[1] * v0[1]) + (v0[2] * v0[2] + v0[3] * v0[3]) + (v1[0] * v1[0] + v1[1] * v1[1]) + (v1[2] * v1[2] + v1[3] * v1[3]); }
                ss += __shfl_xor(ss, 16); ss += __shfl_xor(ss, 32);
                if (fq == 0) part[(size_t)row * 16 + u.pn * 4 + wc] = ss;
            }
    }
};

struct EpiMixIn {
    static constexpr bool PERM = true, AFTER_DRAIN = false;
    bf16_t *Q, *K, *V, *B, *Z; float* logfT; const LAS float* tab; const float *qn, *kn, *bfg;
    __device__ __forceinline__ void operator()(const f32x4 (&acc)[2][2][4][2], const pg8::Unit& u, int wr, int wc, int fr, int fq) const {
        const int row0 = u.pm * 256 + wr * 64 + fr, pn = u.pn; const LAS float* tb = tab + u.ui * 256 + wr * 64 + fr;
        if (pn < 4) {
            const float* gp = (pn < 2 ? qn : kn) + 8 * fq; bf16_t* base = pn < 2 ? Q : K; const float sc = pn < 2 ? 0.125f * LOG2E : 1.0f;
            const int head = (pn & 1) * 4 + wc;
            float g[2][8];
#pragma unroll
            for (int bj = 0; bj < 2; ++bj)
#pragma unroll
                for (int i = 0; i < 8; ++i) g[bj][i] = gp[bj * 32 + i] * sc;
#pragma unroll
            for (int ai = 0; ai < 2; ++ai)
#pragma unroll
                for (int m = 0; m < 4; ++m) {
                    const int row = row0 + ai * 128 + m * 16; const float rs = tb[ai * 128 + m * 16];
                    float a[2][8]; float ss = 0.f;
#pragma unroll
                    for (int bj = 0; bj < 2; ++bj)
#pragma unroll
                        for (int i = 0; i < 8; ++i) { a[bj][i] = acc[ai][bj][m][i >> 2][i & 3] * rs; ss += a[bj][i] * a[bj][i]; }
                    ss += __shfl_xor(ss, 16); ss += __shfl_xor(ss, 32);
                    const float rr = 1.0f / sqrtf(ss * (1.0f / 64.0f) + EPS);
#pragma unroll
                    for (int bj = 0; bj < 2; ++bj) { u32x4 w;
                        w.x = cvtpk(a[bj][0] * rr * g[bj][0], a[bj][1] * rr * g[bj][1]); w.y = cvtpk(a[bj][2] * rr * g[bj][2], a[bj][3] * rr * g[bj][3]);
                        w.z = cvtpk(a[bj][4] * rr * g[bj][4], a[bj][5] * rr * g[bj][5]); w.w = cvtpk(a[bj][6] * rr * g[bj][6], a[bj][7] * rr * g[bj][7]);
                        *(u32x4*)(base + (size_t)row * DH + head * 64 + bj * 32 + 8 * fq) = w; }
                }
        } else if (pn < 6) {
            const int col0 = (pn & 1) * 256 + wc * 32 + 8 * fq;
#pragma unroll
            for (int ai = 0; ai < 2; ++ai)
#pragma unroll
                for (int m = 0; m < 4; ++m) {
                    const int row = row0 + ai * 128 + m * 16; const float rs = tb[ai * 128 + m * 16]; const int bb = row / SEQ, t = row % SEQ;
#pragma unroll
                    for (int bj = 0; bj < 2; ++bj) { const int c = col0 + 128 * bj; bf16_t* vp = V + ((size_t)(bb * NH) * 64 + c) * SEQ + t;
                        const f32x4 v0 = acc[ai][bj][m][0] * rs, v1 = acc[ai][bj][m][1] * rs;
                        const unsigned w0 = cvtpk(v0[0], v0[1]), w1 = cvtpk(v0[2], v0[3]), w2 = cvtpk(v1[0], v1[1]), w3 = cvtpk(v1[2], v1[3]);
                        vp[0] = (bf16_t)w0; vp[SEQ] = (bf16_t)(w0 >> 16); vp[2 * SEQ] = (bf16_t)w1; vp[3 * SEQ] = (bf16_t)(w1 >> 16);
                        vp[4 * SEQ] = (bf16_t)w2; vp[5 * SEQ] = (bf16_t)(w2 >> 16); vp[6 * SEQ] = (bf16_t)w3; vp[7 * SEQ] = (bf16_t)(w3 >> 16); }
                }
        } else if (pn < 8) {
            bf16_t* base = B; const int col0 = (pn & 1) * 256 + wc * 32 + 8 * fq;
#pragma unroll
            for (int ai = 0; ai < 2; ++ai)
#pragma unroll
                for (int m = 0; m < 4; ++m) {
                    const int row = row0 + ai * 128 + m * 16; const float rs = tb[ai * 128 + m * 16];
#pragma unroll
                    for (int bj = 0; bj < 2; ++bj) { const f32x4 v0 = acc[ai][bj][m][0] * rs, v1 = acc[ai][bj][m][1] * rs; u32x4 w;
                        w.x = cvtpk(v0[0], v0[1]); w.y = cvtpk(v0[2], v0[3]); w.z = cvtpk(v1[0], v1[1]); w.w = cvtpk(v1[2], v1[3]);
                        *(u32x4*)(base + (size_t)row * DH + col0 + 128 * bj) = w; }
                }
        } else if (pn < 12) {
            const int col0 = (pn - 8) * 128 + wc * 32 + 8 * fq;
#pragma unroll
            for (int ai = 0; ai < 2; ++ai)
#pragma unroll
                for (int m = 0; m < 4; ++m) {
                    const int row = row0 + ai * 128 + m * 16; const float rs = tb[ai * 128 + m * 16]; const float r2 = rs * rs;
                    const f32x4 v0 = acc[ai][0][m][0] * acc[ai][1][m][0] * r2, v1 = acc[ai][0][m][1] * acc[ai][1][m][1] * r2; u32x4 w;
                    w.x = cvtpk(v0[0], v0[1]); w.y = cvtpk(v0[2], v0[3]); w.z = cvtpk(v1[0], v1[1]); w.w = cvtpk(v1[2], v1[3]);
                    *(u32x4*)(Z + (size_t)row * DH + col0) = w;
                }
        }
    }
};

__device__ __forceinline__ void conv_item(const float* W, int N, int K, bf16_t* WT, int dr0, int sc0, int nvalid, const float* ks, int kb, LAS float* scr, int lane) {
    const int k0 = 64 * kb;
    if (nvalid == 32) {
        const int kr = lane >> 3, n4 = (lane & 7) * 4; f32x4 v[8];
#pragma unroll
        for (int i = 0; i < 8; ++i) v[i] = *(const f32x4*)(W + (size_t)(k0 + 8 * i + kr) * N + sc0 + n4);
        if (ks) {
#pragma unroll
            for (int i = 0; i < 8; ++i) v[i] = v[i] * ks[k0 + 8 * i + kr]; }
#pragma unroll
        for (int i = 0; i < 8; ++i) { LAS float* s = scr + (8 * i + kr) * 33 + n4; s[0] = v[i][0]; s[1] = v[i][1]; s[2] = v[i][2]; s[3] = v[i][3]; }
    } else {
        const int n = lane & 31;
#pragma unroll 8
        for (int i = 0; i < 32; ++i) { const int kk = 2 * i + (lane >> 5);
            float v = 0.f; if (n < nvalid) { v = W[(size_t)(k0 + kk) * N + sc0 + n]; if (ks) v *= ks[k0 + kk]; }
            scr[kk * 33 + n] = v; }
    }
    asm volatile("s_waitcnt lgkmcnt(0)" ::: "memory");
    const int c = lane & 7;
#pragma unroll
    for (int j = 0; j < 4; ++j) { const int nn = (lane >> 3) + 8 * j; const LAS float* s = scr + (8 * c) * 33 + nn;
        u32x4 o; o.x = cvtpk(s[0 * 33], s[1 * 33]); o.y = cvtpk(s[2 * 33], s[3 * 33]); o.z = cvtpk(s[4 * 33], s[5 * 33]); o.w = cvtpk(s[6 * 33], s[7 * 33]);
        *(u32x4*)(WT + (size_t)(dr0 + nn) * K + k0 + 8 * c) = o; }
    asm volatile("s_waitcnt lgkmcnt(0)" ::: "memory");
}

struct Args { const float* in[18]; float* out; unsigned char* ws; };
enum { I_X = 0, I_META, I_F1N, I_F1WI, I_F1WO, I_MIXN, I_WMI, I_BF, I_QN, I_KN, I_CW, I_AON, I_CON, I_WMO, I_F2N, I_F2WI, I_F2WO, I_FN };

__device__ __forceinline__ void p0_prologue(const Args& a, LAS unsigned char* lds, int gw, int NGW, int wave, int lane) {
    unsigned char* ws = a.ws;
    LAS float* scr = (LAS float*)(lds + wave * 16384);
    constexpr int I_IN = (2 * DFF / 32) * (D / 64), I_OUT = (D / 32) * (DFF / 64), I_MI = (NMI / 32) * (D / 64), I_MO = (D / 32) * (D / 64);
    constexpr int NITEMS = 2 * I_IN + 2 * I_OUT + I_MI + I_MO;
    for (int it = gw; it < NITEMS; it += NGW) {
        int r = it;
        if (r < 2 * I_IN) { const int which = r >= I_IN; r -= which * I_IN; const int nblk = 2 * DFF / 32, kb = r / nblk, dr0 = (r % nblk) * 32;
            const int pn = dr0 >> 8, within = dr0 & 255, bj = within >> 7, i0 = within & 127;
            conv_item(a.in[which ? I_F2WI : I_F1WI], 2 * DFF, D, (bf16_t*)(ws + (which ? WS_W2 : WS_W1)), dr0, bj * DFF + pn * 128 + i0, 32, a.in[which ? I_F2N : I_F1N], kb, scr, lane); continue; }
        r -= 2 * I_IN;
        if (r < 2 * I_OUT) { const int which = r >= I_OUT; r -= which * I_OUT; const int nblk = D / 32, kb = r / nblk, dr0 = (r % nblk) * 32;
            conv_item(a.in[which ? I_F2WO : I_F1WO], D, DFF, (bf16_t*)(ws + (which ? WS_W2O : WS_W1O)), dr0, dr0, 32, nullptr, kb, scr, lane); continue; }
        r -= 2 * I_OUT;
        if (r < I_MI) { const int nblk = NMI / 32, kb = r / nblk, dr0 = (r % nblk) * 32;
            const int pn = dr0 >> 8, within = dr0 & 255, bj = within >> 7, i0 = within & 127, wcw = i0 >> 5;
            int sc0, nv = 32;
            if (pn < 4) sc0 = (pn >> 1) * 512 + ((pn & 1) * 4 + wcw) * 64 + bj * 32;
            else if (pn < 6) sc0 = dr0;
            else if (pn < 8) sc0 = 1544 + (dr0 - 1536);
            else if (pn < 12) sc0 = (bj ? 2568 : 2056) + 128 * (pn - 8) + i0;
            else { sc0 = 1536; nv = (dr0 == 3072) ? 8 : 0; }
            conv_item(a.in[I_WMI], 3080, D, (bf16_t*)(ws + WS_WMI), dr0, sc0, nv, a.in[I_MIXN], kb, scr, lane); continue; }
        r -= I_MI;
        { const int nblk = D / 32, kb = r / nblk, dr0 = (r % nblk) * 32;
          const float* ks = (kb < 8) ? a.in[I_AON] : a.in[I_CON] - 512;
          conv_item(a.in[I_WMO], D, D, (bf16_t*)(ws + WS_WMO), dr0, dr0, 32, ks, kb, scr, lane); }
    }
    bf16_t* XA = (bf16_t*)(ws + WS_XA); float* part0 = (float*)(ws + WS_PART);
    for (int r0 = gw * 4; r0 < M + 16; r0 += NGW * 4) {
        f32x4 v[4][4];
#pragma unroll
        for (int rr = 0; rr < 4; ++rr) { const int row = r0 + rr; const float* src = row < M ? a.in[I_X] + (size_t)row * D : a.in[I_META] + (size_t)(row - M) * D;
#pragma unroll
            for (int j = 0; j < 4; ++j) v[rr][j] = ((const f32x4*)src)[lane + 64 * j]; }
#pragma unroll
        for (int rr = 0; rr < 4; ++rr) { const int row = r0 + rr; float ss = 0.f;
#pragma unroll
            for (int j = 0; j < 4; ++j) ss += (v[rr][j][0] * v[rr][j][0] + v[rr][j][1] * v[rr][j][1]) + (v[rr][j][2] * v[rr][j][2] + v[rr][j][3] * v[rr][j][3]);
            ss = wave_sum(ss);
#pragma unroll
            for (int j = 0; j < 4; ++j) { u32x2 w; w.x = cvtpk(v[rr][j][0], v[rr][j][1]); w.y = cvtpk(v[rr][j][2], v[rr][j][3]); *(u32x2*)(XA + (size_t)row * D + 4 * (lane + 64 * j)) = w; }
            if (lane < 16) part0[(size_t)row * 16 + lane] = lane == 0 ? ss : 0.f; }
    }
}

template <int NC, int K> __device__ __forceinline__ void mini16(const bf16_t* X, const bf16_t* W, const int (&wr)[NC], f32x4 (&acc)[NC], LAS unsigned char* lds, int wave, int lane) {
    constexpr int KW = K / 8; static_assert(KW % 32 == 0, "K split");
    const int r = lane & 15, q = lane >> 4;
    const bf16_t* xp = X + (size_t)r * K + wave * KW + 8 * q;
    const bf16_t* wp[NC];
#pragma unroll
    for (int c = 0; c < NC; ++c) { wp[c] = W + (size_t)(wr[c] + r) * K + wave * KW + 8 * q; acc[c] = (f32x4){0.f, 0.f, 0.f, 0.f}; }
#pragma unroll
    for (int k = 0; k < KW; k += 32) { const bf16x8 xv = *(const bf16x8*)(xp + k);
#pragma unroll
        for (int c = 0; c < NC; ++c) { const bf16x8 wv = *(const bf16x8*)(wp[c] + k); acc[c] = __builtin_amdgcn_mfma_f32_16x16x32_bf16(wv, xv, acc[c], 0, 0, 0); } }
    LAS f32x4* P = (LAS f32x4*)lds;
#pragma unroll
    for (int c = 0; c < NC; ++c) P[(wave * NC + c) * 64 + lane] = acc[c];
    __syncthreads();
#pragma unroll
    for (int c = 0; c < NC; ++c) { f32x4 s = P[c * 64 + lane];
#pragma unroll
        for (int w = 1; w < 8; ++w) s += P[(w * NC + c) * 64 + lane];
        acc[c] = s; }
    __syncthreads();
}
__device__ __forceinline__ float log_sigmoid(float x) { return fminf(x, 0.f) - __logf(1.0f + __expf(-fabsf(x))); }
__device__ __forceinline__ float meta_rstd(const float* mpart, int tok) {
    const f32x4* p = (const f32x4*)(mpart + tok * 64); f32x4 s = p[0];
#pragma unroll
    for (int i = 1; i < 16; ++i) s += p[i];
    return 1.0f / sqrtf(((s[0] + s[1]) + (s[2] + s[3])) * (1.0f / 1024.0f) + EPS);
}
__device__ __forceinline__ void meta_up(const bf16_t* XA, const bf16_t* W1, bf16_t* ACT, const float* part0, int item, LAS unsigned char* lds, int wave, int lane) {
    const int j0 = item * 16, ng = 256 * (j0 >> 7) + (j0 & 127); const int wr[2] = {ng, ng + 128}; f32x4 acc[2];
    mini16<2, D>(XA + (size_t)M * D, W1, wr, acc, lds, wave, lane);
    if (wave != 0) return;
    const int tok = lane & 15, nq = lane >> 4; const float rs = row_rstd(part0, M + tok); float a[4];
#pragma unroll
    for (int i = 0; i < 4; ++i) { const float g = acc[0][i] * rs, up = acc[1][i] * rs; a[i] = g * __builtin_amdgcn_rcpf(1.0f + __builtin_amdgcn_exp2f(-g * LOG2E)) * up; }
    u32x2 w; w.x = cvtpk(a[0], a[1]); w.y = cvtpk(a[2], a[3]); *(u32x2*)(ACT + (size_t)(M + tok) * DFF + j0 + 4 * nq) = w;
}
__device__ __forceinline__ void meta_down(const bf16_t* ACT, const bf16_t* W1O, const float* meta, bf16_t* XA, float* mpart, int item, LAS unsigned char* lds, int wave, int lane) {
    const int c0 = item * 16; const int wr[1] = {c0}; f32x4 acc[1];
    mini16<1, DFF>(ACT + (size_t)M * DFF, W1O, wr, acc, lds, wave, lane);
    if (wave != 0) return;
    const int tok = lane & 15, nq = lane >> 4; const f32x4 r = *(const f32x4*)(meta + (size_t)tok * D + c0 + 4 * nq); const f32x4 v = r + acc[0] * 0.5f;
    u32x2 w; w.x = cvtpk(v[0], v[1]); w.y = cvtpk(v[2], v[3]); *(u32x2*)(XA + (size_t)(M + tok) * D + c0 + 4 * nq) = w;
    float ss = (v[0] * v[0] + v[1] * v[1]) + (v[2] * v[2] + v[3] * v[3]); ss += __shfl_xor(ss, 16); ss += __shfl_xor(ss, 32);
    if (nq == 0) mpart[tok * 64 + item] = ss;
}
__device__ __forceinline__ void meta_mix(const bf16_t* XA, const bf16_t* WMI, bf16_t* K, bf16_t* V, bf16_t* Z, float* logfT, const float* mpart, const float* kn, const float* bfg, int item, LAS unsigned char* lds, int wave, int lane) {
    int wr[4];
    if (item < 8) { const int pn = 2 + (item >> 2), wc = item & 3;
#pragma unroll
        for (int c = 0; c < 4; ++c) wr[c] = 256 * pn + 128 * (c >> 1) + 32 * wc + 16 * (c & 1); }
    else if (item < 16) {
#pragma unroll
        for (int c = 0; c < 4; ++c) wr[c] = 1024 + (item - 8) * 64 + 16 * c; }
    else if (item < 32) { const int ch0 = (item - 16) * 32; wr[0] = 2048 + 256 * (ch0 >> 7) + (ch0 & 127); wr[1] = wr[0] + 16; wr[2] = wr[0] + 128; wr[3] = wr[1] + 128; }
    else { wr[0] = 3072; wr[1] = 3072; wr[2] = 3072; wr[3] = 3072; }
    f32x4 acc[4];
    mini16<4, D>(XA + (size_t)M * D, WMI, wr, acc, lds, wave, lane);
    if (wave != 0) return;
    const int tok = lane & 15, nq = lane >> 4; const float rs = meta_rstd(mpart, tok); const size_t row = (size_t)M + tok;
    if (item < 8) { float ss = 0.f;
#pragma unroll
        for (int c = 0; c < 4; ++c) { acc[c] = acc[c] * rs; ss += (acc[c][0] * acc[c][0] + acc[c][1] * acc[c][1]) + (acc[c][2] * acc[c][2] + acc[c][3] * acc[c][3]); }
        ss += __shfl_xor(ss, 16); ss += __shfl_xor(ss, 32); const float rr = 1.0f / sqrtf(ss * (1.0f / 64.0f) + EPS);
#pragma unroll
        for (int c = 0; c < 4; ++c) { const f32x4 g = *(const f32x4*)(kn + 16 * c + 4 * nq); const f32x4 v = acc[c] * rr * g; u32x2 w; w.x = cvtpk(v[0], v[1]); w.y = cvtpk(v[2], v[3]);
            *(u32x2*)(K + row * DH + item * 64 + 16 * c + 4 * nq) = w; } }
    else if (item < 16) {
#pragma unroll
        for (int c = 0; c < 4; ++c) { const f32x4 v = acc[c] * rs; const unsigned w0 = cvtpk(v[0], v[1]), w1 = cvtpk(v[2], v[3]); bf16_t* vp = V + (size_t)((item - 8) * 64 + 16 * c + 4 * nq) * 16 + tok;
            vp[0] = (bf16_t)w0; vp[16] = (bf16_t)(w0 >> 16); vp[32] = (bf16_t)w1; vp[48] = (bf16_t)(w1 >> 16); } }
    else if (item < 32) { const float r2 = rs * rs;
#pragma unroll
        for (int c = 0; c < 2; ++c) { const f32x4 v = acc[c] * acc[2 + c] * r2; u32x2 w; w.x = cvtpk(v[0], v[1]); w.y = cvtpk(v[2], v[3]); *(u32x2*)(Z + row * DH + (item - 16) * 32 + 16 * c + 4 * nq) = w; } }
    else if (nq < 2) {
#pragma unroll
        for (int i = 0; i < 4; ++i) { const int h = 4 * nq + i; logfT[(size_t)h * MP + row] = log_sigmoid(acc[0][i] * rs + bfg[h]); } }
}
__device__ __forceinline__ void flog_wg(const bf16_t* XA, const bf16_t* WMI, float* logfT, const float* part1, const float* bfg, int rowbase, LAS unsigned char* lds, int wave, int lane) {
    const int r = lane & 15, q = lane >> 4;
    const bf16_t* wp = WMI + (size_t)(3072 + r) * D + wave * 128 + 8 * q;
    bf16x8 wv[4];
#pragma unroll
    for (int s = 0; s < 4; ++s) wv[s] = *(const bf16x8*)(wp + 32 * s);
    LAS f32x4* P = (LAS f32x4*)lds;
#pragma unroll
    for (int g = 0; g < 8; ++g) { const bf16_t* xp = XA + (size_t)(rowbase + 16 * g + r) * D + wave * 128 + 8 * q; f32x4 acc = (f32x4){0.f, 0.f, 0.f, 0.f};
#pragma unroll
        for (int s = 0; s < 4; ++s) acc = __builtin_amdgcn_mfma_f32_16x16x32_bf16(wv[s], *(const bf16x8*)(xp + 32 * s), acc, 0, 0, 0);
        P[(wave * 8 + g) * 64 + lane] = acc; }
    __syncthreads();
    f32x4 s = P[wave * 64 + lane];
#pragma unroll
    for (int w = 1; w < 8; ++w) s += P[(w * 8 + wave) * 64 + lane];
    const int tok = lane & 15, nq = lane >> 4, row = rowbase + 16 * wave + tok; const float rs = row_rstd(part1, row);
    if (nq < 2) {
#pragma unroll
        for (int i = 0; i < 4; ++i) { const int h = 4 * nq + i; logfT[(size_t)h * MP + row] = log_sigmoid(s[i] * rs + bfg[h]); } }
    __syncthreads();
}

struct MixP { const bf16_t *Q, *K, *VT, *VTm, *B, *Z; const float* logfT; const float* cw; bf16_t* out; float thresh; };

__device__ __forceinline__ float wave_scan_incl(float v) {
#define DPP_ADD(ctrl, rmask) v += __int_as_float(__builtin_amdgcn_update_dpp(0, __float_as_int(v), ctrl, rmask, 0xf, false))
    DPP_ADD(0x111, 0xf); DPP_ADD(0x112, 0xf); DPP_ADD(0x114, 0xf); DPP_ADD(0x118, 0xf);
    DPP_ADD(0x142, 0xa);
    DPP_ADD(0x143, 0xc);
#undef DPP_ADD
    return v;
}
__device__ __forceinline__ void mixer_unit(const MixP& p, int b, int t0, LAS unsigned char* lds, int wave, int lane) {
    const int r32 = lane & 31, hi = lane >> 5, h = wave;
    LAS float* ssq = (LAS float*)(lds + 4096);
    const size_t rowq = (size_t)b * SEQ + t0;
    bf16x8 qf[4];
    { const bf16_t* qp = p.Q + (rowq + r32) * DH + h * 64 + 8 * hi;
#pragma unroll
      for (int ks = 0; ks < 4; ++ks) qf[ks] = *(const bf16x8*)(qp + 16 * ks); }
    float mrun = -INFINITY, l = 0.f; f32x16 o0, o1;
#pragma unroll
    for (int r = 0; r < 16; ++r) { o0[r] = 0.f; o1[r] = 0.f; }
    const int jd = t0 >> 6, T0 = jd << 6;
    const char* Kh = (const char*)(p.K + h * 64);
    const char* Vh = (const char*)(p.VT + (size_t)(b * NH + h) * 64 * SEQ);
    const char* Vm = (const char*)(p.VTm + (size_t)h * 64 * 16);
    const char* Lh = (const char*)(p.logfT + (size_t)h * MP);
#define KROW(j_) ((j_) >= 0 ? (size_t)b * SEQ + 64 * (j_) : (size_t)M)
    bf16x8 kc[8]; float Lc;
    { const char* kp = Kh + KROW(jd) * DH * 2; const unsigned koff0 = (unsigned)(r32 * DH + 8 * hi) * 2u;
#pragma unroll
      for (int ks = 0; ks < 4; ++ks) { kc[2 * ks] = *(const bf16x8*)(kp + koff0 + 32 * ks); kc[2 * ks + 1] = *(const bf16x8*)(kp + koff0 + 32 * DH * 2 + 32 * ks); }
      Lc = *(const float*)(Lh + KROW(jd) * 4 + (unsigned)lane * 4u); }
    float base = 0.f;
    for (int j = jd; ; --j) {
        int ln = lane; asm volatile("" : "+v"(ln));
        const int r32 = ln & 31, hi = ln >> 5, lane = ln;
        const unsigned koff = (unsigned)(r32 * DH + 8 * hi) * 2u, vldoff = (unsigned)((lane >> 3) * SEQ + 8 * (lane & 7)) * 2u, voffm = (unsigned)(r32 * 16 + 4 * hi) * 2u, loffx = (unsigned)lane * 4u, loffm = (unsigned)(lane & 15) * 4u;
        LAS float* sc = (LAS float*)lds + wave * 64; LAS unsigned char* vt = lds + 8192 + wave * 8704;
        u32x4 vld[8];
        if (j >= 0) { const char* vp = Vh + (size_t)(64 * j) * 2;
#pragma unroll
            for (int i = 0; i < 8; ++i) vld[i] = *(const u32x4*)(vp + vldoff + (size_t)(8 * i) * SEQ * 2); }
        else {
#pragma unroll
            for (int i = 0; i < 2; ++i) { const u32x2 a_ = *(const u32x2*)(Vm + voffm + i * 32 * 16 * 2), b_ = *(const u32x2*)(Vm + voffm + i * 32 * 16 * 2 + 16); vld[i] = (u32x4){a_.x, a_.y, b_.x, b_.y}; } }
        const int nvalid = j >= 0 ? 64 : 16;
        const float P = wave_scan_incl(lane < nvalid ? Lc * LOG2E : 0.f);
        const float tot = __int_as_float(__builtin_amdgcn_readlane(__float_as_int(P), 63));
        const float p31 = __int_as_float(__builtin_amdgcn_readlane(__float_as_int(P), 31));
        const float bj = (j == jd) ? ((t0 > T0) ? p31 : 0.f) : base + tot;
        sc[lane] = bj - P; base = bj;
        f32x16 s0, s1;
#pragma unroll
        for (int r = 0; r < 16; ++r) { s0[r] = 0.f; s1[r] = 0.f; }
#pragma unroll
        for (int ks = 0; ks < 4; ++ks) { s0 = __builtin_amdgcn_mfma_f32_32x32x16_bf16(kc[2 * ks], qf[ks], s0, 0, 0, 0); s1 = __builtin_amdgcn_mfma_f32_32x32x16_bf16(kc[2 * ks + 1], qf[ks], s1, 0, 0, 0); }
        if (j >= 0) { const char* kp = Kh + KROW(j - 1) * DH * 2;
#pragma unroll
            for (int ks = 0; ks < 4; ++ks) { kc[2 * ks] = *(const bf16x8*)(kp + koff + 32 * ks); kc[2 * ks + 1] = *(const bf16x8*)(kp + koff + 32 * DH * 2 + 32 * ks); }
            Lc = *(const float*)(Lh + KROW(j - 1) * 4 + (j > 0 ? loffx : loffm)); }
        asm volatile("s_waitcnt lgkmcnt(0)" ::: "memory");
#pragma unroll
        for (int g = 0; g < 4; ++g) { const f32x4 b0 = *(const LAS f32x4*)(sc + 8 * g + 4 * hi), b1 = *(const LAS f32x4*)(sc + 32 + 8 * g + 4 * hi);
#pragma unroll
            for (int i = 0; i < 4; ++i) { s0[4 * g + i] += b0[i]; s1[4 * g + i] += b1[i]; } }
        if (j == jd) { const int qa4 = t0 + r32 - T0 - 4 * hi;
#pragma unroll
            for (int r = 0; r < 16; ++r) { if ((r & 3) + 8 * (r >> 2) > qa4) s0[r] = -INFINITY; if ((r & 3) + 8 * (r >> 2) + 32 > qa4) s1[r] = -INFINITY; } }
        if (j < 0) { const int h4 = 4 * hi;
#pragma unroll
            for (int r = 0; r < 16; ++r) { if ((r & 3) + 8 * (r >> 2) >= 16 - h4) s0[r] = -INFINITY; s1[r] = -INFINITY; } }
        float mt = fmaxf(s0[0], s1[0]);
#pragma unroll
        for (int r = 1; r < 16; ++r) mt = fmaxf(mt, fmaxf(s0[r], s1[r]));
        mt = fmaxf(mt, __shfl_xor(mt, 32));
        const float mn = fmaxf(mrun, mt), al = __builtin_amdgcn_exp2f(mrun - mn); mrun = mn;
        float ps = 0.f;
#pragma unroll
        for (int r = 0; r < 16; ++r) { s0[r] = __builtin_amdgcn_exp2f(s0[r] - mn); s1[r] = __builtin_amdgcn_exp2f(s1[r] - mn); ps += s0[r] + s1[r]; }
        l = l * al + ps;
#pragma unroll
        for (int r = 0; r < 16; ++r) { o0[r] *= al; o1[r] *= al; }
#define PWPK(S_, o_) (u32x4){cvtpk(S_[o_ + 0], S_[o_ + 1]), cvtpk(S_[o_ + 2], S_[o_ + 3]), cvtpk(S_[o_ + 4], S_[o_ + 5]), cvtpk(S_[o_ + 6], S_[o_ + 7])}
        if (j >= 0) {
#pragma unroll
            for (int i = 0; i < 8; ++i) { LAS unsigned char* wp_ = vt + (8 * i + (lane >> 3)) * 136 + 16 * (lane & 7);
                *(LAS u32x2*)wp_ = (u32x2){vld[i].x, vld[i].y}; *(LAS u32x2*)(wp_ + 8) = (u32x2){vld[i].z, vld[i].w}; }
            asm volatile("s_waitcnt lgkmcnt(0)" ::: "memory");
            const LAS unsigned char* rp_ = vt + r32 * 136 + 8 * hi;
#pragma unroll
            for (int g4 = 0; g4 < 4; ++g4) {
                const u32x4 pw = (g4 < 2) ? PWPK(s0, 8 * (g4 & 1)) : PWPK(s1, 8 * (g4 & 1));
                const bf16x8 pf = __builtin_bit_cast(bf16x8, pw);
                const u32x2 a0 = *(const LAS u32x2*)(rp_ + 32 * g4), b0 = *(const LAS u32x2*)(rp_ + 32 * g4 + 16), a1 = *(const LAS u32x2*)(rp_ + 32 * 136 + 32 * g4), b1 = *(const LAS u32x2*)(rp_ + 32 * 136 + 32 * g4 + 16);
                const u32x4 x0 = (u32x4){a0.x, a0.y, b0.x, b0.y}, x1 = (u32x4){a1.x, a1.y, b1.x, b1.y};
                o0 = __builtin_amdgcn_mfma_f32_32x32x16_bf16(__builtin_bit_cast(bf16x8, x0), pf, o0, 0, 0, 0);
                o1 = __builtin_amdgcn_mfma_f32_32x32x16_bf16(__builtin_bit_cast(bf16x8, x1), pf, o1, 0, 0, 0);
            }
        } else {
            const u32x4 pw = PWPK(s0, 0); const bf16x8 pf = __builtin_bit_cast(bf16x8, pw);
            o0 = __builtin_amdgcn_mfma_f32_32x32x16_bf16(__builtin_bit_cast(bf16x8, vld[0]), pf, o0, 0, 0, 0);
            o1 = __builtin_amdgcn_mfma_f32_32x32x16_bf16(__builtin_bit_cast(bf16x8, vld[1]), pf, o1, 0, 0, 0);
        }
#undef PWPK
        if (j < 0 || base < -p.thresh) break;
    }
    l += __shfl_xor(l, 32);
    const float inv = 1.0f / l; float ss = 0.f;
#pragma unroll
    for (int r = 0; r < 16; ++r) { o0[r] *= inv; o1[r] *= inv; ss += o0[r] * o0[r] + o1[r] * o1[r]; }
    ss += __shfl_xor(ss, 32);
    if (hi == 0) ssq[r32 * 8 + h] = ss;
    { int c0 = lane * 8; asm volatile("" : "+v"(c0));
      float w0[8], w1[8], w2[8];
#pragma unroll
      for (int i = 0; i < 8; ++i) { w0[i] = p.cw[c0 + i]; w1[i] = p.cw[DH + c0 + i]; w2[i] = p.cw[2 * DH + c0 + i]; }
      u32x4 z0[4], z1[4], z2[4], bv[4];
#pragma unroll
      for (int rr = 0; rr < 4; ++rr) { const int t = t0 + wave + 8 * rr; const size_t row = (size_t)b * SEQ + t;
          const size_t row1 = t >= 1 ? row - 1 : (size_t)M + 15, row2 = t >= 2 ? row - 2 : (size_t)M + 14 + t;
          z0[rr] = *(const u32x4*)(p.Z + row * DH + c0); z1[rr] = *(const u32x4*)(p.Z + row1 * DH + c0); z2[rr] = *(const u32x4*)(p.Z + row2 * DH + c0); bv[rr] = *(const u32x4*)(p.B + row * DH + c0); }
#pragma unroll
      for (int rr = 0; rr < 4; ++rr) { const size_t row = (size_t)b * SEQ + t0 + wave + 8 * rr;
          float y[8]; float s2 = 0.f;
#pragma unroll
          for (int i = 0; i < 4; ++i) {
              y[2 * i] = bf_lo(bv[rr][i]) * (w0[2 * i] * bf_lo(z2[rr][i]) + w1[2 * i] * bf_lo(z1[rr][i]) + w2[2 * i] * bf_lo(z0[rr][i]));
              y[2 * i + 1] = bf_hi(bv[rr][i]) * (w0[2 * i + 1] * bf_hi(z2[rr][i]) + w1[2 * i + 1] * bf_hi(z1[rr][i]) + w2[2 * i + 1] * bf_hi(z0[rr][i]));
              s2 += y[2 * i] * y[2 * i] + y[2 * i + 1] * y[2 * i + 1]; }
          s2 = wave_sum(s2); const float rs = 1.0f / sqrtf(s2 * (1.0f / 512.0f) + EPS);
          u32x4 w; w.x = cvtpk(y[0] * rs, y[1] * rs); w.y = cvtpk(y[2] * rs, y[3] * rs); w.z = cvtpk(y[4] * rs, y[5] * rs); w.w = cvtpk(y[6] * rs, y[7] * rs);
          *(u32x4*)(p.out + row * D + DH + c0) = w; } }
    __syncthreads();
    { const f32x4 a = *(const LAS f32x4*)(ssq + r32 * 8), c = *(const LAS f32x4*)(ssq + r32 * 8 + 4);
      const float tot = ((a[0] + a[1]) + (a[2] + a[3])) + ((c[0] + c[1]) + (c[2] + c[3]));
      const float rs = 1.0f / sqrtf(tot * (1.0f / 512.0f) + EPS);
      bf16_t* op = p.out + (rowq + r32) * D + h * 64 + 4 * hi;
#pragma unroll
      for (int g = 0; g < 4; ++g) { u32x2 w;
          w.x = cvtpk(o0[4 * g] * rs, o0[4 * g + 1] * rs); w.y = cvtpk(o0[4 * g + 2] * rs, o0[4 * g + 3] * rs); *(u32x2*)(op + 8 * g) = w;
          w.x = cvtpk(o1[4 * g] * rs, o1[4 * g + 1] * rs); w.y = cvtpk(o1[4 * g + 2] * rs, o1[4 * g + 3] * rs); *(u32x2*)(op + 32 + 8 * g) = w; } }
    __syncthreads();
}

#define RLX_AGENT __ATOMIC_RELAXED, __HIP_MEMORY_SCOPE_AGENT
#define XB_TMO      128
#define XB_XCNT(j)  (256  + 64 * (j))
#define XB_XSUB(j)  (1280 + 64 * (j))
#define XB_XGEN(j)  (2304 + 64 * (j))
#define XB_TOP      3328
#define XB_TOPGEN   3392
#define XCD_BAR_WORDS 3456
#define XB_SPIN_CAP (1u << 18)

__device__ __forceinline__ unsigned xb_ld(unsigned* p)              { return __hip_atomic_load(p, __ATOMIC_RELAXED, __HIP_MEMORY_SCOPE_AGENT); }
__device__ __forceinline__ unsigned xb_add(unsigned* p, unsigned v) { return __hip_atomic_fetch_add(p, v, __ATOMIC_RELAXED, __HIP_MEMORY_SCOPE_AGENT); }
__device__ __forceinline__ unsigned xb_xcc_id() { return (unsigned)__builtin_amdgcn_s_getreg((3 << 11) | 20) & 0xFu; }
#define XB_SPIN(cond, bar) do { unsigned _sp = 0; while (cond) { __builtin_amdgcn_s_sleep(1); \
    if ((++_sp & 255u) == 0u) { if (xb_ld(&(bar)[XB_TMO])) break; if (_sp > XB_SPIN_CAP) { atomicAdd(&(bar)[XB_TMO], 1u); break; } } } } while (0)

struct XcdBarrier {
    unsigned* bar; unsigned x;
    volatile LAS unsigned* st;
};

__device__ __forceinline__ XcdBarrier xcd_barrier_post(unsigned* bar, volatile LAS unsigned* st, const bool t0) {
    XcdBarrier b; b.bar = bar; b.x = xb_xcc_id(); b.st = st;
    if (t0) (void)xb_add(&bar[XB_XCNT(b.x)], 1u);
    return b;
}
__device__ __forceinline__ void xcd_barrier_complete(unsigned* bar, unsigned x, unsigned& nloc, unsigned& nx) {
    const unsigned G = gridDim.x * gridDim.y * gridDim.z;
    unsigned sum, cnt, mine, sp = 0u;
    for (;;) {
        sum = 0u; cnt = 0u; mine = 0u;
#pragma unroll
        for (unsigned j = 0; j < 16; ++j) { const unsigned c = xb_ld(&bar[XB_XCNT(j)]); sum += c; cnt += (c > 0u) ? 1u : 0u; mine = (j == x) ? c : mine; }
        if (sum == G) break;
        __builtin_amdgcn_s_sleep(1);
        if ((++sp & 255u) == 0u) { if (xb_ld(&bar[XB_TMO])) break; if (sp > XB_SPIN_CAP) { atomicAdd(&bar[XB_TMO], 1u); break; } }
    }
    nloc = mine > 0u ? mine : 1u; nx = cnt > 0u ? cnt : 1u;
}

__device__ __forceinline__ void xcd_barrier(const XcdBarrier& b, const bool t0) {
    asm volatile("s_waitcnt vmcnt(0)" ::: "memory");
    __syncthreads();
    if (t0) {
        unsigned* bar = b.bar;
        __builtin_amdgcn_s_waitcnt(0);
        unsigned nloc = b.st[0], nx = b.st[1];
        if (nloc == 0u) { xcd_barrier_complete(bar, b.x, nloc, nx); b.st[0] = nloc; b.st[1] = nx; }
        const unsigned old = xb_add(&bar[XB_XSUB(b.x)], 1u);
        const unsigned gen = old / nloc;
        if (old + 1u == (gen + 1u) * nloc) {
            __builtin_amdgcn_fence(__ATOMIC_RELEASE, "agent");
            asm volatile("s_waitcnt vmcnt(0)" ::: "memory");
            const unsigned og = xb_add(&bar[XB_TOP], 1u);
            const unsigned tg = og / nx;
            if (og + 1u == (tg + 1u) * nx) xb_add(&bar[XB_TOPGEN], 1u);
            else XB_SPIN(xb_ld(&bar[XB_TOPGEN]) == tg, bar);
            __builtin_amdgcn_fence(__ATOMIC_ACQUIRE, "agent");
            xb_add(&bar[XB_XGEN(b.x)], 1u);
            asm volatile("s_waitcnt vmcnt(0)" ::: "memory");
        } else {
            XB_SPIN(xb_ld(&bar[XB_XGEN(b.x)]) == gen, bar);
            __builtin_amdgcn_fence(__ATOMIC_ACQUIRE, "agent");
            asm volatile("s_waitcnt vmcnt(0)" ::: "memory");
        }
    }
    __syncthreads();
}

__global__ void __launch_bounds__(NWAVES * 64, 2) fwd_mega(Args a) {
    extern __shared__ __attribute__((aligned(16))) unsigned char lds_raw[];
    LAS unsigned char* lds = (LAS unsigned char*)lds_raw;
    cg::grid_group grid = cg::this_grid();
    const int wave = __builtin_amdgcn_readfirstlane((int)threadIdx.x >> 6);
#define LANE() ({ int z_ = 0; asm volatile("" : "+v"(z_)); (int)__builtin_amdgcn_mbcnt_hi(~0u, __builtin_amdgcn_mbcnt_lo(~0u, z_)); })
#define TID0() (wave == 0 && LANE() == 0)
    const int G = gridDim.x, bx = blockIdx.x;
    const int vcu = (G % 8 == 0) ? (bx % 8) * (G / 8) + bx / 8 : bx;
    const int gw = vcu * NWAVES + wave, NGW = G * NWAVES;
    unsigned char* ws = a.ws;
    bf16_t *W1 = (bf16_t*)(ws + WS_W1), *W1O = (bf16_t*)(ws + WS_W1O), *WMI = (bf16_t*)(ws + WS_WMI), *WMO = (bf16_t*)(ws + WS_WMO), *W2 = (bf16_t*)(ws + WS_W2), *W2O = (bf16_t*)(ws + WS_W2O);
    bf16_t *XA = (bf16_t*)(ws + WS_XA), *XB = (bf16_t*)(ws + WS_XB), *ACT = (bf16_t*)(ws + WS_ACT);
    bf16_t *Qb = ACT, *Kb = (bf16_t*)(ws + WS_ACT + QKV_STRIDE), *Vb = (bf16_t*)(ws + WS_ACT + 2 * QKV_STRIDE), *Bb = (bf16_t*)(ws + WS_ACT + 3 * QKV_STRIDE), *Zb = (bf16_t*)(ws + WS_ACT + 4 * QKV_STRIDE);
    float *part0 = (float*)(ws + WS_PART), *part1 = (float*)(ws + WS_PART + PART_STRIDE), *part2 = (float*)(ws + WS_PART + 2 * PART_STRIDE), *part3 = (float*)(ws + WS_PART + 3 * PART_STRIDE);
    float *logfT = (float*)(ws + WS_LOGF), *mpart = (float*)(ws + WS_RESM);
    bf16_t* VTm = (bf16_t*)(ws + WS_RESM + 65536);

    volatile LAS unsigned* bst = (volatile LAS unsigned*)(lds + 131072 + 64);
    unsigned* barw = (unsigned*)(ws + WS_CTL);
    { const int tid = wave * 64 + LANE(); if (tid < 2) bst[tid] = 0u; }
    __syncthreads();
    if (__builtin_expect(a.ws == nullptr, 0)) grid.sync();
    const XcdBarrier bar = xcd_barrier_post(barw, bst, TID0());
#define GBAR() do { XcdBarrier b_ = bar; asm volatile("" : "+s"(b_.bar)); xcd_barrier(b_, TID0()); } while (0)
    p0_prologue(a, lds, gw, NGW, wave, LANE());
    GBAR();
    if (vcu < 176) meta_up(XA, W1, ACT, part0, vcu, lds, wave, LANE());
    { pg8::Gemm g{XA, W1, M, 2 * DFF, D}; pg8::StaticOrder S; S.init(M, 2 * DFF, G, bx); EpiSwiGLU E{ACT, (const LAS float*)(lds + RSTAB_OFF)};
      rstd_table(S, part0, lds, wave, LANE());
      pg8::gemm_phase<EpiSwiGLU, pg8::StaticOrder, true, true>(lds, g, S, E, wave); }
    GBAR();
    if (vcu < 64) meta_down(ACT, W1O, a.in[I_META], XA, mpart, vcu, lds, wave, LANE());
    { pg8::Gemm g{ACT, W1O, M, D, DFF}; pg8::StaticOrder S; S.init(M, D, G, bx); EpiResid<false> E{XA, nullptr, XA, part1, 0.5f};
      pg8::gemm_phase<EpiResid<false>, pg8::StaticOrder, true, true>(lds, g, S, E, wave); }
    GBAR();
    if (vcu < 33) meta_mix(XA, WMI, Kb, VTm, Zb, logfT, mpart, a.in[I_KN], a.in[I_BF], vcu, lds, wave, LANE());
    { const int ln = LANE(); for (int it = vcu; it < M / 128; it += G) flog_wg(XA, WMI, logfT, part1, a.in[I_BF], it * 128, lds, wave, ln); }
    { pg8::Gemm g{XA, WMI, M, 3072, D}; pg8::StaticOrder S; S.init(M, 3072, G, bx); EpiMixIn E{Qb, Kb, Vb, Bb, Zb, logfT, (const LAS float*)(lds + RSTAB_OFF), a.in[I_QN], a.in[I_KN], a.in[I_BF]};
      rstd_table(S, part1, lds, wave, LANE());
      pg8::gemm_phase<EpiMixIn, pg8::StaticOrder, true, true>(lds, g, S, E, wave); }
    GBAR();
    { const int lane4 = LANE(); float gq = fabsf(a.in[I_QN][lane4]), gk = fabsf(a.in[I_KN][lane4]);
#pragma unroll
      for (int o = 1; o < 64; o <<= 1) { gq = fmaxf(gq, __shfl_xor(gq, o)); gk = fmaxf(gk, __shfl_xor(gk, o)); }
      MixP mp{Qb, Kb, Vb, VTm, Bb, Zb, logfT, a.in[I_CW], XB, 2.0f * (8.0f * gq * gk * LOG2E * 1.05f) + 170.0f};
      constexpr int NU = M / 32;
      for (int u = vcu; u < NU; u += G) { const int b = u / (SEQ / 32), t0 = (u % (SEQ / 32)) * 32; mixer_unit(mp, b, t0, lds, wave, lane4); } }
    GBAR();
    { pg8::Gemm g{XB, WMO, M, D, D}; pg8::StaticOrder S; S.init(M, D, G, bx); EpiResid<false> E{XA, nullptr, XA, part2, 1.0f};
      pg8::gemm_phase<EpiResid<false>, pg8::StaticOrder, true, true>(lds, g, S, E, wave); }
    GBAR();
    { pg8::Gemm g{XA, W2, M, 2 * DFF, D}; pg8::StaticOrder S; S.init(M, 2 * DFF, G, bx); EpiSwiGLU E{ACT, (const LAS float*)(lds + RSTAB_OFF)};
      rstd_table(S, part2, lds, wave, LANE());
      pg8::gemm_phase<EpiSwiGLU, pg8::StaticOrder, true, true>(lds, g, S, E, wave); }
    GBAR();
    { pg8::Gemm g{ACT, W2O, M, D, DFF}; pg8::StaticOrder S; S.init(M, D, G, bx); EpiResid<false> E{XA, nullptr, XA, part3, 0.5f};
      pg8::gemm_phase<EpiResid<false>, pg8::StaticOrder, true, true>(lds, g, S, E, wave); }
    GBAR();
    { const int lane = LANE(); const float* gfn = a.in[I_FN]; f32x4 gv[4];
#pragma unroll
      for (int j = 0; j < 4; ++j) gv[j] = ((const f32x4*)gfn)[lane + 64 * j];
      for (int r0 = gw * 4; r0 < M; r0 += NGW * 4) {
          u32x2 hv[4][4]; float rs[4];
#pragma unroll
          for (int rr = 0; rr < 4; ++rr) { const u32x2* hp = (const u32x2*)(XA + (size_t)(r0 + rr) * D);
#pragma unroll
              for (int j = 0; j < 4; ++j) hv[rr][j] = hp[lane + 64 * j];
              rs[rr] = row_rstd(part3, r0 + rr); }
#pragma unroll
          for (int rr = 0; rr < 4; ++rr) { f32x4* rp = (f32x4*)(a.out + (size_t)(r0 + rr) * D);
#pragma unroll
              for (int j = 0; j < 4; ++j) { const f32x4 v = (f32x4){bf_lo(hv[rr][j].x), bf_hi(hv[rr][j].x), bf_lo(hv[rr][j].y), bf_hi(hv[rr][j].y)}; rp[lane + 64 * j] = v * rs[rr] * gv[j]; } } } }
}

extern "C" void kernel_launch(void* const* d_in, const int* in_sizes, int n_in, void* d_out, int out_size, void* d_ws, size_t ws_size, hipStream_t stream) {
    static int grid = 0;
    if (grid == 0) {
        if (n_in != 18 || in_sizes[0] != M * D || out_size != M * D || ws_size < WS_END) { fprintf(stderr, "kernel_launch: unexpected shapes (n_in %d, in0 %d, out %d, ws %zu < %zu)\n", n_in, n_in > 0 ? in_sizes[0] : -1, out_size, ws_size, (size_t)WS_END); grid = -1; return; }
        int dev = 0, cus = 0, per_cu = 0;
        if (hipGetDevice(&dev) != hipSuccess || hipDeviceGetAttribute(&cus, hipDeviceAttributeMultiprocessorCount, dev) != hipSuccess) { grid = -1; return; }
        if (hipFuncSetAttribute((const void*)fwd_mega, hipFuncAttributeMaxDynamicSharedMemorySize, LDS_BYTES) != hipSuccess) { fprintf(stderr, "kernel_launch: hipFuncSetAttribute failed\n"); grid = -1; return; }
        if (hipOccupancyMaxActiveBlocksPerMultiprocessor(&per_cu, (const void*)fwd_mega, NWAVES * 64, LDS_BYTES) != hipSuccess || per_cu < 1) { fprintf(stderr, "kernel_launch: occupancy query gave %d\n", per_cu); (void)hipGetLastError(); grid = -1; return; }
        grid = cus * per_cu;
        if (grid < 256) { fprintf(stderr, "kernel_launch: %d resident workgroups; the per-workgroup 1/rms table is sized for >= 256 (<= 11 GEMM units each)\n", grid); grid = -1; return; }
    }
    if (grid < 0) return;
    if (hipMemsetAsync((char*)d_ws + WS_CTL, 0, 65536, stream) != hipSuccess) { fprintf(stderr, "kernel_launch: hipMemsetAsync failed\n"); return; }
    Args a{};
    for (int i = 0; i < 18; ++i) a.in[i] = (const float*)d_in[i];
    a.out = (float*)d_out; a.ws = (unsigned char*)d_ws;
    void* args[] = {&a};
    const hipError_t e = hipLaunchCooperativeKernel((const void*)fwd_mega, dim3(grid), dim3(NWAVES * 64), args, LDS_BYTES, stream);
    if (e != hipSuccess) fprintf(stderr, "kernel_launch: cooperative launch failed: %s (grid %d)\n", hipGetErrorString(e), grid);
}
```
